# Optimizing an MI355X kernel written in HIP

```python
import math
import jax, jax.numpy as jnp
from jax import lax
import numpy as np

D_MODEL = 1024
BATCH = 8
SEQ = 4096
DEPTH = 2

CHUNK = 64
PLE_DIM = 256
D_MIX = D_MODEL
SSM_WIDTH = D_MIX // 2
SSM_GROUP = 16
SSM_GROUPS = SSM_WIDTH // SSM_GROUP
SSM_STATE = 64
ATTN_WIDTH = D_MIX - SSM_WIDTH
ATTN_HEADS = 8
HEAD_DIM = ATTN_WIDTH // ATTN_HEADS
Q_BLOCK = 128
RMS_EPS = 1e-6
DT_MIN = 1e-3
DT_MAX = 1e-1
IN_COLS = 2 * SSM_WIDTH + 4 * ATTN_WIDTH
SPLITS = [SSM_WIDTH, 2 * SSM_WIDTH, 2 * SSM_WIDTH + ATTN_WIDTH,
          2 * SSM_WIDTH + 2 * ATTN_WIDTH, 2 * SSM_WIDTH + 3 * ATTN_WIDTH]

kernel_name = "hymba_s5_stickbreaking_ple_block"


def rmsnorm(x, g):
    xf = x.astype(jnp.float32)
    xf = xf * lax.rsqrt(jnp.mean(xf * xf, axis=-1, keepdims=True) + RMS_EPS)
    return (xf * g.astype(jnp.float32)).astype(x.dtype)


def _complex_scan_combine(left, right):
    a1r, a1i, x1r, x1i = left
    a2r, a2i, x2r, x2i = right
    ar = a2r * a1r - a2i * a1i
    ai = a2r * a1i + a2i * a1r
    xr = a2r * x1r - a2i * x1i + x2r
    xi = a2r * x1i + a2i * x1r + x2i
    return ar, ai, xr, xi


def s5_branch(u, a_re, a_im, log_dt, b_re, b_im, c_re, c_im, d_skip, w_glu, b_glu):
    f32 = jnp.float32
    bsz, seq, _ = u.shape
    uf = u.astype(f32).reshape(bsz, seq, SSM_GROUPS, SSM_GROUP)
    dt = jnp.exp(log_dt.astype(f32))[:, None]
    lr = a_re.astype(f32)
    li = a_im.astype(f32)
    mag = jnp.exp(lr * dt)
    ab_re = mag * jnp.cos(li * dt)
    ab_im = mag * jnp.sin(li * dt)
    num_re = ab_re - 1.0
    num_im = ab_im
    den = lr * lr + li * li
    f_re = (num_re * lr + num_im * li) / den
    f_im = (num_im * lr - num_re * li) / den
    br = b_re.astype(f32)
    bi = b_im.astype(f32)
    bb_re = f_re[..., None] * br - f_im[..., None] * bi
    bb_im = f_re[..., None] * bi + f_im[..., None] * br
    cr = c_re.astype(f32)
    ci = c_im.astype(f32)

    n_chunks = seq // CHUNK
    u_chunks = uf.reshape(bsz, n_chunks, CHUNK, SSM_GROUPS, SSM_GROUP).transpose(1, 2, 0, 3, 4)
    a_re_l = jnp.broadcast_to(ab_re[None, None], (CHUNK, 1, SSM_GROUPS, SSM_STATE))
    a_im_l = jnp.broadcast_to(ab_im[None, None], (CHUNK, 1, SSM_GROUPS, SSM_STATE))

    def chunk_step(carry, u_c):
        h_re, h_im = carry
        bu_re = jnp.einsum('lbgh,gph->lbgp', u_c, bb_re)
        bu_im = jnp.einsum('lbgh,gph->lbgp', u_c, bb_im)
        p_re, p_im, x_re, x_im = lax.associative_scan(
            _complex_scan_combine, (a_re_l, a_im_l, bu_re, bu_im), axis=0)
        x_re = x_re + p_re * h_re - p_im * h_im
        x_im = x_im + p_re * h_im + p_im * h_re
        y_c = jnp.einsum('lbgp,ghp->lbgh', x_re, cr) - jnp.einsum('lbgp,ghp->lbgh', x_im, ci)
        return (x_re[-1], x_im[-1]), y_c

    h0 = jnp.zeros((bsz, SSM_GROUPS, SSM_STATE), f32)
    _, y = lax.scan(chunk_step, (h0, h0), u_chunks)
    y = y.transpose(2, 0, 1, 3, 4).reshape(bsz, seq, SSM_GROUPS, SSM_GROUP)
    y = (y + d_skip.astype(f32) * uf).reshape(bsz, seq, SSM_WIDTH)
    z = jax.nn.gelu(y)
    zz = z @ w_glu.astype(f32) + b_glu.astype(f32)
    val, gate = jnp.split(zz, 2, axis=-1)
    return (val * jax.nn.sigmoid(gate)).astype(u.dtype)


def stick_breaking_branch(q, k, v, q_g, k_g):
    f32 = jnp.float32
    bsz, seq, _ = q.shape

    def heads(t):
        return t.reshape(bsz, seq, ATTN_HEADS, HEAD_DIM).transpose(0, 2, 1, 3)

    qh = rmsnorm(heads(q), q_g).astype(f32)
    kh = rmsnorm(heads(k), k_g).astype(f32)
    vh = heads(v).astype(f32)
    scale = HEAD_DIM ** -0.5
    outs = []
    for blk in range(seq // Q_BLOCK):
        q0 = blk * Q_BLOCK
        kv_len = q0 + Q_BLOCK
        qb = qh[:, :, q0:kv_len]
        kb = kh[:, :, :kv_len]
        vb = vh[:, :, :kv_len]
        z = jnp.einsum('bhqd,bhkd->bhqk', qb, kb) * scale
        t_pos = q0 + jnp.arange(Q_BLOCK)[:, None]
        s_pos = jnp.arange(kv_len)[None, :]
        strict = s_pos < t_pos
        log_stay = jnp.where(strict, jax.nn.log_sigmoid(-z), 0.0)
        later = lax.cumsum(log_stay, axis=3, reverse=True) - log_stay
        weights = jnp.where(strict, jnp.exp(jax.nn.log_sigmoid(z) + later), 0.0)
        outs.append(jnp.einsum('bhqk,bhkd->bhqd', weights, vb))
    o = jnp.concatenate(outs, axis=2)
    return o.transpose(0, 2, 1, 3).reshape(bsz, seq, ATTN_WIDTH).astype(q.dtype)


def setup_inputs(seed: int = 0) -> dict:
    key = jax.random.key(seed)
    ks = jax.random.split(key, 20)
    f32 = jnp.float32
    G, P, H = SSM_GROUPS, SSM_STATE, SSM_GROUP
    n_idx = jnp.arange(P, dtype=f32)
    inputs = {
        "x": jax.random.normal(ks[0], (BATCH, SEQ, D_MODEL), f32),
        "p": jax.random.normal(ks[1], (DEPTH, BATCH, SEQ, PLE_DIM), f32),
        "mix_norm_g": 1.0 + 0.02 * jax.random.normal(ks[2], (DEPTH, D_MODEL), f32),
        "w_in": jax.random.normal(ks[3], (DEPTH, D_MODEL, IN_COLS), f32) * D_MODEL ** -0.5,
        "ssm_a_re": -0.5 + 0.01 * jax.random.normal(ks[4], (DEPTH, G, P), f32),
        "ssm_a_im": math.pi * n_idx + 0.01 * jax.random.normal(ks[5], (DEPTH, G, P), f32),
        "ssm_log_dt": jax.random.uniform(ks[6], (DEPTH, G), f32, math.log(DT_MIN), math.log(DT_MAX)),
        "ssm_b_re": jax.random.normal(ks[7], (DEPTH, G, P, H), f32) * (2.0 * H) ** -0.5,
        "ssm_b_im": jax.random.normal(ks[8], (DEPTH, G, P, H), f32) * (2.0 * H) ** -0.5,
        "ssm_c_re": jax.random.normal(ks[9], (DEPTH, G, H, P), f32) * (2.0 * P) ** -0.5,
        "ssm_c_im": jax.random.normal(ks[10], (DEPTH, G, H, P), f32) * (2.0 * P) ** -0.5,
        "ssm_d": jax.random.normal(ks[11], (DEPTH, G, H), f32),
        "ssm_w_glu": jax.random.normal(ks[12], (DEPTH, SSM_WIDTH, 2 * SSM_WIDTH), f32) * SSM_WIDTH ** -0.5,
        "ssm_b_glu": 0.01 * jax.random.normal(ks[13], (DEPTH, 2 * SSM_WIDTH), f32),
        "q_norm_g": 1.0 + 0.02 * jax.random.normal(ks[14], (DEPTH, HEAD_DIM), f32),
        "k_norm_g": 1.0 + 0.02 * jax.random.normal(ks[15], (DEPTH, HEAD_DIM), f32),
        "w_out": jax.random.normal(ks[16], (DEPTH, D_MIX, D_MODEL), f32) * D_MIX ** -0.5,
        "ple_norm_g": 1.0 + 0.02 * jax.random.normal(ks[17], (DEPTH, D_MODEL), f32),
        "w_ple_gate": jax.random.normal(ks[18], (DEPTH, D_MODEL, D_MODEL), f32) * D_MODEL ** -0.5,
        "w_ple_proj": jax.random.normal(ks[19], (DEPTH, PLE_DIM, D_MODEL), f32) * PLE_DIM ** -0.5,
    }
    return inputs


def reference(x, p, mix_norm_g, w_in, ssm_a_re, ssm_a_im, ssm_log_dt, ssm_b_re, ssm_b_im,
              ssm_c_re, ssm_c_im, ssm_d, ssm_w_glu, ssm_b_glu, q_norm_g, k_norm_g, w_out,
              ple_norm_g, w_ple_gate, w_ple_proj):
    h = x
    for i in range(DEPTH):
        hn = rmsnorm(h, mix_norm_g[i])
        proj = hn @ w_in[i]
        u, g_ssm, q, k, v, g_attn = jnp.split(proj, SPLITS, axis=-1)
        y_ssm = s5_branch(u, ssm_a_re[i], ssm_a_im[i], ssm_log_dt[i], ssm_b_re[i], ssm_b_im[i],
                          ssm_c_re[i], ssm_c_im[i], ssm_d[i], ssm_w_glu[i], ssm_b_glu[i])
        y_ssm = y_ssm * jax.nn.silu(g_ssm)
        y_att = stick_breaking_branch(q, k, v, q_norm_g[i], k_norm_g[i]) * jax.nn.silu(g_attn)
        h = h + jnp.concatenate([y_ssm, y_att], axis=-1) @ w_out[i]
        ple_gate = jax.nn.sigmoid(rmsnorm(h, ple_norm_g[i]) @ w_ple_gate[i])
        h = h + ple_gate * (p[i] @ w_ple_proj[i])
    return h
```

```cpp
#ifndef REP_P0
#define REP_P0 1
#define REP_INPROJ 1
#define REP_ATTN 1
#define REP_SCAN 1
#define REP_SYNC 1
#define REP_GEMMS 1
#define REP_PP 1
#define REP_Y 1
#define REP_GLU 1
#endif
#include <hip/hip_runtime.h>
#include <hip/hip_cooperative_groups.h>
#include <cstdio>
namespace cg = cooperative_groups;

#define LAS __attribute__((address_space(3)))
#define DI __device__ __forceinline__
typedef unsigned short bf16_t;
typedef short bf16x8 __attribute__((ext_vector_type(8)));
typedef float f32x4 __attribute__((ext_vector_type(4)));
typedef float f32x16 __attribute__((ext_vector_type(16)));
typedef unsigned u32x4 __attribute__((ext_vector_type(4)));
typedef unsigned u32x2 __attribute__((ext_vector_type(2)));

constexpr int T = 32768, SEQ = 4096;
constexpr int BM = 256, BK = 64, HALF = 128, HTB = HALF * BK * 2, STAGE_BYTES = 8 * HTB, NXCD = 8, WGM = 2;
constexpr int LDS_DUMMY = STAGE_BYTES + 16;
constexpr int LDS_BYTES = STAGE_BYTES + 16 + 2048;

constexpr size_t MBy = 1u << 20;
constexpr size_t WS_WIN = 0;
constexpr size_t WS_WGLU = WS_WIN + 12 * MBy;
constexpr size_t WS_WOUT = WS_WGLU + 2 * MBy;
constexpr size_t WS_WPG = WS_WOUT + 4 * MBy;
constexpr size_t WS_WPP = WS_WPG + 4 * MBy;
constexpr size_t WS_W1 = WS_WPP + 1 * MBy;
constexpr size_t WS_TOEP = WS_W1 + 16 * MBy;
constexpr size_t WS_MISC = WS_TOEP + 40 * MBy;
constexpr size_t WS_HBA = WS_MISC + 1 * MBy;
constexpr size_t WS_UCAT = WS_HBA + 64 * MBy;
constexpr size_t WS_SGGA = WS_UCAT + 40 * MBy;
constexpr size_t WS_QK = WS_SGGA + 64 * MBy;
constexpr size_t WS_VT = WS_QK + 64 * MBy;
constexpr size_t WS_CAT = WS_VT + 32 * MBy;
constexpr size_t WS_SBUF = WS_CAT + 64 * MBy;
constexpr size_t WS_PB = WS_SBUF + 16 * MBy;
constexpr size_t WS_ZB = WS_PB + 32 * MBy;
constexpr size_t WS_END = WS_ZB + 32 * MBy;

struct Params {
    const float *x, *p, *mix_g, *w_in, *a_re, *a_im, *log_dt, *b_re, *b_im, *c_re, *c_im, *dsk, *w_glu, *b_glu, *q_g, *k_g, *w_out, *ple_g, *w_pg, *w_pp;
    float* out; unsigned char* ws;
};

DI int lane_fresh() { int l; asm volatile("v_mbcnt_lo_u32_b32 %0, -1, 0\n\tv_mbcnt_hi_u32_b32 %0, -1, %0" : "=v"(l)); return l; }
DI unsigned cvt_pk_bf16(float lo, float hi) { unsigned r; asm volatile("v_cvt_pk_bf16_f32 %0, %1, %2" : "=v"(r) : "v"(lo), "v"(hi)); return r; }
DI float bf_lo(unsigned w) { return __uint_as_float(w << 16); }
DI float bf_hi(unsigned w) { return __uint_as_float(w & 0xffff0000u); }
DI float fsigmoid(float x) { return __builtin_amdgcn_rcpf(1.0f + __expf(-x)); }
DI float fsilu(float x) { return x * fsigmoid(x); }
DI float fgelu_tanh(float y) { const float u2 = 1.5957691216057308f * (y + 0.044715f * y * y * y); return y * fsigmoid(u2); }

DI int lds_byte(int r, int c) { const int st = (r >> 4) * 2 + (c >> 5), rr = r & 15, cc = c & 31, ob = rr * 64 + cc * 2; return st * 1024 + (ob ^ (((ob >> 9) & 1) << 5)); }
DI void stage_rc(int b, int& R, int& C) { const int st = b / 1024, sb = b % 1024, swz = sb ^ (((sb >> 9) & 1) << 5); R = (st >> 1) * 16 + swz / 64; C = (st & 1) * 32 + (swz % 64) / 2; }

struct Unit { int pm, pn, g; };
struct Gemm { const bf16_t* A; const bf16_t* Bt; int lda, ldb, K; size_t gsA, gsB; };
struct Order {
    int nM, nN, nwg, total, G, c, lim;
    DI void init(int nM_, int nN_, int nG, int G_, int c_) { nM = nM_; nN = nN_; nwg = nM * nN; total = nwg * nG; lim = total; G = G_; c = c_; asm volatile("" : "+s"(c)); }
    DI bool next(int i, Unit& u) const {
        if (nwg < 0) { if (i >= lim) return false; u.g = nM; u.pm = nN; u.pn = i; return true; }
        int L = i * G + c; if (L >= lim) return false;
        if (total > nwg) {
            const int gpx = (total / nwg) >> 3, q = (c >> 3) + (G >> 3) * i; if (q >= gpx * nwg) return false;
            L = ((c & 7) * gpx + q / nwg) * nwg + q % nwg; }
        u.g = L / nwg; int wgid = L - u.g * nwg;
        { const int q = nwg / NXCD, r = nwg % NXCD, xcd = wgid % NXCD, off = wgid / NXCD; wgid = (xcd < r ? xcd * (q + 1) : r * (q + 1) + (xcd - r) * q) + off; }
        const int nig = WGM * nN, gid = wgid / nig, fm = gid * WGM, gsz = (nM - fm) < WGM ? (nM - fm) : WGM;
        u.pm = fm + ((wgid % nig) % gsz); u.pn = (wgid % nig) / gsz; return true;
    }
};

template <class Epi>
DI void gemm_phase(LAS unsigned char* lds, const Gemm g, const Order& S, const Epi& E, const int wid) {
    const int lane = lane_fresh(), tid = wid * 64 + lane, wr = wid >> 2, wc = wid & 3, fr = lane & 15, fq = lane >> 4;
    const int K = g.K, nt = K / BK;
    unsigned voffA[2], voffB[2];
#pragma unroll
    for (int i = 0; i < 2; ++i) { int R, C; stage_rc(tid * 16 + i * 8192, R, C); voffA[i] = (unsigned)(R * g.lda + C) * 2u; voffB[i] = (unsigned)(R * g.ldb + C) * 2u; }
    const size_t kstep = (size_t)(BK * 2);
    const size_t hstepA = (size_t)HALF * g.lda * 2, hstepB = (size_t)HALF * g.ldb * 2;
    const size_t tstepA = 2 * hstepA, tstepB = 2 * hstepB;
    const unsigned ldsw = (unsigned)wid * 1024u;
    const int aoff = lds_byte(wr * 64 + fr, fq * 8), boff = lds_byte(wc * 32 + fr, fq * 8);
#define PG8_SA(b, h) (((b) * 2 + (h)) * HTB)
#define PG8_SB(b, h) ((4 + (b) * 2 + (h)) * HTB)
#define PG8_STAGE(bufoff, gbase, voff) do { _Pragma("unroll") for (int _i = 0; _i < 2; ++_i) \
        __builtin_amdgcn_global_load_lds((const unsigned*)((const char*)(gbase) + (voff)[_i]), (LAS unsigned*)(lds + (bufoff) + ldsw + _i * 8192), 16, 0, 0); } while (0)
#define PG8_LDA(dst, b, h) do { _Pragma("unroll") for (int m = 0; m < 4; ++m) _Pragma("unroll") for (int k = 0; k < 2; ++k) dst[m][k] = *(const LAS bf16x8*)(lds + PG8_SA(b, h) + aoff + m * 2048 + k * 1024); } while (0)
#define PG8_LDB(dst, b, h) do { _Pragma("unroll") for (int n = 0; n < 2; ++n) _Pragma("unroll") for (int k = 0; k < 2; ++k) dst[n][k] = *(const LAS bf16x8*)(lds + PG8_SB(b, h) + boff + n * 2048 + k * 1024); } while (0)
#define PG8_MMA(ai, bj, At, Bt) do { __builtin_amdgcn_s_setprio(1); _Pragma("unroll") for (int m = 0; m < 4; ++m) _Pragma("unroll") for (int n = 0; n < 2; ++n) _Pragma("unroll") for (int k = 0; k < 2; ++k) \
        acc[ai][bj][m][n] = __builtin_amdgcn_mfma_f32_16x16x32_bf16(Bt[n][k], At[m][k], acc[ai][bj][m][n], 0, 0, 0); __builtin_amdgcn_s_setprio(0); } while (0)
#define PG8_WAIT_V(n) asm volatile("s_waitcnt vmcnt(" #n ")" ::: "memory")
#define PG8_WAIT_L(n) asm volatile("s_waitcnt lgkmcnt(" #n ")" ::: "memory")
#define PG8_BAR __builtin_amdgcn_s_barrier()
#define PG8_SCHED __builtin_amdgcn_sched_barrier(0)
    Unit cur, nxt; int ui = 0;
    if (!S.next(0, cur)) return;
    f32x4 acc[2][2][4][2];
#pragma unroll
    for (int a = 0; a < 2; ++a)
#pragma unroll
        for (int b = 0; b < 2; ++b)
#pragma unroll
            for (int m = 0; m < 4; ++m)
#pragma unroll
                for (int n = 0; n < 2; ++n) acc[a][b][m][n] = (f32x4){0.f, 0.f, 0.f, 0.f};
    bf16x8 At[4][2], B0[2][2], B1[2][2];
    const char* cA = (const char*)(g.A + (size_t)cur.g * g.gsA) + (size_t)cur.pm * tstepA;
    const char* cB = (const char*)(g.Bt + (size_t)cur.g * g.gsB) + (size_t)cur.pn * tstepB;
    PG8_STAGE(PG8_SB(0, 0), cB, voffB); PG8_STAGE(PG8_SB(0, 1), cB + hstepB, voffB); PG8_STAGE(PG8_SA(0, 0), cA, voffA); PG8_STAGE(PG8_SA(0, 1), cA + hstepA, voffA);
    if (wr == 1) PG8_BAR;
    PG8_WAIT_V(2); PG8_BAR;
    PG8_STAGE(PG8_SB(1, 0), cB + kstep, voffB); PG8_STAGE(PG8_SA(1, 0), cA + kstep, voffA); PG8_STAGE(PG8_SB(1, 1), cB + hstepB + kstep, voffB);
    PG8_WAIT_V(6); PG8_BAR;
    for (;;) {
        const bool has_next = S.next(ui + 1, nxt);
        const char* nA = has_next ? (const char*)(g.A + (size_t)nxt.g * g.gsA) + (size_t)nxt.pm * tstepA : cA;
        const char* nB = has_next ? (const char*)(g.Bt + (size_t)nxt.g * g.gsB) + (size_t)nxt.pn * tstepB : cB;
        for (int t = 0; t < nt; t += 2) {
            const bool last = (t == nt - 2);
            const char* a1 = cA + (size_t)(t + 1) * kstep;
            const char* a2 = last ? nA : cA + (size_t)(t + 2) * kstep; const char* b2 = last ? nB : cB + (size_t)(t + 2) * kstep;
            const char* a3 = a2 + kstep; const char* b3 = b2 + kstep;
            if (t == nt - 4) E.prefetch(cur, lds, wid);
            PG8_LDB(B0, 0, 0); PG8_LDB(B1, 0, 1); PG8_SCHED; PG8_LDA(At, 0, 0); PG8_STAGE(PG8_SA(1, 1), a1 + hstepA, voffA);
            PG8_WAIT_V(8); PG8_WAIT_L(0); PG8_BAR; PG8_MMA(0, 0, At, B0); PG8_MMA(0, 1, At, B1); PG8_BAR; PG8_SCHED;
            PG8_LDA(At, 0, 1); PG8_STAGE(PG8_SB(0, 0), b2, voffB); PG8_STAGE(PG8_SB(0, 1), b2 + hstepB, voffB); PG8_STAGE(PG8_SA(0, 0), a2, voffA);
            PG8_WAIT_V(8); PG8_WAIT_L(0); PG8_BAR; PG8_MMA(1, 0, At, B0); PG8_MMA(1, 1, At, B1); PG8_BAR; PG8_SCHED;
            PG8_LDB(B0, 1, 0); PG8_LDB(B1, 1, 1); PG8_SCHED; PG8_LDA(At, 1, 0); PG8_STAGE(PG8_SA(0, 1), a2 + hstepA, voffA);
            PG8_WAIT_V(8); PG8_WAIT_L(0); PG8_BAR; PG8_MMA(0, 0, At, B0); PG8_MMA(0, 1, At, B1); PG8_BAR; PG8_SCHED;
            PG8_LDA(At, 1, 1); PG8_STAGE(PG8_SB(1, 0), b3, voffB); PG8_STAGE(PG8_SB(1, 1), b3 + hstepB, voffB); PG8_STAGE(PG8_SA(1, 0), a3, voffA);
            PG8_WAIT_V(8); PG8_WAIT_L(0); PG8_BAR; PG8_MMA(1, 0, At, B0); PG8_MMA(1, 1, At, B1); PG8_BAR; PG8_SCHED;
        }
        if (wr == 0) PG8_BAR;
        { const int le = lane_fresh(); E(acc, cur, wr, wc, le & 15, le >> 4); }
        if (!has_next) break;
#pragma unroll
        for (int a = 0; a < 2; ++a)
#pragma unroll
            for (int b = 0; b < 2; ++b)
#pragma unroll
                for (int m = 0; m < 4; ++m)
#pragma unroll
                    for (int n = 0; n < 2; ++n) acc[a][b][m][n] = (f32x4){0.f, 0.f, 0.f, 0.f};
        cur = nxt; cA = nA; cB = nB; ++ui;
        if (wr == 1) PG8_BAR;
    }
    PG8_WAIT_V(0);
    PG8_BAR;
#undef PG8_SA
#undef PG8_SB
#undef PG8_STAGE
#undef PG8_LDA
#undef PG8_LDB
#undef PG8_MMA
#undef PG8_WAIT_V
#undef PG8_WAIT_L
#undef PG8_BAR
#undef PG8_SCHED
}

#define EPI_ROWS _Pragma("unroll") for (int ai = 0; ai < 2; ++ai) _Pragma("unroll") for (int m = 0; m < 4; ++m) if ((__extension__({ if ((m & 1) == 0) asm volatile("" ::: "memory"); 1; })))
#define EPI_ROWS_NF _Pragma("unroll") for (int ai = 0; ai < 2; ++ai) _Pragma("unroll") for (int m = 0; m < 4; ++m)
#define EPI_COLS _Pragma("unroll") for (int bj = 0; bj < 2; ++bj) _Pragma("unroll") for (int n = 0; n < 2; ++n)

struct EpiIn {
    DI void prefetch(const Unit& u, LAS unsigned char* lds, int wid) const {
        if (wid < 4) __builtin_amdgcn_global_load_lds((const unsigned*)(ss + u.pm * BM + wid * 64 + lane_fresh()), (LAS unsigned*)(lds + LDS_DUMMY + wid * 256), 4, 0, 0);
    }
    const float* ss; bf16_t *Ucat, *SG, *GA, *Q, *Kb, *VT; const float *qg, *kg;
    DI void operator()(const f32x4 (&acc)[2][2][4][2], const Unit& u, int wr, int wc, int fr, int fq) const {
        const int type = u.pn >> 1, hf = u.pn & 1;
        float rsv[2][4];
        EPI_ROWS_NF rsv[ai][m] = ss[u.pm * BM + ai * HALF + wr * 64 + m * 16 + fr];
        EPI_ROWS_NF rsv[ai][m] = rsqrtf(rsv[ai][m] * (1.f / 1024.f) + 1e-6f);
        if (type == 0) {
            EPI_ROWS_NF { const int row = u.pm * BM + ai * HALF + wr * 64 + m * 16 + fr; const float rs = rsv[ai][m];
                EPI_COLS { const f32x4 v = acc[ai][bj][m][n] * rs; const int g = 16 * hf + 4 * wc + 2 * bj + n;
                    u32x2 w; w.x = cvt_pk_bf16(v[0], v[1]); w.y = cvt_pk_bf16(v[2], v[3]);
                    *(u32x2*)(Ucat + ((size_t)(g * 1024 + (row >> 5)) * 640 + (row & 31) * 16 + 4 * fq)) = w; } }
        } else if (type == 1 || type == 5) {
            bf16_t* dst = type == 1 ? SG : GA;
            EPI_ROWS_NF { const int row = u.pm * BM + ai * HALF + wr * 64 + m * 16 + fr; const float rs = rsv[ai][m];
                EPI_COLS { const f32x4 v = acc[ai][bj][m][n] * rs; const int cs = 256 * hf + 64 * wc + 32 * bj + 16 * n + 4 * fq;
                    u32x2 w; w.x = cvt_pk_bf16(fsilu(v[0]), fsilu(v[1])); w.y = cvt_pk_bf16(fsilu(v[2]), fsilu(v[3]));
                    *(u32x2*)(dst + (size_t)row * 512 + cs) = w; } }
        } else if (type == 2 || type == 3) {
            bf16_t* dst = type == 2 ? Q : Kb; const float* gam = type == 2 ? qg : kg; const float sc = type == 2 ? 0.125f : 1.0f;
            f32x4 gv[2][2];
            EPI_COLS gv[bj][n] = *(const f32x4*)(gam + 32 * bj + 16 * n + 4 * fq) * sc;
            EPI_ROWS_NF { const int row = u.pm * BM + ai * HALF + wr * 64 + m * 16 + fr; const float rs = rsv[ai][m];
                f32x4 v[2][2]; float s = 0.f;
                EPI_COLS { v[bj][n] = acc[ai][bj][m][n] * rs; s += (v[bj][n][0] * v[bj][n][0] + v[bj][n][1] * v[bj][n][1]) + (v[bj][n][2] * v[bj][n][2] + v[bj][n][3] * v[bj][n][3]); }
                s += __shfl_xor(s, 16); s += __shfl_xor(s, 32);
                const float ri = rsqrtf(s * (1.f / 64.f) + 1e-6f);
                EPI_COLS { const f32x4 o = v[bj][n] * ri * gv[bj][n]; const int cs = 256 * hf + 64 * wc + 32 * bj + 16 * n + 4 * fq;
                    u32x2 w; w.x = cvt_pk_bf16(o[0], o[1]); w.y = cvt_pk_bf16(o[2], o[3]);
                    if (type == 2) *(u32x2*)(dst + (size_t)row * 512 + cs) = w;
                    else {
                        const int key = row & 4095;
                        *(u32x2*)(dst + (((size_t)((row >> 12) * 8 + 4 * hf + wc)) << 18) + (key >> 5) * 2048 + (2 * bj + n) * 512 + (key & 31) * 16 + 4 * fq) = w; } } }
        } else {
            EPI_ROWS_NF { const int row = u.pm * BM + ai * HALF + wr * 64 + m * 16 + fr; const float rs = rsv[ai][m];
                const int b = row >> 12, s = row & 4095, head = 4 * hf + wc;
                EPI_COLS { const f32x4 v = acc[ai][bj][m][n] * rs; const int d = 32 * bj + 16 * n + 4 * fq;
                    const unsigned w0 = cvt_pk_bf16(v[0], v[1]), w1 = cvt_pk_bf16(v[2], v[3]);
                    bf16_t* o = VT + (((size_t)(b * 8 + head)) << 18) + (s >> 5) * 2048 + bj * 1024 + ((s >> 4) & 1) * 512 + (16 * n + 4 * fq) * 16 + (s & 15);
                    (void)d; o[0] = (bf16_t)(w0 & 0xffffu); o[16] = (bf16_t)(w0 >> 16); o[32] = (bf16_t)(w1 & 0xffffu); o[48] = (bf16_t)(w1 >> 16); } }
        }
    }
};
struct EpiS {
    DI void prefetch(const Unit&, LAS unsigned char*, int) const {}
    float* Sbuf;
    DI void operator()(const f32x4 (&acc)[2][2][4][2], const Unit& u, int wr, int wc, int fr, int fq) const {
        EPI_ROWS { const int R = u.pm * BM + ai * HALF + wr * 64 + m * 16 + fr;
#pragma unroll
            for (int n = 0; n < 2; ++n) *(f32x4*)(Sbuf + ((size_t)(u.g * 1024 + R) * 128 + 32 * wc + 16 * n + 4 * fq)) = acc[ai][0][m][n]; }
    }
};
struct EpiY {
    DI void prefetch(const Unit&, LAS unsigned char*, int) const {}
    const bf16_t* Ucat; const float* dsk; bf16_t* zb;
    DI void operator()(const f32x4 (&acc)[2][2][4][2], const Unit& u, int wr, int wc, int fr, int fq) const {
        const f32x4 dv = *(const f32x4*)(dsk + u.g * 16 + 4 * fq);
        EPI_ROWS { const int R = u.pm * BM + ai * HALF + wr * 64 + m * 16 + fr;
            EPI_COLS { const int ncol = u.pn * BM + bj * HALF + 32 * wc + 16 * n + 4 * fq;
                const u32x2 ub = *(const u32x2*)(Ucat + ((size_t)(u.g * 1024 + R) * 640 + ncol));
                f32x4 y = acc[ai][bj][m][n];
                y[0] += dv[0] * bf_lo(ub.x); y[1] += dv[1] * bf_hi(ub.x); y[2] += dv[2] * bf_lo(ub.y); y[3] += dv[3] * bf_hi(ub.y);
                u32x2 w; w.x = cvt_pk_bf16(fgelu_tanh(y[0]), fgelu_tanh(y[1])); w.y = cvt_pk_bf16(fgelu_tanh(y[2]), fgelu_tanh(y[3]));
                const int token = R * 32 + (ncol >> 4);
                *(u32x2*)(zb + (size_t)token * 512 + u.g * 16 + 4 * fq) = w; } }
    }
};
struct EpiGlu {
    DI void prefetch(const Unit& u, LAS unsigned char* lds, int wid) const {
        const int id = wid * 64 + lane_fresh(), row = id >> 1, seg = id & 1;
        __builtin_amdgcn_global_load_lds((const unsigned*)(SG + (size_t)(u.pm * BM + row) * 512 + u.pn * 128 + seg * 64), (LAS unsigned*)(lds + LDS_DUMMY + wid * 256), 4, 0, 0);
    }
    const float* bglu; const bf16_t* SG; bf16_t* cat;
    DI void operator()(const f32x4 (&acc)[2][2][4][2], const Unit& u, int wr, int wc, int fr, int fq) const {
        f32x4 bv[2], bg[2];
#pragma unroll
        for (int n = 0; n < 2; ++n) { const int ch = u.pn * 128 + 32 * wc + 16 * n + 4 * fq; bv[n] = *(const f32x4*)(bglu + ch); bg[n] = *(const f32x4*)(bglu + 512 + ch); }
        EPI_ROWS { const int row = u.pm * BM + ai * HALF + wr * 64 + m * 16 + fr;
#pragma unroll
            for (int n = 0; n < 2; ++n) { const int ch = u.pn * 128 + 32 * wc + 16 * n + 4 * fq;
                const f32x4 val = acc[ai][0][m][n] + bv[n], gt = acc[ai][1][m][n] + bg[n];
                const u32x2 sg = *(const u32x2*)(SG + (size_t)row * 512 + ch);
                const float o0 = val[0] * fsigmoid(gt[0]) * bf_lo(sg.x), o1 = val[1] * fsigmoid(gt[1]) * bf_hi(sg.x), o2 = val[2] * fsigmoid(gt[2]) * bf_lo(sg.y), o3 = val[3] * fsigmoid(gt[3]) * bf_hi(sg.y);
                u32x2 w; w.x = cvt_pk_bf16(o0, o1); w.y = cvt_pk_bf16(o2, o3);
                *(u32x2*)(cat + (size_t)row * 1024 + ch) = w; } }
    }
};
struct EpiOut {
    DI void prefetch(const Unit& u, LAS unsigned char* lds, int wid) const {
        const int tid = wid * 64 + lane_fresh();
#pragma unroll
        for (int i = 0; i < 2; ++i) { const int id = tid + 512 * i, row = id >> 2, seg = id & 3;
            __builtin_amdgcn_global_load_lds((const unsigned*)(hin + (size_t)(u.pm * BM + row) * 1024 + u.pn * BM + seg * 64), (LAS unsigned*)(lds + LDS_DUMMY + wid * 256), 4, 0, 0); }
    }
    const bf16_t* hin; bf16_t* hb; float* ss;
    DI void operator()(const f32x4 (&acc)[2][2][4][2], const Unit& u, int wr, int wc, int fr, int fq) const {
        EPI_ROWS { const int row = u.pm * BM + ai * HALF + wr * 64 + m * 16 + fr; float s = 0.f;
            EPI_COLS { const size_t off = (size_t)row * 1024 + u.pn * BM + bj * HALF + 32 * wc + 16 * n + 4 * fq;
                const u32x2 rw = *(const u32x2*)(hin + off); f32x4 hv = acc[ai][bj][m][n];
                hv[0] += bf_lo(rw.x); hv[1] += bf_hi(rw.x); hv[2] += bf_lo(rw.y); hv[3] += bf_hi(rw.y);
                u32x2 w; w.x = cvt_pk_bf16(hv[0], hv[1]); w.y = cvt_pk_bf16(hv[2], hv[3]); *(u32x2*)(hb + off) = w;
                s += (hv[0] * hv[0] + hv[1] * hv[1]) + (hv[2] * hv[2] + hv[3] * hv[3]); }
            s += __shfl_xor(s, 16); s += __shfl_xor(s, 32);
            if (fq == 0) atomicAdd(ss + row, s); }
    }
};
struct EpiPle {
    DI void prefetch(const Unit& u, LAS unsigned char* lds, int wid) const {
        const int tid = wid * 64 + lane_fresh();
#pragma unroll
        for (int i = 0; i < 2; ++i) { const int id = tid + 512 * i, row = id >> 2, seg = id & 3; const size_t off = (size_t)(u.pm * BM + row) * 1024 + u.pn * BM + seg * 64;
            __builtin_amdgcn_global_load_lds((const unsigned*)(h1 + off), (LAS unsigned*)(lds + LDS_DUMMY + wid * 256), 4, 0, 0);
            __builtin_amdgcn_global_load_lds((const unsigned*)(pp + off), (LAS unsigned*)(lds + LDS_DUMMY + wid * 256), 4, 0, 0); }
        if (wid < 4) __builtin_amdgcn_global_load_lds((const unsigned*)(ss1 + u.pm * BM + tid), (LAS unsigned*)(lds + LDS_DUMMY + wid * 256), 4, 0, 0);
    }
    const float* ss1; const bf16_t* h1; float* h; const bf16_t* pp; bf16_t* hb; float* ss2; int last;
    DI void operator()(const f32x4 (&acc)[2][2][4][2], const Unit& u, int wr, int wc, int fr, int fq) const {
        float rsv[2][4];
        EPI_ROWS_NF rsv[ai][m] = ss1[u.pm * BM + ai * HALF + wr * 64 + m * 16 + fr];
        EPI_ROWS_NF rsv[ai][m] = rsqrtf(rsv[ai][m] * (1.f / 1024.f) + 1e-6f);
        EPI_ROWS { const int row = u.pm * BM + ai * HALF + wr * 64 + m * 16 + fr; float s = 0.f;
            const float rs = rsv[ai][m];
            EPI_COLS { const size_t off = (size_t)row * 1024 + u.pn * BM + bj * HALF + 32 * wc + 16 * n + 4 * fq;
                const f32x4 a = acc[ai][bj][m][n] * rs; const u32x2 pw = *(const u32x2*)(pp + off); const u32x2 hw = *(const u32x2*)(h1 + off);
                f32x4 hv;
                hv[0] = bf_lo(hw.x) + fsigmoid(a[0]) * bf_lo(pw.x); hv[1] = bf_hi(hw.x) + fsigmoid(a[1]) * bf_hi(pw.x); hv[2] = bf_lo(hw.y) + fsigmoid(a[2]) * bf_lo(pw.y); hv[3] = bf_hi(hw.y) + fsigmoid(a[3]) * bf_hi(pw.y);
                if (last) *(f32x4*)(h + off) = hv;
                if (!last) { u32x2 w; w.x = cvt_pk_bf16(hv[0], hv[1]); w.y = cvt_pk_bf16(hv[2], hv[3]); *(u32x2*)(hb + off) = w;
                    s += (hv[0] * hv[0] + hv[1] * hv[1]) + (hv[2] * hv[2] + hv[3] * hv[3]); } }
            if (!last) { s += __shfl_xor(s, 16); s += __shfl_xor(s, 32); if (fq == 0) atomicAdd(ss2 + row, s); } }
    }
};
struct EpiPP {
    DI void prefetch(const Unit&, LAS unsigned char*, int) const {}
    bf16_t* pp;
    DI void operator()(const f32x4 (&acc)[2][2][4][2], const Unit& u, int wr, int wc, int fr, int fq) const {
        EPI_ROWS { const int row = u.pm * BM + ai * HALF + wr * 64 + m * 16 + fr;
            EPI_COLS { const size_t off = (size_t)row * 1024 + u.pn * BM + bj * HALF + 32 * wc + 16 * n + 4 * fq; const f32x4 a = acc[ai][bj][m][n] * 1.0f;
                u32x2 w; w.x = cvt_pk_bf16(a[0], a[1]); w.y = cvt_pk_bf16(a[2], a[3]); *(u32x2*)(pp + off) = w; } }
    }
};

DI void attn_item(int item, const bf16_t* Q, const bf16_t* Kb, const bf16_t* VT, const bf16_t* GA, bf16_t* cat, int lane) {
    const int qb = item & 127, h = (item >> 7) & 7, b = item >> 10;
    const int q0 = qb * 32, hf = lane >> 5, ql = lane & 31;
    const bf16_t* qp = Q + (size_t)(b * SEQ + q0 + ql) * 512 + h * 64 + 8 * hf;
    bf16x8 qf[4];
#pragma unroll
    for (int s = 0; s < 4; ++s) qf[s] = *(const bf16x8*)(qp + 16 * s);
    const int kperm = (ql & 16) | ((ql & 4) << 1) | ((ql & 8) >> 1) | (ql & 3);
    const bf16_t* kbase = Kb + (((size_t)(b * 8 + h)) << 18) + kperm * 16 + 8 * hf;
    const bf16_t* vbase = VT + (((size_t)(b * 8 + h)) << 18) + ql * 16 + 8 * hf;
    f32x16 o0, o1;
#pragma unroll
    for (int i = 0; i < 16; ++i) { o0[i] = 0.f; o1[i] = 0.f; }
    float cprod = 1.f;
    bf16x8 kf[4], vf[2][2];
    { const bf16_t* kp = kbase + (size_t)(q0 >> 5) * 2048; const bf16_t* vp = vbase + (size_t)(q0 >> 5) * 2048;
#pragma unroll
      for (int s = 0; s < 4; ++s) kf[s] = *(const bf16x8*)(kp + 512 * s);
#pragma unroll
      for (int s = 0; s < 2; ++s) { vf[s][0] = *(const bf16x8*)(vp + 512 * s); vf[s][1] = *(const bf16x8*)(vp + 1024 + 512 * s); } }
#define ATT_TILE(DIAG) { \
        f32x16 st; _Pragma("unroll") for (int i = 0; i < 16; ++i) st[i] = 0.f; \
        _Pragma("unroll") for (int s = 0; s < 4; ++s) st = __builtin_amdgcn_mfma_f32_32x32x16_bf16(kf[s], qf[s], st, 0, 0, 0); \
        const int kn = kb >= 32 ? kb - 32 : 0; const bf16_t* kp = kbase + (size_t)(kn >> 5) * 2048; const bf16_t* vp = vbase + (size_t)(kn >> 5) * 2048; \
        bf16x8 kf2[4], vf2[2][2]; \
        _Pragma("unroll") for (int s = 0; s < 4; ++s) kf2[s] = *(const bf16x8*)(kp + 512 * s); \
        _Pragma("unroll") for (int s = 0; s < 2; ++s) { vf2[s][0] = *(const bf16x8*)(vp + 512 * s); vf2[s][1] = *(const bf16x8*)(vp + 1024 + 512 * s); } \
        float sg[16], ns[16]; float PA = 1.f, PB = 1.f; \
        _Pragma("unroll") for (int r = 0; r < 16; ++r) { \
            const float t = st[r] * -1.4426950408889634f; \
            const float e = __builtin_amdgcn_exp2f(fminf(t, 115.0f));        \
            float sgm = __builtin_amdgcn_rcpf(1.0f + e);                     \
            float nsv = e * sgm;                                             \
            if (DIAG) { const int koff = 16 * (r >> 3) + 8 * hf + (r & 7); if (koff >= ql) { sgm = 0.f; nsv = 1.f; } } \
            sg[r] = sgm; ns[r] = nsv; if (r < 8) PA *= nsv; else PB *= nsv; } \
        const float PAo = __shfl_xor(PA, 32), PBo = __shfl_xor(PB, 32); \
        float runA = cprod * (PB * PBo) * (hf == 0 ? PAo : 1.f); float runB = cprod * (hf == 0 ? PBo : 1.f); \
        float w[16]; \
        _Pragma("unroll") for (int r = 7; r >= 0; --r) { w[r] = sg[r] * runA; runA *= ns[r]; } \
        _Pragma("unroll") for (int r = 15; r >= 8; --r) { w[r] = sg[r] * runB; runB *= ns[r]; } \
        cprod *= (PA * PAo) * (PB * PBo); \
        _Pragma("unroll") for (int s = 0; s < 2; ++s) { \
            u32x4 pw; pw.x = cvt_pk_bf16(w[8 * s], w[8 * s + 1]); pw.y = cvt_pk_bf16(w[8 * s + 2], w[8 * s + 3]); pw.z = cvt_pk_bf16(w[8 * s + 4], w[8 * s + 5]); pw.w = cvt_pk_bf16(w[8 * s + 6], w[8 * s + 7]); \
            const bf16x8 wf = __builtin_bit_cast(bf16x8, pw); \
            o0 = __builtin_amdgcn_mfma_f32_32x32x16_bf16(wf, vf[s][0], o0, 0, 0, 0); \
            o1 = __builtin_amdgcn_mfma_f32_32x32x16_bf16(wf, vf[s][1], o1, 0, 0, 0); } \
        _Pragma("unroll") for (int s = 0; s < 4; ++s) kf[s] = kf2[s]; \
        _Pragma("unroll") for (int s = 0; s < 2; ++s) { vf[s][0] = vf2[s][0]; vf[s][1] = vf2[s][1]; } \
        kb -= 32; }
    { int kb = q0;
      ATT_TILE(true)
      if (kb >= 0 && !__all(cprod < 1.17549435e-38f)) {
          _Pragma("nounroll") for (;;) { ATT_TILE(false) if (kb < 0 || __all(cprod < 1.17549435e-38f)) break; } } }
#undef ATT_TILE
#pragma unroll
    for (int r = 0; r < 16; ++r) {
        const size_t tok = (size_t)(b * SEQ + q0 + 8 * (r >> 2) + 4 * hf + (r & 3));
        const float g0 = __uint_as_float((unsigned)GA[tok * 512 + h * 64 + ql] << 16), g1 = __uint_as_float((unsigned)GA[tok * 512 + h * 64 + 32 + ql] << 16);
        const unsigned w = cvt_pk_bf16(o0[r] * g0, o1[r] * g1);
        cat[tok * 1024 + 512 + h * 64 + ql] = (bf16_t)(w & 0xffffu);
        cat[tok * 1024 + 512 + h * 64 + 32 + ql] = (bf16_t)(w >> 16);
    }
}

DI void sincos_d(double ang, double& s, double& c) {
    const double k = rint(ang * 0.63661977236758134308);
    double y = fma(-k, 1.5707963267948966192, ang); y = fma(-k, 6.123233995736766e-17, y);
    const double y2 = y * y;
    const double sp = y * (1.0 - y2 * (1.0 / 6.0) * (1.0 - y2 * (1.0 / 20.0) * (1.0 - y2 * (1.0 / 42.0) * (1.0 - y2 * (1.0 / 72.0) * (1.0 - y2 * (1.0 / 110.0) * (1.0 - y2 * (1.0 / 156.0) * (1.0 - y2 * (1.0 / 210.0) * (1.0 - y2 * (1.0 / 272.0)))))))));
    const double cp = 1.0 - y2 * (1.0 / 2.0) * (1.0 - y2 * (1.0 / 12.0) * (1.0 - y2 * (1.0 / 30.0) * (1.0 - y2 * (1.0 / 56.0) * (1.0 - y2 * (1.0 / 90.0) * (1.0 - y2 * (1.0 / 132.0) * (1.0 - y2 * (1.0 / 182.0) * (1.0 - y2 * (1.0 / 240.0))))))));
    const int q = (int)((long long)k & 3);
    s = (q == 0) ? sp : (q == 1) ? cp : (q == 2) ? -sp : -cp;
    c = (q == 0) ? cp : (q == 1) ? -sp : (q == 2) ? -cp : sp;
}
DI double exp_d(double x) {
    const double k = rint(x * 1.4426950408889634074); const double r = fma(-k, 0.69314718055994530942, x);
    double t = 1.0;
#pragma unroll
    for (int i = 14; i >= 1; --i) t = 1.0 + t * r * (1.0 / (double)i);
    return ldexp(t, (int)k);
}

template <int MODE>
DI int colmap(int n) {
    if (MODE == 1) { const int pn = n >> 8, r = n & 255, bj = r >> 7, wc = (r >> 5) & 3, c = r & 31; return 256 * pn + 64 * wc + 32 * bj + c; }
    if (MODE == 2) { const int pn = n >> 8, r = n & 255; return r < 128 ? 128 * pn + r : 512 + 128 * pn + (r - 128); }
    return n;
}
template <int MODE>
DI void transpose_w(const float* W, int K, int N, bf16_t* WT, const float* kscale, LAS float* scr, int gw, int nw, int lane) {
    const int nblk = N >> 5, items = (K >> 6) * nblk;
    for (int item = gw; item < items; item += nw) {
        const int kb = item / nblk, nb = item - kb * nblk, k0 = 64 * kb, n0 = 32 * nb, col0 = colmap<MODE>(n0);
        float tv[32];
#pragma unroll
        for (int i = 0; i < 32; ++i) { const int kk = 2 * i + (lane >> 5); tv[i] = W[(size_t)(k0 + kk) * N + col0 + (lane & 31)]; }
        if (kscale) {
#pragma unroll
            for (int i = 0; i < 32; ++i) tv[i] *= kscale[k0 + 2 * i + (lane >> 5)]; }
#pragma unroll
        for (int i = 0; i < 32; ++i) { const int kk = 2 * i + (lane >> 5); scr[kk * 33 + (lane & 31)] = tv[i]; }
        asm volatile("s_waitcnt lgkmcnt(0)" ::: "memory");
        const int cc = lane & 7;
#pragma unroll
        for (int j = 0; j < 4; ++j) { const int n = (lane >> 3) + 8 * j; const LAS float* sp = scr + (8 * cc) * 33 + n;
            u32x4 o; o.x = cvt_pk_bf16(sp[0 * 33], sp[1 * 33]); o.y = cvt_pk_bf16(sp[2 * 33], sp[3 * 33]); o.z = cvt_pk_bf16(sp[4 * 33], sp[5 * 33]); o.w = cvt_pk_bf16(sp[6 * 33], sp[7 * 33]);
            *(u32x4*)(WT + (size_t)(n0 + n) * K + k0 + 8 * cc) = o; }
        asm volatile("s_waitcnt lgkmcnt(0)" ::: "memory");
    }
}

DI void ssm_prep(const Params& P, int lg, int qd, LAS unsigned char* lds, int tid) {
    LAS float* apr = (LAS float*)lds;
    LAS float* api = apr + 33 * 64;
    LAS float* bbr = api + 33 * 64;
    LAS float* bbi = bbr + 1024;
    LAS float* cr = bbi + 1024;
    LAS float* ci = cr + 1024;
    LAS float* ktab = ci + 1024;
    LAS float* part = ktab + 8192;
    LAS double* fz = (LAS double*)(part + 8192);
    const double dt = exp_d((double)P.log_dt[lg]);
    for (int idx = tid; idx < 33 * 64; idx += 512) {
        const int tau = idx >> 6, p = idx & 63;
        const double lr = (double)P.a_re[lg * 64 + p], li = (double)P.a_im[lg * 64 + p];
        const double mag = exp_d(lr * dt * (double)tau); double s, c; sincos_d(li * dt * (double)tau, s, c);
        apr[idx] = (float)(mag * c); api[idx] = (float)(mag * s);
        if (tau == 32 && qd == 0) { float* a32 = (float*)(P.ws + WS_MISC) + (size_t)(lg * 64 + p) * 2; a32[0] = (float)(mag * c); a32[1] = (float)(mag * s); }
        if (tau == 1) {
            const double nr = mag * c - 1.0, ni = mag * s, den = lr * lr + li * li;
            fz[2 * p] = (nr * lr + ni * li) / den; fz[2 * p + 1] = (ni * lr - nr * li) / den; }
    }
    for (int idx = tid; idx < 1024; idx += 512) { cr[idx] = P.c_re[(size_t)lg * 1024 + idx]; ci[idx] = P.c_im[(size_t)lg * 1024 + idx]; }
    __syncthreads();
    for (int idx = tid; idx < 1024; idx += 512) { const int p = idx >> 4; const double fr_ = fz[2 * p], fi_ = fz[2 * p + 1];
        const double br = (double)P.b_re[(size_t)lg * 1024 + idx], bi = (double)P.b_im[(size_t)lg * 1024 + idx];
        bbr[idx] = (float)(fr_ * br - fi_ * bi); bbi[idx] = (float)(fr_ * bi + fi_ * br); }
    __syncthreads();
    {
        const int hh = tid & 255, hp = hh >> 4, h = hh & 15, ph = tid >> 8;
        float cbr[32], cbi[32];
#pragma unroll
        for (int i = 0; i < 32; ++i) { const int p = 32 * ph + i; const float c_r = cr[h * 64 + p], c_i = ci[h * 64 + p], x_r = bbr[p * 16 + hp], x_i = bbi[p * 16 + hp];
            cbr[i] = c_r * x_r - c_i * x_i; cbi[i] = c_r * x_i + c_i * x_r; }
        for (int tau = 0; tau < 32; ++tau) { float acc = 0.f;
#pragma unroll
            for (int i = 0; i < 32; ++i) acc += apr[tau * 64 + 32 * ph + i] * cbr[i] - api[tau * 64 + 32 * ph + i] * cbi[i];
            if (ph) part[tau * 256 + hh] = acc; else ktab[tau * 256 + hh] = acc; }
    }
    __syncthreads();
    for (int o = tid; o < 8192; o += 512) ktab[o] += part[o];
    __syncthreads();
    bf16_t* W1 = (bf16_t*)(P.ws + WS_W1) + (size_t)lg * 256 * 512;
    for (int it = tid; it < 128 * 64; it += 512) {
        const int n = 128 * qd + (it >> 6), k8 = it & 63, s = k8 >> 1, hp0 = (k8 & 1) * 8; float v[8];
#pragma unroll
        for (int i = 0; i < 8; ++i) {
            if (n < 128) { const int p = n & 63; const float ar = apr[(31 - s) * 64 + p], ai = api[(31 - s) * 64 + p], xr = bbr[p * 16 + hp0 + i], xi = bbi[p * 16 + hp0 + i];
                v[i] = n < 64 ? ar * xr - ai * xi : ar * xi + ai * xr; }
            else v[i] = 0.f;
        }
        u32x4 o; o.x = cvt_pk_bf16(v[0], v[1]); o.y = cvt_pk_bf16(v[2], v[3]); o.z = cvt_pk_bf16(v[4], v[5]); o.w = cvt_pk_bf16(v[6], v[7]);
        *(u32x4*)(W1 + (size_t)n * 512 + k8 * 8) = o;
    }
    bf16_t* TP = (bf16_t*)(P.ws + WS_TOEP) + (size_t)lg * 512 * 640;
    for (int it = tid; it < 256 * 80; it += 512) {
        const int n = 256 * qd + it / 80, k8 = it % 80, t = n >> 4, h = n & 15; float v[8];
        if (k8 < 64) { const int s = k8 >> 1, hp0 = (k8 & 1) * 8;
#pragma unroll
            for (int i = 0; i < 8; ++i) v[i] = (s <= t) ? ktab[(t - s) * 256 + (hp0 + i) * 16 + h] : 0.f;
        } else if (k8 < 72) {
#pragma unroll
            for (int i = 0; i < 8; ++i) { const int p = (k8 - 64) * 8 + i; v[i] = cr[h * 64 + p] * apr[(t + 1) * 64 + p] - ci[h * 64 + p] * api[(t + 1) * 64 + p]; }
        } else {
#pragma unroll
            for (int i = 0; i < 8; ++i) { const int p = (k8 - 72) * 8 + i; v[i] = -(cr[h * 64 + p] * api[(t + 1) * 64 + p] + ci[h * 64 + p] * apr[(t + 1) * 64 + p]); }
        }
        u32x4 o; o.x = cvt_pk_bf16(v[0], v[1]); o.y = cvt_pk_bf16(v[2], v[3]); o.z = cvt_pk_bf16(v[4], v[5]); o.w = cvt_pk_bf16(v[6], v[7]);
        *(u32x4*)(TP + (size_t)n * 640 + k8 * 8) = o;
    }
    __syncthreads();
}

#define XB_TMO      128
#define XB_XCNT(j)  (256  + 64 * (j))
#define XB_XSUB(j)  (1280 + 64 * (j))
#define XB_XGEN(j)  (2304 + 64 * (j))
#define XB_TOP      3328
#define XB_TOPGEN   3392
#define XCD_BAR_WORDS 3456
#define XB_SPIN_CAP (1u << 18)
DI unsigned xb_ld(unsigned* p) { return __hip_atomic_load(p, __ATOMIC_RELAXED, __HIP_MEMORY_SCOPE_AGENT); }
DI unsigned xb_add(unsigned* p, unsigned v) { return __hip_atomic_fetch_add(p, v, __ATOMIC_RELAXED, __HIP_MEMORY_SCOPE_AGENT); }
DI unsigned xb_xcc_id() { return (unsigned)__builtin_amdgcn_s_getreg((3 << 11) | 20) & 0xFu; }
#define XB_SPIN(cond, bar) do { unsigned _sp = 0; while (cond) { __builtin_amdgcn_s_sleep(1); \
    if ((++_sp & 255u) == 0u) { if (xb_ld(&(bar)[XB_TMO])) break; if (_sp > XB_SPIN_CAP) { atomicAdd(&(bar)[XB_TMO], 1u); break; } } } } while (0)
DI void xcd_barrier_complete(unsigned* bar, unsigned x, unsigned G, unsigned& nloc, unsigned& nx) {
    unsigned sum, cnt, mine, sp = 0u;
    for (;;) {
        sum = 0u; cnt = 0u; mine = 0u;
#pragma unroll 1
        for (unsigned j = 0; j < 16; ++j) { const unsigned cj = xb_ld(&bar[XB_XCNT(j)]); sum += cj; cnt += (cj > 0u) ? 1u : 0u; mine = (j == x) ? cj : mine; }
        if (sum == G) break;
        __builtin_amdgcn_s_sleep(1);
        if ((++sp & 255u) == 0u) { if (xb_ld(&bar[XB_TMO])) break; if (sp > XB_SPIN_CAP) { atomicAdd(&bar[XB_TMO], 1u); break; } }
    }
    nloc = mine > 0u ? mine : 1u; nx = cnt > 0u ? cnt : 1u;
}
DI void xcd_barrier(unsigned* bar, volatile LAS unsigned* st, const int wid) {
    asm volatile("" : "+s"(bar));
    asm volatile("s_waitcnt vmcnt(0)" ::: "memory");
    __syncthreads();
    if (wid == 0 && lane_fresh() == 0) {
        const unsigned x = xb_xcc_id();
        __builtin_amdgcn_s_waitcnt(0);
        const unsigned nloc = st[0], nx = st[1];
        const unsigned old = xb_add(&bar[XB_XSUB(x)], 1u);
        const unsigned gen = old / nloc;
        if (old + 1u == (gen + 1u) * nloc) {
            __builtin_amdgcn_fence(__ATOMIC_RELEASE, "agent");
            asm volatile("s_waitcnt vmcnt(0)" ::: "memory");
            const unsigned og = xb_add(&bar[XB_TOP], 1u);
            const unsigned tg = og / nx;
            if (og + 1u == (tg + 1u) * nx) xb_add(&bar[XB_TOPGEN], 1u);
            else XB_SPIN(xb_ld(&bar[XB_TOPGEN]) == tg, bar);
            __builtin_amdgcn_fence(__ATOMIC_ACQUIRE, "agent");
            xb_add(&bar[XB_XGEN(x)], 1u);
            asm volatile("s_waitcnt vmcnt(0)" ::: "memory");
        } else {
            XB_SPIN(xb_ld(&bar[XB_XGEN(x)]) == gen, bar);
            __builtin_amdgcn_fence(__ATOMIC_ACQUIRE, "agent");
            asm volatile("s_waitcnt vmcnt(0)" ::: "memory");
        }
    }
    __syncthreads();
}

__global__ void __launch_bounds__(512) mega(Params P) {
    extern __shared__ __attribute__((aligned(16))) unsigned char shm[];
    LAS unsigned char* lds = (LAS unsigned char*)shm;
    cg::grid_group grid = cg::this_grid();
    const int wid = __builtin_amdgcn_readfirstlane(threadIdx.x >> 6);
    const int G = gridDim.x, c = blockIdx.x;
    const int gthreads = G * 512;
#define LANE lane_fresh()
#define TID (wid * 64 + lane_fresh())
#define GTID (c * 512 + wid * 64 + lane_fresh())
    unsigned char* ws = P.ws;
    float* ssb = (float*)(ws + WS_MISC + 65536);
    bf16_t* hbA = (bf16_t*)(ws + WS_HBA);
    bf16_t* Ucat = (bf16_t*)(ws + WS_UCAT);
    bf16_t* SG = (bf16_t*)(ws + WS_SGGA); bf16_t* GA = SG + (size_t)T * 512; bf16_t* hbB = SG;
    bf16_t* Qb = (bf16_t*)(ws + WS_QK); bf16_t* Kb = Qb + (size_t)T * 512; bf16_t* pp = Qb;
    bf16_t* VT = (bf16_t*)(ws + WS_VT); bf16_t* zb = (bf16_t*)(ws + WS_ZB);
    bf16_t* cat = (bf16_t*)(ws + WS_CAT);
    float* Sbuf = (float*)(ws + WS_SBUF);
    bf16_t* pb = (bf16_t*)(ws + WS_PB);

    unsigned* bar = (unsigned*)(ws + WS_MISC + 786432);
    volatile LAS unsigned* xst = (volatile LAS unsigned*)(lds + STAGE_BYTES);
#define GSYNC() xcd_barrier(bar, xst, wid)
    if (wid == 0 && LANE == 0) { xst[0] = 0u; xst[1] = 0u; (void)xb_add(&bar[XB_XCNT(xb_xcc_id())], 1u); }
    if (P.ws == nullptr) grid.sync();
    for (int rep = 0; rep < REP_P0; ++rep) {
    const int role = (c >> 3) & 1, sc = ((c >> 4) << 3) | (c & 7), SG_ = G >> 1;
    const int sthreads = SG_ * 512;
    if (role == 0) ssm_prep(P, sc >> 1, sc & 1, lds, TID);
    { const int lane = LANE; LAS float* scr = (LAS float*)lds + wid * (64 * 33); const int l = role == 0 ? 1 : 0;
    for (int i = sc * 512 + TID; i < 3 * T; i += SG_ * 512) if (role == 1) ssb[T + i] = 0.f;
    {
        transpose_w<1>(P.w_in + (size_t)l * 1024 * 3072, 1024, 3072, (bf16_t*)(ws + WS_WIN) + (size_t)l * 3072 * 1024, P.mix_g + l * 1024, scr, sc * 8 + wid, SG_ * 8, lane);
        transpose_w<2>(P.w_glu + (size_t)l * 512 * 1024, 512, 1024, (bf16_t*)(ws + WS_WGLU) + (size_t)l * 1024 * 512, nullptr, scr, sc * 8 + wid, SG_ * 8, lane);
        transpose_w<0>(P.w_out + (size_t)l * 1024 * 1024, 1024, 1024, (bf16_t*)(ws + WS_WOUT) + (size_t)l * 1024 * 1024, nullptr, scr, sc * 8 + wid, SG_ * 8, lane);
        transpose_w<0>(P.w_pg + (size_t)l * 1024 * 1024, 1024, 1024, (bf16_t*)(ws + WS_WPG) + (size_t)l * 1024 * 1024, P.ple_g + l * 1024, scr, sc * 8 + wid, SG_ * 8, lane);
        transpose_w<0>(P.w_pp + (size_t)l * 256 * 1024, 256, 1024, (bf16_t*)(ws + WS_WPP) + (size_t)l * 1024 * 256, nullptr, scr, sc * 8 + wid, SG_ * 8, lane);
    } }
    if (role == 1)
    for (int row = (sc * 8 + wid) * 2; row < T; row += SG_ * 16) {
        const int lane = LANE;
        const f32x4* xr = (const f32x4*)(P.x + (size_t)row * 1024); f32x4 v[2][4];
#pragma unroll
        for (int r2 = 0; r2 < 2; ++r2)
#pragma unroll
            for (int j = 0; j < 4; ++j) v[r2][j] = xr[r2 * 256 + lane + 64 * j];
#pragma unroll
        for (int r2 = 0; r2 < 2; ++r2) { float s = 0.f;
#pragma unroll
            for (int j = 0; j < 4; ++j) { const f32x4 q = v[r2][j]; s += (q[0] * q[0] + q[1] * q[1]) + (q[2] * q[2] + q[3] * q[3]);
                u32x2 w; w.x = cvt_pk_bf16(q[0], q[1]); w.y = cvt_pk_bf16(q[2], q[3]); *(u32x2*)(hbA + (size_t)(row + r2) * 1024 + (lane + 64 * j) * 4) = w; }
#pragma unroll
            for (int o = 1; o < 64; o <<= 1) s += __shfl_xor(s, o);
            if (lane == 0) ssb[row + r2] = s; }
    }
    { const size_t pbase = (size_t)(role == 0 ? 1 : 0) * T * 256 / 8, pend = pbase + (size_t)T * 256 / 8;
    for (size_t i = pbase + sc * 512 + TID; i < pend; i += (size_t)4 * sthreads) {
        f32x4 a[4], b[4];
#pragma unroll
        for (int q = 0; q < 4; ++q) { const size_t ii = i + (size_t)q * sthreads; if (ii < pend) { a[q] = ((const f32x4*)P.p)[2 * ii]; b[q] = ((const f32x4*)P.p)[2 * ii + 1]; } }
#pragma unroll
        for (int q = 0; q < 4; ++q) { const size_t ii = i + (size_t)q * sthreads; if (ii < pend) {
            u32x4 o; o.x = cvt_pk_bf16(a[q][0], a[q][1]); o.y = cvt_pk_bf16(a[q][2], a[q][3]); o.z = cvt_pk_bf16(b[q][0], b[q][1]); o.w = cvt_pk_bf16(b[q][2], b[q][3]);
            ((u32x4*)pb)[ii] = o; } }
    }
    }
    }
    if (wid == 0 && LANE == 0) { unsigned nloc, nx; xcd_barrier_complete(bar, xb_xcc_id(), G, nloc, nx); xst[0] = nloc; xst[1] = nx; }
    GSYNC();

    auto layer = [&](const int l) __attribute__((always_inline)) {
        float* ssIn = ssb + (size_t)(2 * l) * T; float* ssMid = ssb + (size_t)(2 * l + 1) * T; float* ssNext = ssb + (size_t)(2 * l + 2 > 3 ? 3 : 2 * l + 2) * T;
        { Gemm g{hbA, (const bf16_t*)(ws + WS_WIN) + (size_t)l * 3072 * 1024, 1024, 1024, 1024, 0, 0};
          Order S; S.init(T / 256, 12, 1, G, c);
          EpiIn E{ssIn, Ucat, SG, GA, Qb, Kb, VT, P.q_g + l * 64, P.k_g + l * 64};
          for (int rep = 0; rep < REP_INPROJ; ++rep) gemm_phase(lds, g, S, E, wid); }
        GSYNC();
        { Gemm g{Ucat, (const bf16_t*)(ws + WS_W1) + (size_t)l * 32 * 256 * 512, 640, 512, 512, (size_t)1024 * 640, (size_t)256 * 512};
          Order S; S.init(4, 1, 32, G, c);
          EpiS E{Sbuf};
          for (int rep = 0; rep < REP_GEMMS; ++rep) gemm_phase(lds, g, S, E, wid); }
        if (c < 128) {
            asm volatile("s_waitcnt vmcnt(0)" ::: "memory"); __syncthreads();
            const int lane = LANE, seg = lane >> 4, pl = lane & 15;
            const int q_ = c >> 3, L_ = ((c & 7) * 4 + (q_ >> 2)) * 4 + (q_ & 3);
            const int pq = wid & 3, g = L_ >> 2, b = 2 * (L_ & 3) + (wid >> 2), p = pq * 16 + pl;
            const float* a32 = (const float*)(ws + WS_MISC) + (size_t)((l * 32 + g) * 64 + p) * 2; const float ar = a32[0], ai = a32[1];
            const size_t row0 = (size_t)g * 1024 + b * 128 + seg * 32;
            const float* __restrict__ Sp = Sbuf + row0 * 128 + p;
            float sr[32], si[32];
#pragma unroll
            for (int j = 0; j < 32; ++j) { sr[j] = Sp[(size_t)j * 128]; si[j] = Sp[(size_t)j * 128 + 64]; }
            float hr = 0.f, hi = 0.f, wr_ = 1.f, wi_ = 0.f;
#pragma unroll
            for (int j = 0; j < 32; ++j) { const float nr = ar * hr - ai * hi + sr[j], ni = ar * hi + ai * hr + si[j]; hr = nr; hi = ni;
                const float xr = ar * wr_ - ai * wi_, xi = ar * wi_ + ai * wr_; wr_ = xr; wi_ = xi; }
            const float e0r = __shfl(hr, pl), e0i = __shfl(hi, pl), e1r = __shfl(hr, pl + 16), e1i = __shfl(hi, pl + 16), e2r = __shfl(hr, pl + 32), e2i = __shfl(hi, pl + 32);
            const float h1r = e0r, h1i = e0i;
            const float h2r = wr_ * h1r - wi_ * h1i + e1r, h2i = wr_ * h1i + wi_ * h1r + e1i;
            const float h3r = wr_ * h2r - wi_ * h2i + e2r, h3i = wr_ * h2i + wi_ * h2r + e2i;
            const float cinr = seg == 0 ? 0.f : seg == 1 ? h1r : seg == 2 ? h2r : h3r, cini = seg == 0 ? 0.f : seg == 1 ? h1i : seg == 2 ? h2i : h3i;
            bf16_t* __restrict__ Up = Ucat + row0 * 640 + 512 + p;
            hr = 0.f; hi = 0.f; float cr_ = cinr, ci_ = cini;
#pragma unroll
            for (int j = 0; j < 32; ++j) {
                const unsigned pk = cvt_pk_bf16(hr + cr_, hi + ci_);
                Up[(size_t)j * 640] = (bf16_t)(pk & 0xffffu); Up[(size_t)j * 640 + 64] = (bf16_t)(pk >> 16);
                const float nr = ar * hr - ai * hi + sr[j], ni = ar * hi + ai * hr + si[j]; hr = nr; hi = ni;
                const float xr = ar * cr_ - ai * ci_, xi = ar * ci_ + ai * cr_; cr_ = xr; ci_ = xi; }
            asm volatile("s_waitcnt vmcnt(0)" ::: "memory"); __syncthreads();
            { Gemm gy{Ucat, (const bf16_t*)(ws + WS_TOEP) + (size_t)l * 32 * 512 * 640, 640, 640, 640, (size_t)1024 * 640, (size_t)512 * 640};
              Order SY; SY.nwg = -1; SY.nM = g; SY.nN = L_ & 3; SY.lim = 2; SY.total = 0; SY.G = 0; SY.c = 0;
              EpiY EY{Ucat, P.dsk + l * 512, zb};
              for (int rep = 0; rep < REP_Y; ++rep) gemm_phase(lds, gy, SY, EY, wid); }
        }
        for (int rep = 0; rep < REP_ATTN; ++rep)
        {
            const int nit = c < 128 ? 1 : 7, base = c < 128 ? (c * 8 + wid) : 1024 + ((c - 128) * 8 + wid) * 7;
            for (int j = 0; j < nit; ++j) attn_item(base + j, Qb, Kb, VT, GA, cat, LANE); }
        GSYNC();
        { Gemm g{zb, (const bf16_t*)(ws + WS_WGLU) + (size_t)l * 1024 * 512, 512, 512, 512, 0, 0};
          Order S; S.init(T / 256, 4, 1, G, c);
          EpiGlu E{P.b_glu + l * 1024, SG, cat};
          for (int rep = 0; rep < REP_GLU; ++rep) gemm_phase(lds, g, S, E, wid); }
        { Gemm g{pb + (size_t)l * T * 256, (const bf16_t*)(ws + WS_WPP) + (size_t)l * 1024 * 256, 256, 256, 256, 0, 0};
          Order S; S.init(T / 256, 4, 1, G, c);
          EpiPP E{pp};
          for (int rep = 0; rep < REP_PP; ++rep) gemm_phase(lds, g, S, E, wid); }
        GSYNC();
        { Gemm g{cat, (const bf16_t*)(ws + WS_WOUT) + (size_t)l * 1024 * 1024, 1024, 1024, 1024, 0, 0};
          Order S; S.init(T / 256, 4, 1, G, c);
          EpiOut E{hbA, hbB, ssMid};
          gemm_phase(lds, g, S, E, wid); }
        GSYNC();
        { Gemm g{hbB, (const bf16_t*)(ws + WS_WPG) + (size_t)l * 1024 * 1024, 1024, 1024, 1024, 0, 0};
          Order S; S.init(T / 256, 4, 1, G, c);
          EpiPle E{ssMid, hbB, P.out, pp, hbA, ssNext, l == 1 ? 1 : 0};
          gemm_phase(lds, g, S, E, wid); }
        if (l == 0) GSYNC();
    };
    layer(0); layer(1);
}

extern "C" void kernel_launch(void* const* d_in, const int* in_sizes, int n_in, void* d_out, int out_size, void* d_ws, size_t ws_size, hipStream_t stream) {
    static int grid = 0;
    if (grid == 0) {
        if (n_in != 20 || ws_size < WS_END) { fprintf(stderr, "kernel_launch: unexpected inputs (n_in %d, ws %zu < %zu)\n", n_in, ws_size, (size_t)WS_END); grid = -1; return; }
        int dev = 0, cus = 0, per_cu = 0;
        hipGetDevice(&dev); hipDeviceGetAttribute(&cus, hipDeviceAttributeMultiprocessorCount, dev);
        if (hipFuncSetAttribute((const void*)mega, hipFuncAttributeMaxDynamicSharedMemorySize, LDS_BYTES) != hipSuccess) { fprintf(stderr, "hipFuncSetAttribute failed\n"); grid = -1; return; }
        if (hipOccupancyMaxActiveBlocksPerMultiprocessor(&per_cu, (const void*)mega, 512, LDS_BYTES) != hipSuccess || per_cu < 1) { fprintf(stderr, "occupancy query: %d\n", per_cu); per_cu = 1; }
        (void)hipGetLastError();
        if (cus < 256) { fprintf(stderr, "kernel_launch: built for a 256-CU device (static work partition over 256 workgroups), found %d CUs; nothing launched\n", cus); grid = -1; return; }
        grid = 256;
    }
    if (grid < 0) return;
    if (hipMemsetAsync((char*)d_ws + WS_MISC + 786432, 0, XCD_BAR_WORDS * 4, stream) != hipSuccess) { fprintf(stderr, "kernel_launch: hipMemsetAsync failed\n"); return; }
    Params P{};
    const float** pp = (const float**)&P;
    for (int i = 0; i < 20; ++i) pp[i] = (const float*)d_in[i];
    P.out = (float*)d_out; P.ws = (unsigned char*)d_ws;
    void* args[] = {&P};
    hipError_t e = hipLaunchCooperativeKernel((const void*)mega, dim3(grid), dim3(512), args, LDS_BYTES, stream);
    if (e != hipSuccess) fprintf(stderr, "cooperative launch failed: %s (grid %d)\n", hipGetErrorString(e), grid);
}
```

```cpp
#ifndef REP_P0
#define REP_P0 1
#define REP_INPROJ 1
#define REP_ATTN 1
#define REP_SCAN 1
#define REP_SYNC 1
#define REP_GEMMS 1
#define REP_PP 1
#define REP_Y 1
#define REP_GLU 1
#endif
#include <hip/hip_runtime.h>
#include <hip/hip_cooperative_groups.h>
#include <cstdio>
namespace cg = cooperative_groups;

#define LAS __attribute__((address_space(3)))
#define DI __device__ __forceinline__
typedef unsigned short bf16_t;
typedef short bf16x8 __attribute__((ext_vector_type(8)));
typedef float f32x4 __attribute__((ext_vector_type(4)));
typedef float f32x16 __attribute__((ext_vector_type(16)));
typedef unsigned u32x4 __attribute__((ext_vector_type(4)));
typedef unsigned u32x2 __attribute__((ext_vector_type(2)));

constexpr int T = 32768, SEQ = 4096;
constexpr int BM = 256, BK = 64, HALF = 128, HTB = HALF * BK * 2, STAGE_BYTES = 8 * HTB, NXCD = 8, WGM = 2;
constexpr int LDS_DUMMY = STAGE_BYTES + 16;
constexpr int LDS_BYTES = STAGE_BYTES + 16 + 2048;

constexpr size_t MBy = 1u << 20;
constexpr size_t WS_WIN = 0;
constexpr size_t WS_WGLU = WS_WIN + 12 * MBy;
constexpr size_t WS_WOUT = WS_WGLU + 2 * MBy;
constexpr size_t WS_WPG = WS_WOUT + 4 * MBy;
constexpr size_t WS_WPP = WS_WPG + 4 * MBy;
constexpr size_t WS_W1 = WS_WPP + 1 * MBy;
constexpr size_t WS_TOEP = WS_W1 + 16 * MBy;
constexpr size_t WS_MISC = WS_TOEP + 40 * MBy;
constexpr size_t WS_HBA = WS_MISC + 1 * MBy;
constexpr size_t WS_UCAT = WS_HBA + 64 * MBy;
constexpr size_t WS_SGGA = WS_UCAT + 40 * MBy;
constexpr size_t WS_QK = WS_SGGA + 64 * MBy;
constexpr size_t WS_VT = WS_QK + 64 * MBy;
constexpr size_t WS_CAT = WS_VT + 32 * MBy;
constexpr size_t WS_SBUF = WS_CAT + 64 * MBy;
constexpr size_t WS_PB = WS_SBUF + 16 * MBy;
constexpr size_t WS_ZB = WS_PB + 32 * MBy;
constexpr size_t WS_END = WS_ZB + 32 * MBy;

struct Params {
    const float *x, *p, *mix_g, *w_in, *a_re, *a_im, *log_dt, *b_re, *b_im, *c_re, *c_im, *dsk, *w_glu, *b_glu, *q_g, *k_g, *w_out, *ple_g, *w_pg, *w_pp;
    float* out; unsigned char* ws;
};

DI int lane_fresh() { int l; asm volatile("v_mbcnt_lo_u32_b32 %0, -1, 0\n\tv_mbcnt_hi_u32_b32 %0, -1, %0" : "=v"(l)); return l; }
DI unsigned cvt_pk_bf16(float lo, float hi) { unsigned r; asm volatile("v_cvt_pk_bf16_f32 %0, %1, %2" : "=v"(r) : "v"(lo), "v"(hi)); return r; }
DI float bf_lo(unsigned w) { return __uint_as_float(w << 16); }
DI float bf_hi(unsigned w) { return __uint_as_float(w & 0xffff0000u); }
DI float fsigmoid(float x) { return __builtin_amdgcn_rcpf(1.0f + __expf(-x)); }
DI float fsilu(float x) { return x * fsigmoid(x); }
DI float fgelu_tanh(float y) { const float u2 = 1.5957691216057308f * (y + 0.044715f * y * y * y); return y * fsigmoid(u2); }

DI int lds_byte(int r, int c) { const int st = (r >> 4) * 2 + (c >> 5), rr = r & 15, cc = c & 31, ob = rr * 64 + cc * 2; return st * 1024 + (ob ^ (((ob >> 9) & 1) << 5)); }
DI void stage_rc(int b, int& R, int& C) { const int st = b / 1024, sb = b % 1024, swz = sb ^ (((sb >> 9) & 1) << 5); R = (st >> 1) * 16 + swz / 64; C = (st & 1) * 32 + (swz % 64) / 2; }

struct Unit { int pm, pn, g; };
struct Gemm { const bf16_t* A; const bf16_t* Bt; int lda, ldb, K; size_t gsA, gsB; };
struct Order {
    int nM, nN, nwg, total, G, c, lim;
    DI void init(int nM_, int nN_, int nG, int G_, int c_) { nM = nM_; nN = nN_; nwg = nM * nN; total = nwg * nG; lim = total; G = G_; c = c_; asm volatile("" : "+s"(c)); }
    DI bool next(int i, Unit& u) const {
        if (nwg < 0) { if (i >= lim) return false; u.g = nM; u.pm = nN; u.pn = i; return true; }
        int L = i * G + c; if (L >= lim) return false;
        if (total > nwg) {
            const int gpx = (total / nwg) >> 3, q = (c >> 3) + (G >> 3) * i; if (q >= gpx * nwg) return false;
            L = ((c & 7) * gpx + q / nwg) * nwg + q % nwg; }
        u.g = L / nwg; int wgid = L - u.g * nwg;
        { const int q = nwg / NXCD, r = nwg % NXCD, xcd = wgid % NXCD, off = wgid / NXCD; wgid = (xcd < r ? xcd * (q + 1) : r * (q + 1) + (xcd - r) * q) + off; }
        const int nig = WGM * nN, gid = wgid / nig, fm = gid * WGM, gsz = (nM - fm) < WGM ? (nM - fm) : WGM;
        u.pm = fm + ((wgid % nig) % gsz); u.pn = (wgid % nig) / gsz; return true;
    }
};

template <class Epi>
DI void gemm_phase(LAS unsigned char* lds, const Gemm g, const Order& S, const Epi& E, const int wid) {
    const int lane = lane_fresh(), tid = wid * 64 + lane, wr = wid >> 2, wc = wid & 3, fr = lane & 15, fq = lane >> 4;
    const int K = g.K, nt = K / BK;
    unsigned voffA[2], voffB[2];
#pragma unroll
    for (int i = 0; i < 2; ++i) { int R, C; stage_rc(tid * 16 + i * 8192, R, C); voffA[i] = (unsigned)(R * g.lda + C) * 2u; voffB[i] = (unsigned)(R * g.ldb + C) * 2u; }
    const size_t kstep = (size_t)(BK * 2);
    const size_t hstepA = (size_t)HALF * g.lda * 2, hstepB = (size_t)HALF * g.ldb * 2;
    const size_t tstepA = 2 * hstepA, tstepB = 2 * hstepB;
    const unsigned ldsw = (unsigned)wid * 1024u;
    const int aoff = lds_byte(wr * 64 + fr, fq * 8), boff = lds_byte(wc * 32 + fr, fq * 8);
#define PG8_SA(b, h) (((b) * 2 + (h)) * HTB)
#define PG8_SB(b, h) ((4 + (b) * 2 + (h)) * HTB)
#define PG8_STAGE(bufoff, gbase, voff) do { _Pragma("unroll") for (int _i = 0; _i < 2; ++_i) \
        __builtin_amdgcn_global_load_lds((const unsigned*)((const char*)(gbase) + (voff)[_i]), (LAS unsigned*)(lds + (bufoff) + ldsw + _i * 8192), 16, 0, 0); } while (0)
#define PG8_LDA(dst, b, h) do { _Pragma("unroll") for (int m = 0; m < 4; ++m) _Pragma("unroll") for (int k = 0; k < 2; ++k) dst[m][k] = *(const LAS bf16x8*)(lds + PG8_SA(b, h) + aoff + m * 2048 + k * 1024); } while (0)
#define PG8_LDB(dst, b, h) do { _Pragma("unroll") for (int n = 0; n < 2; ++n) _Pragma("unroll") for (int k = 0; k < 2; ++k) dst[n][k] = *(const LAS bf16x8*)(lds + PG8_SB(b, h) + boff + n * 2048 + k * 1024); } while (0)
#define PG8_MMA(ai, bj, At, Bt) do { __builtin_amdgcn_s_setprio(1); _Pragma("unroll") for (int m = 0; m < 4; ++m) _Pragma("unroll") for (int n = 0; n < 2; ++n) _Pragma("unroll") for (int k = 0; k < 2; ++k) \
        acc[ai][bj][m][n] = __builtin_amdgcn_mfma_f32_16x16x32_bf16(Bt[n][k], At[m][k], acc[ai][bj][m][n], 0, 0, 0); __builtin_amdgcn_s_setprio(0); } while (0)
#define PG8_WAIT_V(n) asm volatile("s_waitcnt vmcnt(" #n ")" ::: "memory")
#define PG8_WAIT_L(n) asm volatile("s_waitcnt lgkmcnt(" #n ")" ::: "memory")
#define PG8_BAR __builtin_amdgcn_s_barrier()
#define PG8_SCHED __builtin_amdgcn_sched_barrier(0)
    Unit cur, nxt; int ui = 0;
    if (!S.next(0, cur)) return;
    f32x4 acc[2][2][4][2];
#pragma unroll
    for (int a = 0; a < 2; ++a)
#pragma unroll
        for (int b = 0; b < 2; ++b)
#pragma unroll
            for (int m = 0; m < 4; ++m)
#pragma unroll
                for (int n = 0; n < 2; ++n) acc[a][b][m][n] = (f32x4){0.f, 0.f, 0.f, 0.f};
    bf16x8 At[4][2], B0[2][2], B1[2][2];
    const char* cA = (const char*)(g.A + (size_t)cur.g * g.gsA) + (size_t)cur.pm * tstepA;
    const char* cB = (const char*)(g.Bt + (size_t)cur.g * g.gsB) + (size_t)cur.pn * tstepB;
    PG8_STAGE(PG8_SB(0, 0), cB, voffB); PG8_STAGE(PG8_SB(0, 1), cB + hstepB, voffB); PG8_STAGE(PG8_SA(0, 0), cA, voffA); PG8_STAGE(PG8_SA(0, 1), cA + hstepA, voffA);
    if (wr == 1) PG8_BAR;
    PG8_WAIT_V(2); PG8_BAR;
    PG8_STAGE(PG8_SB(1, 0), cB + kstep, voffB); PG8_STAGE(PG8_SA(1, 0), cA + kstep, voffA); PG8_STAGE(PG8_SB(1, 1), cB + hstepB + kstep, voffB);
    PG8_WAIT_V(6); PG8_BAR;
    for (;;) {
        const bool has_next = S.next(ui + 1, nxt);
        const char* nA = has_next ? (const char*)(g.A + (size_t)nxt.g * g.gsA) + (size_t)nxt.pm * tstepA : cA;
        const char* nB = has_next ? (const char*)(g.Bt + (size_t)nxt.g * g.gsB) + (size_t)nxt.pn * tstepB : cB;
        for (int t = 0; t < nt; t += 2) {
            const bool last = (t == nt - 2);
            const char* a1 = cA + (size_t)(t + 1) * kstep;
            const char* a2 = last ? nA : cA + (size_t)(t + 2) * kstep; const char* b2 = last ? nB : cB + (size_t)(t + 2) * kstep;
            const char* a3 = a2 + kstep; const char* b3 = b2 + kstep;
            if (t == nt - 4) E.prefetch(cur, lds, wid);
            PG8_LDB(B0, 0, 0); PG8_LDB(B1, 0, 1); PG8_SCHED; PG8_LDA(At, 0, 0); PG8_STAGE(PG8_SA(1, 1), a1 + hstepA, voffA);
            PG8_WAIT_V(8); PG8_WAIT_L(0); PG8_BAR; PG8_MMA(0, 0, At, B0); PG8_MMA(0, 1, At, B1); PG8_BAR; PG8_SCHED;
            PG8_LDA(At, 0, 1); PG8_STAGE(PG8_SB(0, 0), b2, voffB); PG8_STAGE(PG8_SB(0, 1), b2 + hstepB, voffB); PG8_STAGE(PG8_SA(0, 0), a2, voffA);
            PG8_WAIT_V(8); PG8_WAIT_L(0); PG8_BAR; PG8_MMA(1, 0, At, B0); PG8_MMA(1, 1, At, B1); PG8_BAR; PG8_SCHED;
            PG8_LDB(B0, 1, 0); PG8_LDB(B1, 1, 1); PG8_SCHED; PG8_LDA(At, 1, 0); PG8_STAGE(PG8_SA(0, 1), a2 + hstepA, voffA);
            PG8_WAIT_V(8); PG8_WAIT_L(0); PG8_BAR; PG8_MMA(0, 0, At, B0); PG8_MMA(0, 1, At, B1); PG8_BAR; PG8_SCHED;
            PG8_LDA(At, 1, 1); PG8_STAGE(PG8_SB(1, 0), b3, voffB); PG8_STAGE(PG8_SB(1, 1), b3 + hstepB, voffB); PG8_STAGE(PG8_SA(1, 0), a3, voffA);
            PG8_WAIT_V(8); PG8_WAIT_L(0); PG8_BAR; PG8_MMA(1, 0, At, B0); PG8_MMA(1, 1, At, B1); PG8_BAR; PG8_SCHED;
        }
        if (wr == 0) PG8_BAR;
        { const int le = lane_fresh(); E(acc, cur, wr, wc, le & 15, le >> 4); }
        if (!has_next) break;
#pragma unroll
        for (int a = 0; a < 2; ++a)
#pragma unroll
            for (int b = 0; b < 2; ++b)
#pragma unroll
                for (int m = 0; m < 4; ++m)
#pragma unroll
                    for (int n = 0; n < 2; ++n) acc[a][b][m][n] = (f32x4){0.f, 0.f, 0.f, 0.f};
        cur = nxt; cA = nA; cB = nB; ++ui;
        if (wr == 1) PG8_BAR;
    }
    PG8_WAIT_V(0);
    PG8_BAR;
#undef PG8_SA
#undef PG8_SB
#undef PG8_STAGE
#undef PG8_LDA
#undef PG8_LDB
#undef PG8_MMA
#undef PG8_WAIT_V
#undef PG8_WAIT_L
#undef PG8_BAR
#undef PG8_SCHED
}

#define EPI_ROWS _Pragma("unroll") for (int ai = 0; ai < 2; ++ai) _Pragma("unroll") for (int m = 0; m < 4; ++m) if ((__extension__({ if ((m & 1) == 0) asm volatile("" ::: "memory"); 1; })))
#define EPI_ROWS_NF _Pragma("unroll") for (int ai = 0; ai < 2; ++ai) _Pragma("unroll") for (int m = 0; m < 4; ++m)
#define EPI_COLS _Pragma("unroll") for (int bj = 0; bj < 2; ++bj) _Pragma("unroll") for (int n = 0; n < 2; ++n)

struct EpiIn {
    DI void prefetch(const Unit& u, LAS unsigned char* lds, int wid) const {
        if (wid < 4) __builtin_amdgcn_global_load_lds((const unsigned*)(ss + u.pm * BM + wid * 64 + lane_fresh()), (LAS unsigned*)(lds + LDS_DUMMY + wid * 256), 4, 0, 0);
    }
    const float* ss; bf16_t *Ucat, *SG, *GA, *Q, *Kb, *VT; const float *qg, *kg;
    DI void operator()(const f32x4 (&acc)[2][2][4][2], const Unit& u, int wr, int wc, int fr, int fq) const {
        const int type = u.pn >> 1, hf = u.pn & 1;
        float rsv[2][4];
        EPI_ROWS_NF rsv[ai][m] = ss[u.pm * BM + ai * HALF + wr * 64 + m * 16 + fr];
        EPI_ROWS_NF rsv[ai][m] = rsqrtf(rsv[ai][m] * (1.f / 1024.f) + 1e-6f);
        if (type == 0) {
            EPI_ROWS_NF { const int row = u.pm * BM + ai * HALF + wr * 64 + m * 16 + fr; const float rs = rsv[ai][m];
                EPI_COLS { const f32x4 v = acc[ai][bj][m][n] * rs; const int g = 16 * hf + 4 * wc + 2 * bj + n;
                    u32x2 w; w.x = cvt_pk_bf16(v[0], v[1]); w.y = cvt_pk_bf16(v[2], v[3]);
                    *(u32x2*)(Ucat + ((size_t)(g * 1024 + (row >> 5)) * 640 + (row & 31) * 16 + 4 * fq)) = w; } }
        } else if (type == 1 || type == 5) {
            bf16_t* dst = type == 1 ? SG : GA;
            EPI_ROWS_NF { const int row = u.pm * BM + ai * HALF + wr * 64 + m * 16 + fr; const float rs = rsv[ai][m];
                EPI_COLS { const f32x4 v = acc[ai][bj][m][n] * rs; const int cs = 256 * hf + 64 * wc + 32 * bj + 16 * n + 4 * fq;
                    u32x2 w; w.x = cvt_pk_bf16(fsilu(v[0]), fsilu(v[1])); w.y = cvt_pk_bf16(fsilu(v[2]), fsilu(v[3]));
                    *(u32x2*)(dst + (size_t)row * 512 + cs) = w; } }
        } else if (type == 2 || type == 3) {
            bf16_t* dst = type == 2 ? Q : Kb; const float* gam = type == 2 ? qg : kg; const float sc = type == 2 ? 0.125f : 1.0f;
            f32x4 gv[2][2];
            EPI_COLS gv[bj][n] = *(const f32x4*)(gam + 32 * bj + 16 * n + 4 * fq) * sc;
            EPI_ROWS_NF { const int row = u.pm * BM + ai * HALF + wr * 64 + m * 16 + fr; const float rs = rsv[ai][m];
                f32x4 v[2][2]; float s = 0.f;
                EPI_COLS { v[bj][n] = acc[ai][bj][m][n] * rs; s += (v[bj][n][0] * v[bj][n][0] + v[bj][n][1] * v[bj][n][1]) + (v[bj][n][2] * v[bj][n][2] + v[bj][n][3] * v[bj][n][3]); }
                s += __shfl_xor(s, 16); s += __shfl_xor(s, 32);
                const float ri = rsqrtf(s * (1.f / 64.f) + 1e-6f);
                EPI_COLS { const f32x4 o = v[bj][n] * ri * gv[bj][n]; const int cs = 256 * hf + 64 * wc + 32 * bj + 16 * n + 4 * fq;
                    u32x2 w; w.x = cvt_pk_bf16(o[0], o[1]); w.y = cvt_pk_bf16(o[2], o[3]);
                    if (type == 2) *(u32x2*)(dst + (size_t)row * 512 + cs) = w;
                    else {
                        const int key = row & 4095;
                        *(u32x2*)(dst + (((size_t)((row >> 12) * 8 + 4 * hf + wc)) << 18) + (key >> 5) * 2048 + (2 * bj + n) * 512 + (key & 31) * 16 + 4 * fq) = w; } } }
        } else {
            EPI_ROWS_NF { const int row = u.pm * BM + ai * HALF + wr * 64 + m * 16 + fr; const float rs = rsv[ai][m];
                const int b = row >> 12, s = row & 4095, head = 4 * hf + wc;
                EPI_COLS { const f32x4 v = acc[ai][bj][m][n] * rs; const int d = 32 * bj + 16 * n + 4 * fq;
                    const unsigned w0 = cvt_pk_bf16(v[0], v[1]), w1 = cvt_pk_bf16(v[2], v[3]);
                    bf16_t* o = VT + (((size_t)(b * 8 + head)) << 18) + (s >> 5) * 2048 + bj * 1024 + ((s >> 4) & 1) * 512 + (16 * n + 4 * fq) * 16 + (s & 15);
                    (void)d; o[0] = (bf16_t)(w0 & 0xffffu); o[16] = (bf16_t)(w0 >> 16); o[32] = (bf16_t)(w1 & 0xffffu); o[48] = (bf16_t)(w1 >> 16); } }
        }
    }
};
struct EpiS {
    DI void prefetch(const Unit&, LAS unsigned char*, int) const {}
    float* Sbuf;
    DI void operator()(const f32x4 (&acc)[2][2][4][2], const Unit& u, int wr, int wc, int fr, int fq) const {
        EPI_ROWS { const int R = u.pm * BM + ai * HALF + wr * 64 + m * 16 + fr;
#pragma unroll
            for (int n = 0; n < 2; ++n) *(f32x4*)(Sbuf + ((size_t)(u.g * 1024 + R) * 128 + 32 * wc + 16 * n + 4 * fq)) = acc[ai][0][m][n]; }
    }
};
struct EpiY {
    DI void prefetch(const Unit&, LAS unsigned char*, int) const {}
    const bf16_t* Ucat; const float* dsk; bf16_t* zb;
    DI void operator()(const f32x4 (&acc)[2][2][4][2], const Unit& u, int wr, int wc, int fr, int fq) const {
        const f32x4 dv = *(const f32x4*)(dsk + u.g * 16 + 4 * fq);
        EPI_ROWS { const int R = u.pm * BM + ai * HALF + wr * 64 + m * 16 + fr;
            EPI_COLS { const int ncol = u.pn * BM + bj * HALF + 32 * wc + 16 * n + 4 * fq;
                const u32x2 ub = *(const u32x2*)(Ucat + ((size_t)(u.g * 1024 + R) * 640 + ncol));
                f32x4 y = acc[ai][bj][m][n];
                y[0] += dv[0] * bf_lo(ub.x); y[1] += dv[1] * bf_hi(ub.x); y[2] += dv[2] * bf_lo(ub.y); y[3] += dv[3] * bf_hi(ub.y);
                u32x2 w; w.x = cvt_pk_bf16(fgelu_tanh(y[0]), fgelu_tanh(y[1])); w.y = cvt_pk_bf16(fgelu_tanh(y[2]), fgelu_tanh(y[3]));
                const int token = R * 32 + (ncol >> 4);
                *(u32x2*)(zb + (size_t)token * 512 + u.g * 16 + 4 * fq) = w; } }
    }
};
struct EpiGlu {
    DI void prefetch(const Unit& u, LAS unsigned char* lds, int wid) const {
        const int id = wid * 64 + lane_fresh(), row = id >> 1, seg = id & 1;
        __builtin_amdgcn_global_load_lds((const unsigned*)(SG + (size_t)(u.pm * BM + row) * 512 + u.pn * 128 + seg * 64), (LAS unsigned*)(lds + LDS_DUMMY + wid * 256), 4, 0, 0);
    }
    const float* bglu; const bf16_t* SG; bf16_t* cat;
    DI void operator()(const f32x4 (&acc)[2][2][4][2], const Unit& u, int wr, int wc, int fr, int fq) const {
        f32x4 bv[2], bg[2];
#pragma unroll
        for (int n = 0; n < 2; ++n) { const int ch = u.pn * 128 + 32 * wc + 16 * n + 4 * fq; bv[n] = *(const f32x4*)(bglu + ch); bg[n] = *(const f32x4*)(bglu + 512 + ch); }
        EPI_ROWS { const int row = u.pm * BM + ai * HALF + wr * 64 + m * 16 + fr;
#pragma unroll
            for (int n = 0; n < 2; ++n) { const int ch = u.pn * 128 + 32 * wc + 16 * n + 4 * fq;
                const f32x4 val = acc[ai][0][m][n] + bv[n], gt = acc[ai][1][m][n] + bg[n];
                const u32x2 sg = *(const u32x2*)(SG + (size_t)row * 512 + ch);
                const float o0 = val[0] * fsigmoid(gt[0]) * bf_lo(sg.x), o1 = val[1] * fsigmoid(gt[1]) * bf_hi(sg.x), o2 = val[2] * fsigmoid(gt[2]) * bf_lo(sg.y), o3 = val[3] * fsigmoid(gt[3]) * bf_hi(sg.y);
                u32x2 w; w.x = cvt_pk_bf16(o0, o1); w.y = cvt_pk_bf16(o2, o3);
                *(u32x2*)(cat + (size_t)row * 1024 + ch) = w; } }
    }
};
struct EpiOut {
    DI void prefetch(const Unit& u, LAS unsigned char* lds, int wid) const {
        const int tid = wid * 64 + lane_fresh();
#pragma unroll
        for (int i = 0; i < 2; ++i) { const int id = tid + 512 * i, row = id >> 2, seg = id & 3;
            __builtin_amdgcn_global_load_lds((const unsigned*)(hin + (size_t)(u.pm * BM + row) * 1024 + u.pn * BM + seg * 64), (LAS unsigned*)(lds + LDS_DUMMY + wid * 256), 4, 0, 0); }
    }
    const bf16_t* hin; bf16_t* hb; float* ss;
    DI void operator()(const f32x4 (&acc)[2][2][4][2], const Unit& u, int wr, int wc, int fr, int fq) const {
        EPI_ROWS { const int row = u.pm * BM + ai * HALF + wr * 64 + m * 16 + fr; float s = 0.f;
            EPI_COLS { const size_t off = (size_t)row * 1024 + u.pn * BM + bj * HALF + 32 * wc + 16 * n + 4 * fq;
                const u32x2 rw = *(const u32x2*)(hin + off); f32x4 hv = acc[ai][bj][m][n];
                hv[0] += bf_lo(rw.x); hv[1] += bf_hi(rw.x); hv[2] += bf_lo(rw.y); hv[3] += bf_hi(rw.y);
                u32x2 w; w.x = cvt_pk_bf16(hv[0], hv[1]); w.y = cvt_pk_bf16(hv[2], hv[3]); *(u32x2*)(hb + off) = w;
                s += (hv[0] * hv[0] + hv[1] * hv[1]) + (hv[2] * hv[2] + hv[3] * hv[3]); }
            s += __shfl_xor(s, 16); s += __shfl_xor(s, 32);
            if (fq == 0) atomicAdd(ss + row, s); }
    }
};
struct EpiPle {
    DI void prefetch(const Unit& u, LAS unsigned char* lds, int wid) const {
        const int tid = wid * 64 + lane_fresh();
#pragma unroll
        for (int i = 0; i < 2; ++i) { const int id = tid + 512 * i, row = id >> 2, seg = id & 3; const size_t off = (size_t)(u.pm * BM + row) * 1024 + u.pn * BM + seg * 64;
            __builtin_amdgcn_global_load_lds((const unsigned*)(h1 + off), (LAS unsigned*)(lds + LDS_DUMMY + wid * 256), 4, 0, 0);
            __builtin_amdgcn_global_load_lds((const unsigned*)(pp + off), (LAS unsigned*)(lds + LDS_DUMMY + wid * 256), 4, 0, 0); }
        if (wid < 4) __builtin_amdgcn_global_load_lds((const unsigned*)(ss1 + u.pm * BM + tid), (LAS unsigned*)(lds + LDS_DUMMY + wid * 256), 4, 0, 0);
    }
    const float* ss1; const bf16_t* h1; float* h; const bf16_t* pp; bf16_t* hb; float* ss2; int last;
    DI void operator()(const f32x4 (&acc)[2][2][4][2], const Unit& u, int wr, int wc, int fr, int fq) const {
        float rsv[2][4];
        EPI_ROWS_NF rsv[ai][m] = ss1[u.pm * BM + ai * HALF + wr * 64 + m * 16 + fr];
        EPI_ROWS_NF rsv[ai][m] = rsqrtf(rsv[ai][m] * (1.f / 1024.f) + 1e-6f);
        EPI_ROWS { const int row = u.pm * BM + ai * HALF + wr * 64 + m * 16 + fr; float s = 0.f;
            const float rs = rsv[ai][m];
            EPI_COLS { const size_t off = (size_t)row * 1024 + u.pn * BM + bj * HALF + 32 * wc + 16 * n + 4 * fq;
                const f32x4 a = acc[ai][bj][m][n] * rs; const u32x2 pw = *(const u32x2*)(pp + off); const u32x2 hw = *(const u32x2*)(h1 + off);
                f32x4 hv;
                hv[0] = bf_lo(hw.x) + fsigmoid(a[0]) * bf_lo(pw.x); hv[1] = bf_hi(hw.x) + fsigmoid(a[1]) * bf_hi(pw.x); hv[2] = bf_lo(hw.y) + fsigmoid(a[2]) * bf_lo(pw.y); hv[3] = bf_hi(hw.y) + fsigmoid(a[3]) * bf_hi(pw.y);
                if (last) *(f32x4*)(h + off) = hv;
                if (!last) { u32x2 w; w.x = cvt_pk_bf16(hv[0], hv[1]); w.y = cvt_pk_bf16(hv[2], hv[3]); *(u32x2*)(hb + off) = w;
                    s += (hv[0] * hv[0] + hv[1] * hv[1]) + (hv[2] * hv[2] + hv[3] * hv[3]); } }
            if (!last) { s += __shfl_xor(s, 16); s += __shfl_xor(s, 32); if (fq == 0) atomicAdd(ss2 + row, s); } }
    }
};
struct EpiPP {
    DI void prefetch(const Unit&, LAS unsigned char*, int) const {}
    bf16_t* pp;
    DI void operator()(const f32x4 (&acc)[2][2][4][2], const Unit& u, int wr, int wc, int fr, int fq) const {
        EPI_ROWS { const int row = u.pm * BM + ai * HALF + wr * 64 + m * 16 + fr;
            EPI_COLS { const size_t off = (size_t)row * 1024 + u.pn * BM + bj * HALF + 32 * wc + 16 * n + 4 * fq; const f32x4 a = acc[ai][bj][m][n] * 1.0f;
                u32x2 w; w.x = cvt_pk_bf16(a[0], a[1]); w.y = cvt_pk_bf16(a[2], a[3]); *(u32x2*)(pp + off) = w; } }
    }
};

DI void attn_item(int item, const bf16_t* Q, const bf16_t* Kb, const bf16_t* VT, const bf16_t* GA, bf16_t* cat, int lane) {
    const int qb = item & 127, h = (item >> 7) & 7, b = item >> 10;
    const int q0 = qb * 32, hf = lane >> 5, ql = lane & 31;
    const bf16_t* qp = Q + (size_t)(b * SEQ + q0 + ql) * 512 + h * 64 + 8 * hf;
    bf16x8 qf[4];
#pragma unroll
    for (int s = 0; s < 4; ++s) qf[s] = *(const bf16x8*)(qp + 16 * s);
    const int kperm = (ql & 16) | ((ql & 4) << 1) | ((ql & 8) >> 1) | (ql & 3);
    const bf16_t* kbase = Kb + (((size_t)(b * 8 + h)) << 18) + kperm * 16 + 8 * hf;
    const bf16_t* vbase = VT + (((size_t)(b * 8 + h)) << 18) + ql * 16 + 8 * hf;
    f32x16 o0, o1;
#pragma unroll
    for (int i = 0; i < 16; ++i) { o0[i] = 0.f; o1[i] = 0.f; }
    float cprod = 1.f;
    bf16x8 kf[4], vf[2][2];
    { const bf16_t* kp = kbase + (size_t)(q0 >> 5) * 2048; const bf16_t* vp = vbase + (size_t)(q0 >> 5) * 2048;
#pragma unroll
      for (int s = 0; s < 4; ++s) kf[s] = *(const bf16x8*)(kp + 512 * s);
#pragma unroll
      for (int s = 0; s < 2; ++s) { vf[s][0] = *(const bf16x8*)(vp + 512 * s); vf[s][1] = *(const bf16x8*)(vp + 1024 + 512 * s); } }
#define ATT_TILE(DIAG) { \
        f32x16 st; _Pragma("unroll") for (int i = 0; i < 16; ++i) st[i] = 0.f; \
        _Pragma("unroll") for (int s = 0; s < 4; ++s) st = __builtin_amdgcn_mfma_f32_32x32x16_bf16(kf[s], qf[s], st, 0, 0, 0); \
        const int kn = kb >= 32 ? kb - 32 : 0; const bf16_t* kp = kbase + (size_t)(kn >> 5) * 2048; const bf16_t* vp = vbase + (size_t)(kn >> 5) * 2048; \
        bf16x8 kf2[4], vf2[2][2]; \
        _Pragma("unroll") for (int s = 0; s < 4; ++s) kf2[s] = *(const bf16x8*)(kp + 512 * s); \
        _Pragma("unroll") for (int s = 0; s < 2; ++s) { vf2[s][0] = *(const bf16x8*)(vp + 512 * s); vf2[s][1] = *(const bf16x8*)(vp + 1024 + 512 * s); } \
        float sg[16], ns[16]; float PA = 1.f, PB = 1.f; \
        _Pragma("unroll") for (int r = 0; r < 16; ++r) { \
            const float t = st[r] * -1.4426950408889634f; \
            const float e = __builtin_amdgcn_exp2f(fminf(t, 115.0f));        \
            float sgm = __builtin_amdgcn_rcpf(1.0f + e);                     \
            float nsv = e * sgm;                                             \
            if (DIAG) { const int koff = 16 * (r >> 3) + 8 * hf + (r & 7); if (koff >= ql) { sgm = 0.f; nsv = 1.f; } } \
            sg[r] = sgm; ns[r] = nsv; if (r < 8) PA *= nsv; else PB *= nsv; } \
        const float PAo = __shfl_xor(PA, 32), PBo = __shfl_xor(PB, 32); \
        float runA = cprod * (PB * PBo) * (hf == 0 ? PAo : 1.f); float runB = cprod * (hf == 0 ? PBo : 1.f); \
        float w[16]; \
        _Pragma("unroll") for (int r = 7; r >= 0; --r) { w[r] = sg[r] * runA; runA *= ns[r]; } \
        _Pragma("unroll") for (int r = 15; r >= 8; --r) { w[r] = sg[r] * runB; runB *= ns[r]; } \
        cprod *= (PA * PAo) * (PB * PBo); \
        _Pragma("unroll") for (int s = 0; s < 2; ++s) { \
            u32x4 pw; pw.x = cvt_pk_bf16(w[8 * s], w[8 * s + 1]); pw.y = cvt_pk_bf16(w[8 * s + 2], w[8 * s + 3]); pw.z = cvt_pk_bf16(w[8 * s + 4], w[8 * s + 5]); pw.w = cvt_pk_bf16(w[8 * s + 6], w[8 * s + 7]); \
            const bf16x8 wf = __builtin_bit_cast(bf16x8, pw); \
            o0 = __builtin_amdgcn_mfma_f32_32x32x16_bf16(wf, vf[s][0], o0, 0, 0, 0); \
            o1 = __builtin_amdgcn_mfma_f32_32x32x16_bf16(wf, vf[s][1], o1, 0, 0, 0); } \
        _Pragma("unroll") for (int s = 0; s < 4; ++s) kf[s] = kf2[s]; \
        _Pragma("unroll") for (int s = 0; s < 2; ++s) { vf[s][0] = vf2[s][0]; vf[s][1] = vf2[s][1]; } \
        kb -= 32; }
    { int kb = q0;
      ATT_TILE(true)
      if (kb >= 0 && !__all(cprod < 1.17549435e-38f)) {
          _Pragma("nounroll") for (;;) { ATT_TILE(false) if (kb < 0 || __all(cprod < 1.17549435e-38f)) break; } } }
#undef ATT_TILE
#pragma unroll
    for (int r = 0; r < 16; ++r) {
        const size_t tok = (size_t)(b * SEQ + q0 + 8 * (r >> 2) + 4 * hf + (r & 3));
        const float g0 = __uint_as_float((unsigned)GA[tok * 512 + h * 64 + ql] << 16), g1 = __uint_as_float((unsigned)GA[tok * 512 + h * 64 + 32 + ql] << 16);
        const unsigned w = cvt_pk_bf16(o0[r] * g0, o1[r] * g1);
        cat[tok * 1024 + 512 + h * 64 + ql] = (bf16_t)(w & 0xffffu);
        cat[tok * 1024 + 512 + h * 64 + 32 + ql] = (bf16_t)(w >> 16);
    }
}

DI void sincos_d(double ang, double& s, double& c) {
    const double k = rint(ang * 0.63661977236758134308);
    double y = fma(-k, 1.5707963267948966192, ang); y = fma(-k, 6.123233995736766e-17, y);
    const double y2 = y * y;
    const double sp = y * (1.0 - y2 * (1.0 / 6.0) * (1.0 - y2 * (1.0 / 20.0) * (1.0 - y2 * (1.0 / 42.0) * (1.0 - y2 * (1.0 / 72.0) * (1.0 - y2 * (1.0 / 110.0) * (1.0 - y2 * (1.0 / 156.0) * (1.0 - y2 * (1.0 / 210.0) * (1.0 - y2 * (1.0 / 272.0)))))))));
    const double cp = 1.0 - y2 * (1.0 / 2.0) * (1.0 - y2 * (1.0 / 12.0) * (1.0 - y2 * (1.0 / 30.0) * (1.0 - y2 * (1.0 / 56.0) * (1.0 - y2 * (1.0 / 90.0) * (1.0 - y2 * (1.0 / 132.0) * (1.0 - y2 * (1.0 / 182.0) * (1.0 - y2 * (1.0 / 240.0))))))));
    const int q = (int)((long long)k & 3);
    s = (q == 0) ? sp : (q == 1) ? cp : (q == 2) ? -sp : -cp;
    c = (q == 0) ? cp : (q == 1) ? -sp : (q == 2) ? -cp : sp;
}
DI double exp_d(double x) {
    const double k = rint(x * 1.4426950408889634074); const double r = fma(-k, 0.69314718055994530942, x);
    double t = 1.0;
#pragma unroll
    for (int i = 14; i >= 1; --i) t = 1.0 + t * r * (1.0 / (double)i);
    return ldexp(t, (int)k);
}

template <int MODE>
DI int colmap(int n) {
    if (MODE == 1) { const int pn = n >> 8, r = n & 255, bj = r >> 7, wc = (r >> 5) & 3, c = r & 31; return 256 * pn + 64 * wc + 32 * bj + c; }
    if (MODE == 2) { const int pn = n >> 8, r = n & 255; return r < 128 ? 128 * pn + r : 512 + 128 * pn + (r - 128); }
    return n;
}
template <int MODE>
DI void transpose_w(const float* W, int K, int N, bf16_t* WT, const float* kscale, LAS float* scr, int gw, int nw, int lane) {
    const int nblk = N >> 5, items = (K >> 6) * nblk;
    for (int item = gw; item < items; item += nw) {
        const int kb = item / nblk, nb = item - kb * nblk, k0 = 64 * kb, n0 = 32 * nb, col0 = colmap<MODE>(n0);
        float tv[32];
#pragma unroll
        for (int i = 0; i < 32; ++i) { const int kk = 2 * i + (lane >> 5); tv[i] = W[(size_t)(k0 + kk) * N + col0 + (lane & 31)]; }
        if (kscale) {
#pragma unroll
            for (int i = 0; i < 32; ++i) tv[i] *= kscale[k0 + 2 * i + (lane >> 5)]; }
#pragma unroll
        for (int i = 0; i < 32; ++i) { const int kk = 2 * i + (lane >> 5); scr[kk * 33 + (lane & 31)] = tv[i]; }
        asm volatile("s_waitcnt lgkmcnt(0)" ::: "memory");
        const int cc = lane & 7;
#pragma unroll
        for (int j = 0; j < 4; ++j) { const int n = (lane >> 3) + 8 * j; const LAS float* sp = scr + (8 * cc) * 33 + n;
            u32x4 o; o.x = cvt_pk_bf16(sp[0 * 33], sp[1 * 33]); o.y = cvt_pk_bf16(sp[2 * 33], sp[3 * 33]); o.z = cvt_pk_bf16(sp[4 * 33], sp[5 * 33]); o.w = cvt_pk_bf16(sp[6 * 33], sp[7 * 33]);
            *(u32x4*)(WT + (size_t)(n0 + n) * K + k0 + 8 * cc) = o; }
        asm volatile("s_waitcnt lgkmcnt(0)" ::: "memory");
    }
}

DI void ssm_prep(const Params& P, int lg, int qd, LAS unsigned char* lds, int tid) {
    LAS float* apr = (LAS float*)lds;
    LAS float* api = apr + 33 * 64;
    LAS float* bbr = api + 33 * 64;
    LAS float* bbi = bbr + 1024;
    LAS float* cr = bbi + 1024;
    LAS float* ci = cr + 1024;
    LAS float* ktab = ci + 1024;
    LAS float* part = ktab + 8192;
    LAS double* fz = (LAS double*)(part + 8192);
    const double dt = exp_d((double)P.log_dt[lg]);
    for (int idx = tid; idx < 33 * 64; idx += 512) {
        const int tau = idx >> 6, p = idx & 63;
        const double lr = (double)P.a_re[lg * 64 + p], li = (double)P.a_im[lg * 64 + p];
        const double mag = exp_d(lr * dt * (double)tau); double s, c; sincos_d(li * dt * (double)tau, s, c);
        apr[idx] = (float)(mag * c); api[idx] = (float)(mag * s);
        if (tau == 32 && qd == 0) { float* a32 = (float*)(P.ws + WS_MISC) + (size_t)(lg * 64 + p) * 2; a32[0] = (float)(mag * c); a32[1] = (float)(mag * s); }
        if (tau == 1) {
            const double nr = mag * c - 1.0, ni = mag * s, den = lr * lr + li * li;
            fz[2 * p] = (nr * lr + ni * li) / den; fz[2 * p + 1] = (ni * lr - nr * li) / den; }
    }
    for (int idx = tid; idx < 1024; idx += 512) { cr[idx] = P.c_re[(size_t)lg * 1024 + idx]; ci[idx] = P.c_im[(size_t)lg * 1024 + idx]; }
    __syncthreads();
    for (int idx = tid; idx < 1024; idx += 512) { const int p = idx >> 4; const double fr_ = fz[2 * p], fi_ = fz[2 * p + 1];
        const double br = (double)P.b_re[(size_t)lg * 1024 + idx], bi = (double)P.b_im[(size_t)lg * 1024 + idx];
        bbr[idx] = (float)(fr_ * br - fi_ * bi); bbi[idx] = (float)(fr_ * bi + fi_ * br); }
    __syncthreads();
    {
        const int hh = tid & 255, hp = hh >> 4, h = hh & 15, ph = tid >> 8;
        float cbr[32], cbi[32];
#pragma unroll
        for (int i = 0; i < 32; ++i) { const int p = 32 * ph + i; const float c_r = cr[h * 64 + p], c_i = ci[h * 64 + p], x_r = bbr[p * 16 + hp], x_i = bbi[p * 16 + hp];
            cbr[i] = c_r * x_r - c_i * x_i; cbi[i] = c_r * x_i + c_i * x_r; }
        for (int tau = 0; tau < 32; ++tau) { float acc = 0.f;
#pragma unroll
            for (int i = 0; i < 32; ++i) acc += apr[tau * 64 + 32 * ph + i] * cbr[i] - api[tau * 64 + 32 * ph + i] * cbi[i];
            if (ph) part[tau * 256 + hh] = acc; else ktab[tau * 256 + hh] = acc; }
    }
    __syncthreads();
    for (int o = tid; o < 8192; o += 512) ktab[o] += part[o];
    __syncthreads();
    bf16_t* W1 = (bf16_t*)(P.ws + WS_W1) + (size_t)lg * 256 * 512;
    for (int it = tid; it < 128 * 64; it += 512) {
        const int n = 128 * qd + (it >> 6), k8 = it & 63, s = k8 >> 1, hp0 = (k8 & 1) * 8; float v[8];
#pragma unroll
        for (int i = 0; i < 8; ++i) {
            if (n < 128) { const int p = n & 63; const float ar = apr[(31 - s) * 64 + p], ai = api[(31 - s) * 64 + p], xr = bbr[p * 16 + hp0 + i], xi = bbi[p * 16 + hp0 + i];
                v[i] = n < 64 ? ar * xr - ai * xi : ar * xi + ai * xr; }
            else v[i] = 0.f;
        }
        u32x4 o; o.x = cvt_pk_bf16(v[0], v[1]); o.y = cvt_pk_bf16(v[2], v[3]); o.z = cvt_pk_bf16(v[4], v[5]); o.w = cvt_pk_bf16(v[6], v[7]);
        *(u32x4*)(W1 + (size_t)n * 512 + k8 * 8) = o;
    }
    bf16_t* TP = (bf16_t*)(P.ws + WS_TOEP) + (size_t)lg * 512 * 640;
    for (int it = tid; it < 256 * 80; it += 512) {
        const int n = 256 * qd + it / 80, k8 = it % 80, t = n >> 4, h = n & 15; float v[8];
        if (k8 < 64) { const int s = k8 >> 1, hp0 = (k8 & 1) * 8;
#pragma unroll
            for (int i = 0; i < 8; ++i) v[i] = (s <= t) ? ktab[(t - s) * 256 + (hp0 + i) * 16 + h] : 0.f;
        } else if (k8 < 72) {
#pragma unroll
            for (int i = 0; i < 8; ++i) { const int p = (k8 - 64) * 8 + i; v[i] = cr[h * 64 + p] * apr[(t + 1) * 64 + p] - ci[h * 64 + p] * api[(t + 1) * 64 + p]; }
        } else {
#pragma unroll
            for (int i = 0; i < 8; ++i) { const int p = (k8 - 72) * 8 + i; v[i] = -(cr[h * 64 + p] * api[(t + 1) * 64 + p] + ci[h * 64 + p] * apr[(t + 1) * 64 + p]); }
        }
        u32x4 o; o.x = cvt_pk_bf16(v[0], v[1]); o.y = cvt_pk_bf16(v[2], v[3]); o.z = cvt_pk_bf16(v[4], v[5]); o.w = cvt_pk_bf16(v[6], v[7]);
        *(u32x4*)(TP + (size_t)n * 640 + k8 * 8) = o;
    }
    __syncthreads();
}

#define XB_TMO      128
#define XB_XCNT(j)  (256  + 64 * (j))
#define XB_XSUB(j)  (1280 + 64 * (j))
#define XB_XGEN(j)  (2304 + 64 * (j))
#define XB_TOP      3328
#define XB_TOPGEN   3392
#define XCD_BAR_WORDS 3456
#define XB_SPIN_CAP (1u << 18)
DI unsigned xb_ld(unsigned* p) { return __hip_atomic_load(p, __ATOMIC_RELAXED, __HIP_MEMORY_SCOPE_AGENT); }
DI unsigned xb_add(unsigned* p, unsigned v) { return __hip_atomic_fetch_add(p, v, __ATOMIC_RELAXED, __HIP_MEMORY_SCOPE_AGENT); }
DI unsigned xb_xcc_id() { return (unsigned)__builtin_amdgcn_s_getreg((3 << 11) | 20) & 0xFu; }
#define XB_SPIN(cond, bar) do { unsigned _sp = 0; while (cond) { __builtin_amdgcn_s_sleep(1); \
    if ((++_sp & 255u) == 0u) { if (xb_ld(&(bar)[XB_TMO])) break; if (_sp > XB_SPIN_CAP) { atomicAdd(&(bar)[XB_TMO], 1u); break; } } } } while (0)
DI void xcd_barrier_complete(unsigned* bar, unsigned x, unsigned G, unsigned& nloc, unsigned& nx) {
    unsigned sum, cnt, mine, sp = 0u;
    for (;;) {
        sum = 0u; cnt = 0u; mine = 0u;
#pragma unroll 1
        for (unsigned j = 0; j < 16; ++j) { const unsigned cj = xb_ld(&bar[XB_XCNT(j)]); sum += cj; cnt += (cj > 0u) ? 1u : 0u; mine = (j == x) ? cj : mine; }
        if (sum == G) break;
        __builtin_amdgcn_s_sleep(1);
        if ((++sp & 255u) == 0u) { if (xb_ld(&bar[XB_TMO])) break; if (sp > XB_SPIN_CAP) { atomicAdd(&bar[XB_TMO], 1u); break; } }
    }
    nloc = mine > 0u ? mine : 1u; nx = cnt > 0u ? cnt : 1u;
}
DI void xcd_barrier(unsigned* bar, volatile LAS unsigned* st, const int wid) {
    asm volatile("" : "+s"(bar));
    asm volatile("s_waitcnt vmcnt(0)" ::: "memory");
    __syncthreads();
    if (wid == 0 && lane_fresh() == 0) {
        const unsigned x = xb_xcc_id();
        __builtin_amdgcn_s_waitcnt(0);
        const unsigned nloc = st[0], nx = st[1];
        const unsigned old = xb_add(&bar[XB_XSUB(x)], 1u);
        const unsigned gen = old / nloc;
        if (old + 1u == (gen + 1u) * nloc) {
            __builtin_amdgcn_fence(__ATOMIC_RELEASE, "agent");
            asm volatile("s_waitcnt vmcnt(0)" ::: "memory");
            const unsigned og = xb_add(&bar[XB_TOP], 1u);
            const unsigned tg = og / nx;
            if (og + 1u == (tg + 1u) * nx) xb_add(&bar[XB_TOPGEN], 1u);
            else XB_SPIN(xb_ld(&bar[XB_TOPGEN]) == tg, bar);
            __builtin_amdgcn_fence(__ATOMIC_ACQUIRE, "agent");
            xb_add(&bar[XB_XGEN(x)], 1u);
            asm volatile("s_waitcnt vmcnt(0)" ::: "memory");
        } else {
            XB_SPIN(xb_ld(&bar[XB_XGEN(x)]) == gen, bar);
            __builtin_amdgcn_fence(__ATOMIC_ACQUIRE, "agent");
            asm volatile("s_waitcnt vmcnt(0)" ::: "memory");
        }
    }
    __syncthreads();
}

__global__ void __launch_bounds__(512) mega(Params P) {
    extern __shared__ __attribute__((aligned(16))) unsigned char shm[];
    LAS unsigned char* lds = (LAS unsigned char*)shm;
    cg::grid_group grid = cg::this_grid();
    const int wid = __builtin_amdgcn_readfirstlane(threadIdx.x >> 6);
    const int G = gridDim.x, c = blockIdx.x;
    const int gthreads = G * 512;
#define LANE lane_fresh()
#define TID (wid * 64 + lane_fresh())
#define GTID (c * 512 + wid * 64 + lane_fresh())
    unsigned char* ws = P.ws;
    float* ssb = (float*)(ws + WS_MISC + 65536);
    bf16_t* hbA = (bf16_t*)(ws + WS_HBA);
    bf16_t* Ucat = (bf16_t*)(ws + WS_UCAT);
    bf16_t* SG = (bf16_t*)(ws + WS_SGGA); bf16_t* GA = SG + (size_t)T * 512; bf16_t* hbB = SG;
    bf16_t* Qb = (bf16_t*)(ws + WS_QK); bf16_t* Kb = Qb + (size_t)T * 512; bf16_t* pp = Qb;
    bf16_t* VT = (bf16_t*)(ws + WS_VT); bf16_t* zb = (bf16_t*)(ws + WS_ZB);
    bf16_t* cat = (bf16_t*)(ws + WS_CAT);
    float* Sbuf = (float*)(ws + WS_SBUF);
    bf16_t* pb = (bf16_t*)(ws + WS_PB);

    unsigned* bar = (unsigned*)(ws + WS_MISC + 786432);
    volatile LAS unsigned* xst = (volatile LAS unsigned*)(lds + STAGE_BYTES);
#define GSYNC() xcd_barrier(bar, xst, wid)
    if (wid == 0 && LANE == 0) { xst[0] = 0u; xst[1] = 0u; (void)xb_add(&bar[XB_XCNT(xb_xcc_id())], 1u); }
    if (P.ws == nullptr) grid.sync();
    for (int rep = 0; rep < REP_P0; ++rep) {
    const int role = (c >> 3) & 1, sc = ((c >> 4) << 3) | (c & 7), SG_ = G >> 1;
    const int sthreads = SG_ * 512;
    if (role == 0) ssm_prep(P, sc >> 1, sc & 1, lds, TID);
    { const int lane = LANE; LAS float* scr = (LAS float*)lds + wid * (64 * 33); const int l = role == 0 ? 1 : 0;
    for (int i = sc * 512 + TID; i < 3 * T; i += SG_ * 512) if (role == 1) ssb[T + i] = 0.f;
    {
        transpose_w<1>(P.w_in + (size_t)l * 1024 * 3072, 1024, 3072, (bf16_t*)(ws + WS_WIN) + (size_t)l * 3072 * 1024, P.mix_g + l * 1024, scr, sc * 8 + wid, SG_ * 8, lane);
        transpose_w<2>(P.w_glu + (size_t)l * 512 * 1024, 512, 1024, (bf16_t*)(ws + WS_WGLU) + (size_t)l * 1024 * 512, nullptr, scr, sc * 8 + wid, SG_ * 8, lane);
        transpose_w<0>(P.w_out + (size_t)l * 1024 * 1024, 1024, 1024, (bf16_t*)(ws + WS_WOUT) + (size_t)l * 1024 * 1024, nullptr, scr, sc * 8 + wid, SG_ * 8, lane);
        transpose_w<0>(P.w_pg + (size_t)l * 1024 * 1024, 1024, 1024, (bf16_t*)(ws + WS_WPG) + (size_t)l * 1024 * 1024, P.ple_g + l * 1024, scr, sc * 8 + wid, SG_ * 8, lane);
        transpose_w<0>(P.w_pp + (size_t)l * 256 * 1024, 256, 1024, (bf16_t*)(ws + WS_WPP) + (size_t)l * 1024 * 256, nullptr, scr, sc * 8 + wid, SG_ * 8, lane);
    } }
    if (role == 1)
    for (int row = (sc * 8 + wid) * 2; row < T; row += SG_ * 16) {
        const int lane = LANE;
        const f32x4* xr = (const f32x4*)(P.x + (size_t)row * 1024); f32x4 v[2][4];
#pragma unroll
        for (int r2 = 0; r2 < 2; ++r2)
#pragma unroll
            for (int j = 0; j < 4; ++j) v[r2][j] = xr[r2 * 256 + lane + 64 * j];
#pragma unroll
        for (int r2 = 0; r2 < 2; ++r2) { float s = 0.f;
#pragma unroll
            for (int j = 0; j < 4; ++j) { const f32x4 q = v[r2][j]; s += (q[0] * q[0] + q[1] * q[1]) + (q[2] * q[2] + q[3] * q[3]);
                u32x2 w; w.x = cvt_pk_bf16(q[0], q[1]); w.y = cvt_pk_bf16(q[2], q[3]); *(u32x2*)(hbA + (size_t)(row + r2) * 1024 + (lane + 64 * j) * 4) = w; }
#pragma unroll
            for (int o = 1; o < 64; o <<= 1) s += __shfl_xor(s, o);
            if (lane == 0) ssb[row + r2] = s; }
    }
    { const size_t pbase = (size_t)(role == 0 ? 1 : 0) * T * 256 / 8, pend = pbase + (size_t)T * 256 / 8;
    for (size_t i = pbase + sc * 512 + TID; i < pend; i += (size_t)4 * sthreads) {
        f32x4 a[4], b[4];
#pragma unroll
        for (int q = 0; q < 4; ++q) { const size_t ii = i + (size_t)q * sthreads; if (ii < pend) { a[q] = ((const f32x4*)P.p)[2 * ii]; b[q] = ((const f32x4*)P.p)[2 * ii + 1]; } }
#pragma unroll
        for (int q = 0; q < 4; ++q) { const size_t ii = i + (size_t)q * sthreads; if (ii < pend) {
            u32x4 o; o.x = cvt_pk_bf16(a[q][0], a[q][1]); o.y = cvt_pk_bf16(a[q][2], a[q][3]); o.z = cvt_pk_bf16(b[q][0], b[q][1]); o.w = cvt_pk_bf16(b[q][2], b[q][3]);
            ((u32x4*)pb)[ii] = o; } }
    }
    }
    }
    if (wid == 0 && LANE == 0) { unsigned nloc, nx; xcd_barrier_complete(bar, xb_xcc_id(), G, nloc, nx); xst[0] = nloc; xst[1] = nx; }
    GSYNC();

    auto layer = [&](const int l) __attribute__((always_inline)) {
        float* ssIn = ssb + (size_t)(2 * l) * T; float* ssMid = ssb + (size_t)(2 * l + 1) * T; float* ssNext = ssb + (size_t)(2 * l + 2 > 3 ? 3 : 2 * l + 2) * T;
        { Gemm g{hbA, (const bf16_t*)(ws + WS_WIN) + (size_t)l * 3072 * 1024, 1024, 1024, 1024, 0, 0};
          Order S; S.init(T / 256, 12, 1, G, c);
          EpiIn E{ssIn, Ucat, SG, GA, Qb, Kb, VT, P.q_g + l * 64, P.k_g + l * 64};
          for (int rep = 0; rep < REP_INPROJ; ++rep) gemm_phase(lds, g, S, E, wid); }
        GSYNC();
        { Gemm g{Ucat, (const bf16_t*)(ws + WS_W1) + (size_t)l * 32 * 256 * 512, 640, 512, 512, (size_t)1024 * 640, (size_t)256 * 512};
          Order S; S.init(4, 1, 32, G, c);
          EpiS E{Sbuf};
          for (int rep = 0; rep < REP_GEMMS; ++rep) gemm_phase(lds, g, S, E, wid); }
        if (c < 128) {
            asm volatile("s_waitcnt vmcnt(0)" ::: "memory"); __syncthreads();
            const int lane = LANE, seg = lane >> 4, pl = lane & 15;
            const int q_ = c >> 3, L_ = ((c & 7) * 4 + (q_ >> 2)) * 4 + (q_ & 3);
            const int pq = wid & 3, g = L_ >> 2, b = 2 * (L_ & 3) + (wid >> 2), p = pq * 16 + pl;
            const float* a32 = (const float*)(ws + WS_MISC) + (size_t)((l * 32 + g) * 64 + p) * 2; const float ar = a32[0], ai = a32[1];
            const size_t row0 = (size_t)g * 1024 + b * 128 + seg * 32;
            const float* __restrict__ Sp = Sbuf + row0 * 128 + p;
            float sr[32], si[32];
#pragma unroll
            for (int j = 0; j < 32; ++j) { sr[j] = Sp[(size_t)j * 128]; si[j] = Sp[(size_t)j * 128 + 64]; }
            float hr = 0.f, hi = 0.f, wr_ = 1.f, wi_ = 0.f;
#pragma unroll
            for (int j = 0; j < 32; ++j) { const float nr = ar * hr - ai * hi + sr[j], ni = ar * hi + ai * hr + si[j]; hr = nr; hi = ni;
                const float xr = ar * wr_ - ai * wi_, xi = ar * wi_ + ai * wr_; wr_ = xr; wi_ = xi; }
            const float e0r = __shfl(hr, pl), e0i = __shfl(hi, pl), e1r = __shfl(hr, pl + 16), e1i = __shfl(hi, pl + 16), e2r = __shfl(hr, pl + 32), e2i = __shfl(hi, pl + 32);
            const float h1r = e0r, h1i = e0i;
            const float h2r = wr_ * h1r - wi_ * h1i + e1r, h2i = wr_ * h1i + wi_ * h1r + e1i;
            const float h3r = wr_ * h2r - wi_ * h2i + e2r, h3i = wr_ * h2i + wi_ * h2r + e2i;
            const float cinr = seg == 0 ? 0.f : seg == 1 ? h1r : seg == 2 ? h2r : h3r, cini = seg == 0 ? 0.f : seg == 1 ? h1i : seg == 2 ? h2i : h3i;
            bf16_t* __restrict__ Up = Ucat + row0 * 640 + 512 + p;
            hr = 0.f; hi = 0.f; float cr_ = cinr, ci_ = cini;
#pragma unroll
            for (int j = 0; j < 32; ++j) {
                const unsigned pk = cvt_pk_bf16(hr + cr_, hi + ci_);
                Up[(size_t)j * 640] = (bf16_t)(pk & 0xffffu); Up[(size_t)j * 640 + 64] = (bf16_t)(pk >> 16);
                const float nr = ar * hr - ai * hi + sr[j], ni = ar * hi + ai * hr + si[j]; hr = nr; hi = ni;
                const float xr = ar * cr_ - ai * ci_, xi = ar * ci_ + ai * cr_; cr_ = xr; ci_ = xi; }
            asm volatile("s_waitcnt vmcnt(0)" ::: "memory"); __syncthreads();
            { Gemm gy{Ucat, (const bf16_t*)(ws + WS_TOEP) + (size_t)l * 32 * 512 * 640, 640, 640, 640, (size_t)1024 * 640, (size_t)512 * 640};
              Order SY; SY.nwg = -1; SY.nM = g; SY.nN = L_ & 3; SY.lim = 2; SY.total = 0; SY.G = 0; SY.c = 0;
              EpiY EY{Ucat, P.dsk + l * 512, zb};
              for (int rep = 0; rep < REP_Y; ++rep) gemm_phase(lds, gy, SY, EY, wid); }
        }
        for (int rep = 0; rep < REP_ATTN; ++rep)
        {
            const int nit = c < 128 ? 1 : 7, base = c < 128 ? (c * 8 + wid) : 1024 + (c - 128) * 56 + wid;
            for (int j = 0; j < nit; ++j) attn_item(base + 8 * j, Qb, Kb, VT, GA, cat, LANE); }
        GSYNC();
        { Gemm g{zb, (const bf16_t*)(ws + WS_WGLU) + (size_t)l * 1024 * 512, 512, 512, 512, 0, 0};
          Order S; S.init(T / 256, 4, 1, G, c);
          EpiGlu E{P.b_glu + l * 1024, SG, cat};
          for (int rep = 0; rep < REP_GLU; ++rep) gemm_phase(lds, g, S, E, wid); }
        { Gemm g{pb + (size_t)l * T * 256, (const bf16_t*)(ws + WS_WPP) + (size_t)l * 1024 * 256, 256, 256, 256, 0, 0};
          Order S; S.init(T / 256, 4, 1, G, c);
          EpiPP E{pp};
          for (int rep = 0; rep < REP_PP; ++rep) gemm_phase(lds, g, S, E, wid); }
        GSYNC();
        { Gemm g{cat, (const bf16_t*)(ws + WS_WOUT) + (size_t)l * 1024 * 1024, 1024, 1024, 1024, 0, 0};
          Order S; S.init(T / 256, 4, 1, G, c);
          EpiOut E{hbA, hbB, ssMid};
          gemm_phase(lds, g, S, E, wid); }
        GSYNC();
        { Gemm g{hbB, (const bf16_t*)(ws + WS_WPG) + (size_t)l * 1024 * 1024, 1024, 1024, 1024, 0, 0};
          Order S; S.init(T / 256, 4, 1, G, c);
          EpiPle E{ssMid, hbB, P.out, pp, hbA, ssNext, l == 1 ? 1 : 0};
          gemm_phase(lds, g, S, E, wid); }
        if (l == 0) GSYNC();
    };
    layer(0); layer(1);
}

extern "C" void kernel_launch(void* const* d_in, const int* in_sizes, int n_in, void* d_out, int out_size, void* d_ws, size_t ws_size, hipStream_t stream) {
    static int grid = 0;
    if (grid == 0) {
        if (n_in != 20 || ws_size < WS_END) { fprintf(stderr, "kernel_launch: unexpected inputs (n_in %d, ws %zu < %zu)\n", n_in, ws_size, (size_t)WS_END); grid = -1; return; }
        int dev = 0, cus = 0, per_cu = 0;
        hipGetDevice(&dev); hipDeviceGetAttribute(&cus, hipDeviceAttributeMultiprocessorCount, dev);
        if (hipFuncSetAttribute((const void*)mega, hipFuncAttributeMaxDynamicSharedMemorySize, LDS_BYTES) != hipSuccess) { fprintf(stderr, "hipFuncSetAttribute failed\n"); grid = -1; return; }
        if (hipOccupancyMaxActiveBlocksPerMultiprocessor(&per_cu, (const void*)mega, 512, LDS_BYTES) != hipSuccess || per_cu < 1) { fprintf(stderr, "occupancy query: %d\n", per_cu); per_cu = 1; }
        (void)hipGetLastError();
        if (cus < 256) { fprintf(stderr, "kernel_launch: built for a 256-CU device (static work partition over 256 workgroups), found %d CUs; nothing launched\n", cus); grid = -1; return; }
        grid = 256;
    }
    if (grid < 0) return;
    if (hipMemsetAsync((char*)d_ws + WS_MISC + 786432, 0, XCD_BAR_WORDS * 4, stream) != hipSuccess) { fprintf(stderr, "kernel_launch: hipMemsetAsync failed\n"); return; }
    Params P{};
    const float** pp = (const float**)&P;
    for (int i = 0; i < 20; ++i) pp[i] = (const float*)d_in[i];
    P.out = (float*)d_out; P.ws = (unsigned char*)d_ws;
    void* args[] = {&P};
    hipError_t e = hipLaunchCooperativeKernel((const void*)mega, dim3(grid), dim3(512), args, LDS_BYTES, stream);
    if (e != hipSuccess) fprintf(stderr, "cooperative launch failed: %s (grid %d)\n", hipGetErrorString(e), grid);
}
```

```cpp
#ifndef REP_P0
#define REP_P0 1
#define REP_INPROJ 1
#define REP_ATTN 1
#define REP_SCAN 1
#define REP_SYNC 1
#define REP_GEMMS 1
#define REP_PP 1
#define REP_Y 1
#define REP_GLU 1
#endif
#include <hip/hip_runtime.h>
#include <hip/hip_cooperative_groups.h>
#include <cstdio>
namespace cg = cooperative_groups;

#define LAS __attribute__((address_space(3)))
#define DI __device__ __forceinline__
typedef unsigned short bf16_t;
typedef short bf16x8 __attribute__((ext_vector_type(8)));
typedef float f32x4 __attribute__((ext_vector_type(4)));
typedef float f32x16 __attribute__((ext_vector_type(16)));
typedef unsigned u32x4 __attribute__((ext_vector_type(4)));
typedef unsigned u32x2 __attribute__((ext_vector_type(2)));

constexpr int T = 32768, SEQ = 4096;
constexpr int BM = 256, BK = 64, HALF = 128, HTB = HALF * BK * 2, STAGE_BYTES = 8 * HTB, NXCD = 8, WGM = 2;
constexpr int LDS_DUMMY = STAGE_BYTES + 16;
constexpr int LDS_BYTES = STAGE_BYTES + 16 + 2048;

constexpr size_t MBy = 1u << 20;
constexpr size_t WS_WIN = 0;
constexpr size_t WS_WGLU = WS_WIN + 12 * MBy;
constexpr size_t WS_WOUT = WS_WGLU + 2 * MBy;
constexpr size_t WS_WPG = WS_WOUT + 4 * MBy;
constexpr size_t WS_WPP = WS_WPG + 4 * MBy;
constexpr size_t WS_W1 = WS_WPP + 1 * MBy;
constexpr size_t WS_TOEP = WS_W1 + 16 * MBy;
constexpr size_t WS_MISC = WS_TOEP + 40 * MBy;
constexpr size_t WS_HBA = WS_MISC + 1 * MBy;
constexpr size_t WS_UCAT = WS_HBA + 64 * MBy;
constexpr size_t WS_SGGA = WS_UCAT + 40 * MBy;
constexpr size_t WS_QK = WS_SGGA + 64 * MBy;
constexpr size_t WS_VT = WS_QK + 64 * MBy;
constexpr size_t WS_CAT = WS_VT + 32 * MBy;
constexpr size_t WS_SBUF = WS_CAT + 64 * MBy;
constexpr size_t WS_PB = WS_SBUF + 16 * MBy;
constexpr size_t WS_ZB = WS_PB + 32 * MBy;
constexpr size_t WS_END = WS_ZB + 32 * MBy;

struct Params {
    const float *x, *p, *mix_g, *w_in, *a_re, *a_im, *log_dt, *b_re, *b_im, *c_re, *c_im, *dsk, *w_glu, *b_glu, *q_g, *k_g, *w_out, *ple_g, *w_pg, *w_pp;
    float* out; unsigned char* ws;
};

DI int lane_fresh() { int l; asm volatile("v_mbcnt_lo_u32_b32 %0, -1, 0\n\tv_mbcnt_hi_u32_b32 %0, -1, %0" : "=v"(l)); return l; }
DI unsigned cvt_pk_bf16(float lo, float hi) { unsigned r; asm volatile("v_cvt_pk_bf16_f32 %0, %1, %2" : "=v"(r) : "v"(lo), "v"(hi)); return r; }
DI float bf_lo(unsigned w) { return __uint_as_float(w << 16); }
DI float bf_hi(unsigned w) { return __uint_as_float(w & 0xffff0000u); }
DI float fsigmoid(float x) { return __builtin_amdgcn_rcpf(1.0f + __expf(-x)); }
DI float fsilu(float x) { return x * fsigmoid(x); }
DI float fgelu_tanh(float y) { const float u2 = 1.5957691216057308f * (y + 0.044715f * y * y * y); return y * fsigmoid(u2); }

DI int lds_byte(int r, int c) { const int st = (r >> 4) * 2 + (c >> 5), rr = r & 15, cc = c & 31, ob = rr * 64 + cc * 2; return st * 1024 + (ob ^ (((ob >> 9) & 1) << 5)); }
DI void stage_rc(int b, int& R, int& C) { const int st = b / 1024, sb = b % 1024, swz = sb ^ (((sb >> 9) & 1) << 5); R = (st >> 1) * 16 + swz / 64; C = (st & 1) * 32 + (swz % 64) / 2; }

struct Unit { int pm, pn, g; };
struct Gemm { const bf16_t* A; const bf16_t* Bt; int lda, ldb, K; size_t gsA, gsB; };
struct Order {
    int nM, nN, nwg, total, G, c, lim;
    DI void init(int nM_, int nN_, int nG, int G_, int c_) { nM = nM_; nN = nN_; nwg = nM * nN; total = nwg * nG; lim = total; G = G_; c = c_; asm volatile("" : "+s"(c)); }
    DI bool next(int i, Unit& u) const {
        if (nwg < 0) { if (i >= lim) return false; u.g = nM; u.pm = nN; u.pn = i; return true; }
        int L = i * G + c; if (L >= lim) return false;
        if (total > nwg) {
            const int gpx = (total / nwg) >> 3, q = (c >> 3) + (G >> 3) * i; if (q >= gpx * nwg) return false;
            L = ((c & 7) * gpx + q / nwg) * nwg + q % nwg; }
        u.g = L / nwg; int wgid = L - u.g * nwg;
        { const int q = nwg / NXCD, r = nwg % NXCD, xcd = wgid % NXCD, off = wgid / NXCD; wgid = (xcd < r ? xcd * (q + 1) : r * (q + 1) + (xcd - r) * q) + off; }
        const int nig = WGM * nN, gid = wgid / nig, fm = gid * WGM, gsz = (nM - fm) < WGM ? (nM - fm) : WGM;
        u.pm = fm + ((wgid % nig) % gsz); u.pn = (wgid % nig) / gsz; return true;
    }
};

template <class Epi>
DI void gemm_phase(LAS unsigned char* lds, const Gemm g, const Order& S, const Epi& E, const int wid) {
    const int lane = lane_fresh(), tid = wid * 64 + lane, wr = wid >> 2, wc = wid & 3, fr = lane & 15, fq = lane >> 4;
    const int K = g.K, nt = K / BK;
    unsigned voffA[2], voffB[2];
#pragma unroll
    for (int i = 0; i < 2; ++i) { int R, C; stage_rc(tid * 16 + i * 8192, R, C); voffA[i] = (unsigned)(R * g.lda + C) * 2u; voffB[i] = (unsigned)(R * g.ldb + C) * 2u; }
    const size_t kstep = (size_t)(BK * 2);
    const size_t hstepA = (size_t)HALF * g.lda * 2, hstepB = (size_t)HALF * g.ldb * 2;
    const size_t tstepA = 2 * hstepA, tstepB = 2 * hstepB;
    const unsigned ldsw = (unsigned)wid * 1024u;
    const int aoff = lds_byte(wr * 64 + fr, fq * 8), boff = lds_byte(wc * 32 + fr, fq * 8);
#define PG8_SA(b, h) (((b) * 2 + (h)) * HTB)
#define PG8_SB(b, h) ((4 + (b) * 2 + (h)) * HTB)
#define PG8_STAGE(bufoff, gbase, voff) do { _Pragma("unroll") for (int _i = 0; _i < 2; ++_i) \
        __builtin_amdgcn_global_load_lds((const unsigned*)((const char*)(gbase) + (voff)[_i]), (LAS unsigned*)(lds + (bufoff) + ldsw + _i * 8192), 16, 0, 0); } while (0)
#define PG8_LDA(dst, b, h) do { _Pragma("unroll") for (int m = 0; m < 4; ++m) _Pragma("unroll") for (int k = 0; k < 2; ++k) dst[m][k] = *(const LAS bf16x8*)(lds + PG8_SA(b, h) + aoff + m * 2048 + k * 1024); } while (0)
#define PG8_LDB(dst, b, h) do { _Pragma("unroll") for (int n = 0; n < 2; ++n) _Pragma("unroll") for (int k = 0; k < 2; ++k) dst[n][k] = *(const LAS bf16x8*)(lds + PG8_SB(b, h) + boff + n * 2048 + k * 1024); } while (0)
#define PG8_MMA(ai, bj, At, Bt) do { __builtin_amdgcn_s_setprio(1); _Pragma("unroll") for (int m = 0; m < 4; ++m) _Pragma("unroll") for (int n = 0; n < 2; ++n) _Pragma("unroll") for (int k = 0; k < 2; ++k) \
        acc[ai][bj][m][n] = __builtin_amdgcn_mfma_f32_16x16x32_bf16(Bt[n][k], At[m][k], acc[ai][bj][m][n], 0, 0, 0); __builtin_amdgcn_s_setprio(0); } while (0)
#define PG8_WAIT_V(n) asm volatile("s_waitcnt vmcnt(" #n ")" ::: "memory")
#define PG8_WAIT_L(n) asm volatile("s_waitcnt lgkmcnt(" #n ")" ::: "memory")
#define PG8_BAR __builtin_amdgcn_s_barrier()
#define PG8_SCHED __builtin_amdgcn_sched_barrier(0)
    Unit cur, nxt; int ui = 0;
    if (!S.next(0, cur)) return;
    f32x4 acc[2][2][4][2];
#pragma unroll
    for (int a = 0; a < 2; ++a)
#pragma unroll
        for (int b = 0; b < 2; ++b)
#pragma unroll
            for (int m = 0; m < 4; ++m)
#pragma unroll
                for (int n = 0; n < 2; ++n) acc[a][b][m][n] = (f32x4){0.f, 0.f, 0.f, 0.f};
    bf16x8 At[4][2], B0[2][2], B1[2][2];
    const char* cA = (const char*)(g.A + (size_t)cur.g * g.gsA) + (size_t)cur.pm * tstepA;
    const char* cB = (const char*)(g.Bt + (size_t)cur.g * g.gsB) + (size_t)cur.pn * tstepB;
    PG8_STAGE(PG8_SB(0, 0), cB, voffB); PG8_STAGE(PG8_SB(0, 1), cB + hstepB, voffB); PG8_STAGE(PG8_SA(0, 0), cA, voffA); PG8_STAGE(PG8_SA(0, 1), cA + hstepA, voffA);
    if (wr == 1) PG8_BAR;
    PG8_WAIT_V(2); PG8_BAR;
    PG8_STAGE(PG8_SB(1, 0), cB + kstep, voffB); PG8_STAGE(PG8_SA(1, 0), cA + kstep, voffA); PG8_STAGE(PG8_SB(1, 1), cB + hstepB + kstep, voffB);
    PG8_WAIT_V(6); PG8_BAR;
    for (;;) {
        const bool has_next = S.next(ui + 1, nxt);
        const char* nA = has_next ? (const char*)(g.A + (size_t)nxt.g * g.gsA) + (size_t)nxt.pm * tstepA : cA;
        const char* nB = has_next ? (const char*)(g.Bt + (size_t)nxt.g * g.gsB) + (size_t)nxt.pn * tstepB : cB;
        for (int t = 0; t < nt; t += 2) {
            const bool last = (t == nt - 2);
            const char* a1 = cA + (size_t)(t + 1) * kstep;
            const char* a2 = last ? nA : cA + (size_t)(t + 2) * kstep; const char* b2 = last ? nB : cB + (size_t)(t + 2) * kstep;
            const char* a3 = a2 + kstep; const char* b3 = b2 + kstep;
            if (t == nt - 2) E.prefetch(cur, lds, wid);
            PG8_LDB(B0, 0, 0); PG8_LDB(B1, 0, 1); PG8_SCHED; PG8_LDA(At, 0, 0); PG8_STAGE(PG8_SA(1, 1), a1 + hstepA, voffA);
            PG8_WAIT_V(8); PG8_WAIT_L(0); PG8_BAR; PG8_MMA(0, 0, At, B0); PG8_MMA(0, 1, At, B1); PG8_BAR; PG8_SCHED;
            PG8_LDA(At, 0, 1); PG8_STAGE(PG8_SB(0, 0), b2, voffB); PG8_STAGE(PG8_SB(0, 1), b2 + hstepB, voffB); PG8_STAGE(PG8_SA(0, 0), a2, voffA);
            PG8_WAIT_V(8); PG8_WAIT_L(0); PG8_BAR; PG8_MMA(1, 0, At, B0); PG8_MMA(1, 1, At, B1); PG8_BAR; PG8_SCHED;
            PG8_LDB(B0, 1, 0); PG8_LDB(B1, 1, 1); PG8_SCHED; PG8_LDA(At, 1, 0); PG8_STAGE(PG8_SA(0, 1), a2 + hstepA, voffA);
            PG8_WAIT_V(8); PG8_WAIT_L(0); PG8_BAR; PG8_MMA(0, 0, At, B0); PG8_MMA(0, 1, At, B1); PG8_BAR; PG8_SCHED;
            PG8_LDA(At, 1, 1); PG8_STAGE(PG8_SB(1, 0), b3, voffB); PG8_STAGE(PG8_SB(1, 1), b3 + hstepB, voffB); PG8_STAGE(PG8_SA(1, 0), a3, voffA);
            PG8_WAIT_V(8); PG8_WAIT_L(0); PG8_BAR; PG8_MMA(1, 0, At, B0); PG8_MMA(1, 1, At, B1); PG8_BAR; PG8_SCHED;
        }
        if (wr == 0) PG8_BAR;
        { const int le = lane_fresh(); E(acc, cur, wr, wc, le & 15, le >> 4); }
        if (!has_next) break;
#pragma unroll
        for (int a = 0; a < 2; ++a)
#pragma unroll
            for (int b = 0; b < 2; ++b)
#pragma unroll
                for (int m = 0; m < 4; ++m)
#pragma unroll
                    for (int n = 0; n < 2; ++n) acc[a][b][m][n] = (f32x4){0.f, 0.f, 0.f, 0.f};
        cur = nxt; cA = nA; cB = nB; ++ui;
        if (wr == 1) PG8_BAR;
    }
    PG8_WAIT_V(0);
    PG8_BAR;
#undef PG8_SA
#undef PG8_SB
#undef PG8_STAGE
#undef PG8_LDA
#undef PG8_LDB
#undef PG8_MMA
#undef PG8_WAIT_V
#undef PG8_WAIT_L
#undef PG8_BAR
#undef PG8_SCHED
}

#define EPI_ROWS _Pragma("unroll") for (int ai = 0; ai < 2; ++ai) _Pragma("unroll") for (int m = 0; m < 4; ++m) if ((__extension__({ if ((m & 1) == 0) asm volatile("" ::: "memory"); 1; })))
#define EPI_ROWS_NF _Pragma("unroll") for (int ai = 0; ai < 2; ++ai) _Pragma("unroll") for (int m = 0; m < 4; ++m)
#define EPI_COLS _Pragma("unroll") for (int bj = 0; bj < 2; ++bj) _Pragma("unroll") for (int n = 0; n < 2; ++n)

struct EpiIn {
    DI void prefetch(const Unit& u, LAS unsigned char* lds, int wid) const {
        if (wid < 4) __builtin_amdgcn_global_load_lds((const unsigned*)(ss + u.pm * BM + wid * 64 + lane_fresh()), (LAS unsigned*)(lds + LDS_DUMMY + wid * 256), 4, 0, 0);
    }
    const float* ss; bf16_t *Ucat, *SG, *GA, *Q, *Kb, *VT; const float *qg, *kg;
    DI void operator()(const f32x4 (&acc)[2][2][4][2], const Unit& u, int wr, int wc, int fr, int fq) const {
        const int type = u.pn >> 1, hf = u.pn & 1;
        float rsv[2][4];
        EPI_ROWS_NF rsv[ai][m] = ss[u.pm * BM + ai * HALF + wr * 64 + m * 16 + fr];
        EPI_ROWS_NF rsv[ai][m] = rsqrtf(rsv[ai][m] * (1.f / 1024.f) + 1e-6f);
        if (type == 0) {
            EPI_ROWS_NF { const int row = u.pm * BM + ai * HALF + wr * 64 + m * 16 + fr; const float rs = rsv[ai][m];
                EPI_COLS { const f32x4 v = acc[ai][bj][m][n] * rs; const int g = 16 * hf + 4 * wc + 2 * bj + n;
                    u32x2 w; w.x = cvt_pk_bf16(v[0], v[1]); w.y = cvt_pk_bf16(v[2], v[3]);
                    *(u32x2*)(Ucat + ((size_t)(g * 1024 + (row >> 5)) * 640 + (row & 31) * 16 + 4 * fq)) = w; } }
        } else if (type == 1 || type == 5) {
            bf16_t* dst = type == 1 ? SG : GA;
            EPI_ROWS_NF { const int row = u.pm * BM + ai * HALF + wr * 64 + m * 16 + fr; const float rs = rsv[ai][m];
                EPI_COLS { const f32x4 v = acc[ai][bj][m][n] * rs; const int cs = 256 * hf + 64 * wc + 32 * bj + 16 * n + 4 * fq;
                    u32x2 w; w.x = cvt_pk_bf16(fsilu(v[0]), fsilu(v[1])); w.y = cvt_pk_bf16(fsilu(v[2]), fsilu(v[3]));
                    *(u32x2*)(dst + (size_t)row * 512 + cs) = w; } }
        } else if (type == 2 || type == 3) {
            bf16_t* dst = type == 2 ? Q : Kb; const float* gam = type == 2 ? qg : kg; const float sc = type == 2 ? 0.125f : 1.0f;
            f32x4 gv[2][2];
            EPI_COLS gv[bj][n] = *(const f32x4*)(gam + 32 * bj + 16 * n + 4 * fq) * sc;
            EPI_ROWS_NF { const int row = u.pm * BM + ai * HALF + wr * 64 + m * 16 + fr; const float rs = rsv[ai][m];
                f32x4 v[2][2]; float s = 0.f;
                EPI_COLS { v[bj][n] = acc[ai][bj][m][n] * rs; s += (v[bj][n][0] * v[bj][n][0] + v[bj][n][1] * v[bj][n][1]) + (v[bj][n][2] * v[bj][n][2] + v[bj][n][3] * v[bj][n][3]); }
                s += __shfl_xor(s, 16); s += __shfl_xor(s, 32);
                const float ri = rsqrtf(s * (1.f / 64.f) + 1e-6f);
                EPI_COLS { const f32x4 o = v[bj][n] * ri * gv[bj][n]; const int cs = 256 * hf + 64 * wc + 32 * bj + 16 * n + 4 * fq;
                    u32x2 w; w.x = cvt_pk_bf16(o[0], o[1]); w.y = cvt_pk_bf16(o[2], o[3]);
                    if (type == 2) *(u32x2*)(dst + (size_t)row * 512 + cs) = w;
                    else {
                        const int key = row & 4095;
                        *(u32x2*)(dst + (((size_t)((row >> 12) * 8 + 4 * hf + wc)) << 18) + (key >> 5) * 2048 + (2 * bj + n) * 512 + (key & 31) * 16 + 4 * fq) = w; } } }
        } else {
            EPI_ROWS_NF { const int row = u.pm * BM + ai * HALF + wr * 64 + m * 16 + fr; const float rs = rsv[ai][m];
                const int b = row >> 12, s = row & 4095, head = 4 * hf + wc;
                EPI_COLS { const f32x4 v = acc[ai][bj][m][n] * rs; const int d = 32 * bj + 16 * n + 4 * fq;
                    const unsigned w0 = cvt_pk_bf16(v[0], v[1]), w1 = cvt_pk_bf16(v[2], v[3]);
                    bf16_t* o = VT + (((size_t)(b * 8 + head)) << 18) + (s >> 5) * 2048 + bj * 1024 + ((s >> 4) & 1) * 512 + (16 * n + 4 * fq) * 16 + (s & 15);
                    (void)d; o[0] = (bf16_t)(w0 & 0xffffu); o[16] = (bf16_t)(w0 >> 16); o[32] = (bf16_t)(w1 & 0xffffu); o[48] = (bf16_t)(w1 >> 16); } }
        }
    }
};
struct EpiS {
    DI void prefetch(const Unit&, LAS unsigned char*, int) const {}
    float* Sbuf;
    DI void operator()(const f32x4 (&acc)[2][2][4][2], const Unit& u, int wr, int wc, int fr, int fq) const {
        EPI_ROWS { const int R = u.pm * BM + ai * HALF + wr * 64 + m * 16 + fr;
#pragma unroll
            for (int n = 0; n < 2; ++n) *(f32x4*)(Sbuf + ((size_t)(u.g * 1024 + R) * 128 + 32 * wc + 16 * n + 4 * fq)) = acc[ai][0][m][n]; }
    }
};
struct EpiY {
    DI void prefetch(const Unit&, LAS unsigned char*, int) const {}
    const bf16_t* Ucat; const float* dsk; bf16_t* zb;
    DI void operator()(const f32x4 (&acc)[2][2][4][2], const Unit& u, int wr, int wc, int fr, int fq) const {
        const f32x4 dv = *(const f32x4*)(dsk + u.g * 16 + 4 * fq);
        EPI_ROWS { const int R = u.pm * BM + ai * HALF + wr * 64 + m * 16 + fr;
            EPI_COLS { const int ncol = u.pn * BM + bj * HALF + 32 * wc + 16 * n + 4 * fq;
                const u32x2 ub = *(const u32x2*)(Ucat + ((size_t)(u.g * 1024 + R) * 640 + ncol));
                f32x4 y = acc[ai][bj][m][n];
                y[0] += dv[0] * bf_lo(ub.x); y[1] += dv[1] * bf_hi(ub.x); y[2] += dv[2] * bf_lo(ub.y); y[3] += dv[3] * bf_hi(ub.y);
                u32x2 w; w.x = cvt_pk_bf16(fgelu_tanh(y[0]), fgelu_tanh(y[1])); w.y = cvt_pk_bf16(fgelu_tanh(y[2]), fgelu_tanh(y[3]));
                const int token = R * 32 + (ncol >> 4);
                *(u32x2*)(zb + (size_t)token * 512 + u.g * 16 + 4 * fq) = w; } }
    }
};
struct EpiGlu {
    DI void prefetch(const Unit& u, LAS unsigned char* lds, int wid) const {
        const int id = wid * 64 + lane_fresh(), row = id >> 1, seg = id & 1;
        __builtin_amdgcn_global_load_lds((const unsigned*)(SG + (size_t)(u.pm * BM + row) * 512 + u.pn * 128 + seg * 64), (LAS unsigned*)(lds + LDS_DUMMY + wid * 256), 4, 0, 0);
    }
    const float* bglu; const bf16_t* SG; bf16_t* cat;
    DI void operator()(const f32x4 (&acc)[2][2][4][2], const Unit& u, int wr, int wc, int fr, int fq) const {
        f32x4 bv[2], bg[2];
#pragma unroll
        for (int n = 0; n < 2; ++n) { const int ch = u.pn * 128 + 32 * wc + 16 * n + 4 * fq; bv[n] = *(const f32x4*)(bglu + ch); bg[n] = *(const f32x4*)(bglu + 512 + ch); }
        EPI_ROWS { const int row = u.pm * BM + ai * HALF + wr * 64 + m * 16 + fr;
#pragma unroll
            for (int n = 0; n < 2; ++n) { const int ch = u.pn * 128 + 32 * wc + 16 * n + 4 * fq;
                const f32x4 val = acc[ai][0][m][n] + bv[n], gt = acc[ai][1][m][n] + bg[n];
                const u32x2 sg = *(const u32x2*)(SG + (size_t)row * 512 + ch);
                const float o0 = val[0] * fsigmoid(gt[0]) * bf_lo(sg.x), o1 = val[1] * fsigmoid(gt[1]) * bf_hi(sg.x), o2 = val[2] * fsigmoid(gt[2]) * bf_lo(sg.y), o3 = val[3] * fsigmoid(gt[3]) * bf_hi(sg.y);
                u32x2 w; w.x = cvt_pk_bf16(o0, o1); w.y = cvt_pk_bf16(o2, o3);
                *(u32x2*)(cat + (size_t)row * 1024 + ch) = w; } }
    }
};
struct EpiOut {
    DI void prefetch(const Unit& u, LAS unsigned char* lds, int wid) const {
        const int tid = wid * 64 + lane_fresh();
#pragma unroll
        for (int i = 0; i < 2; ++i) { const int id = tid + 512 * i, row = id >> 2, seg = id & 3;
            __builtin_amdgcn_global_load_lds((const unsigned*)(hin + (size_t)(u.pm * BM + row) * 1024 + u.pn * BM + seg * 64), (LAS unsigned*)(lds + LDS_DUMMY + wid * 256), 4, 0, 0); }
    }
    const bf16_t* hin; bf16_t* hb; float* ss;
    DI void operator()(const f32x4 (&acc)[2][2][4][2], const Unit& u, int wr, int wc, int fr, int fq) const {
        EPI_ROWS { const int row = u.pm * BM + ai * HALF + wr * 64 + m * 16 + fr; float s = 0.f;
            EPI_COLS { const size_t off = (size_t)row * 1024 + u.pn * BM + bj * HALF + 32 * wc + 16 * n + 4 * fq;
                const u32x2 rw = *(const u32x2*)(hin + off); f32x4 hv = acc[ai][bj][m][n];
                hv[0] += bf_lo(rw.x); hv[1] += bf_hi(rw.x); hv[2] += bf_lo(rw.y); hv[3] += bf_hi(rw.y);
                u32x2 w; w.x = cvt_pk_bf16(hv[0], hv[1]); w.y = cvt_pk_bf16(hv[2], hv[3]); *(u32x2*)(hb + off) = w;
                s += (hv[0] * hv[0] + hv[1] * hv[1]) + (hv[2] * hv[2] + hv[3] * hv[3]); }
            s += __shfl_xor(s, 16); s += __shfl_xor(s, 32);
            if (fq == 0) atomicAdd(ss + row, s); }
    }
};
struct EpiPle {
    DI void prefetch(const Unit& u, LAS unsigned char* lds, int wid) const {
        const int tid = wid * 64 + lane_fresh();
#pragma unroll
        for (int i = 0; i < 2; ++i) { const int id = tid + 512 * i, row = id >> 2, seg = id & 3; const size_t off = (size_t)(u.pm * BM + row) * 1024 + u.pn * BM + seg * 64;
            __builtin_amdgcn_global_load_lds((const unsigned*)(h1 + off), (LAS unsigned*)(lds + LDS_DUMMY + wid * 256), 4, 0, 0);
            __builtin_amdgcn_global_load_lds((const unsigned*)(pp + off), (LAS unsigned*)(lds + LDS_DUMMY + wid * 256), 4, 0, 0); }
        if (wid < 4) __builtin_amdgcn_global_load_lds((const unsigned*)(ss1 + u.pm * BM + tid), (LAS unsigned*)(lds + LDS_DUMMY + wid * 256), 4, 0, 0);
    }
    const float* ss1; const bf16_t* h1; float* h; const bf16_t* pp; bf16_t* hb; float* ss2; int last;
    DI void operator()(const f32x4 (&acc)[2][2][4][2], const Unit& u, int wr, int wc, int fr, int fq) const {
        float rsv[2][4];
        EPI_ROWS_NF rsv[ai][m] = ss1[u.pm * BM + ai * HALF + wr * 64 + m * 16 + fr];
        EPI_ROWS_NF rsv[ai][m] = rsqrtf(rsv[ai][m] * (1.f / 1024.f) + 1e-6f);
        EPI_ROWS { const int row = u.pm * BM + ai * HALF + wr * 64 + m * 16 + fr; float s = 0.f;
            const float rs = rsv[ai][m];
            EPI_COLS { const size_t off = (size_t)row * 1024 + u.pn * BM + bj * HALF + 32 * wc + 16 * n + 4 * fq;
                const f32x4 a = acc[ai][bj][m][n] * rs; const u32x2 pw = *(const u32x2*)(pp + off); const u32x2 hw = *(const u32x2*)(h1 + off);
                f32x4 hv;
                hv[0] = bf_lo(hw.x) + fsigmoid(a[0]) * bf_lo(pw.x); hv[1] = bf_hi(hw.x) + fsigmoid(a[1]) * bf_hi(pw.x); hv[2] = bf_lo(hw.y) + fsigmoid(a[2]) * bf_lo(pw.y); hv[3] = bf_hi(hw.y) + fsigmoid(a[3]) * bf_hi(pw.y);
                if (last) *(f32x4*)(h + off) = hv;
                if (!last) { u32x2 w; w.x = cvt_pk_bf16(hv[0], hv[1]); w.y = cvt_pk_bf16(hv[2], hv[3]); *(u32x2*)(hb + off) = w;
                    s += (hv[0] * hv[0] + hv[1] * hv[1]) + (hv[2] * hv[2] + hv[3] * hv[3]); } }
            if (!last) { s += __shfl_xor(s, 16); s += __shfl_xor(s, 32); if (fq == 0) atomicAdd(ss2 + row, s); } }
    }
};
struct EpiPP {
    DI void prefetch(const Unit&, LAS unsigned char*, int) const {}
    bf16_t* pp;
    DI void operator()(const f32x4 (&acc)[2][2][4][2], const Unit& u, int wr, int wc, int fr, int fq) const {
        EPI_ROWS { const int row = u.pm * BM + ai * HALF + wr * 64 + m * 16 + fr;
            EPI_COLS { const size_t off = (size_t)row * 1024 + u.pn * BM + bj * HALF + 32 * wc + 16 * n + 4 * fq; const f32x4 a = acc[ai][bj][m][n] * 1.0f;
                u32x2 w; w.x = cvt_pk_bf16(a[0], a[1]); w.y = cvt_pk_bf16(a[2], a[3]); *(u32x2*)(pp + off) = w; } }
    }
};

DI void attn_item(int item, const bf16_t* Q, const bf16_t* Kb, const bf16_t* VT, const bf16_t* GA, bf16_t* cat, int lane) {
    const int qb = item & 127, h = (item >> 7) & 7, b = item >> 10;
    const int q0 = qb * 32, hf = lane >> 5, ql = lane & 31;
    const bf16_t* qp = Q + (size_t)(b * SEQ + q0 + ql) * 512 + h * 64 + 8 * hf;
    bf16x8 qf[4];
#pragma unroll
    for (int s = 0; s < 4; ++s) qf[s] = *(const bf16x8*)(qp + 16 * s);
    const int kperm = (ql & 16) | ((ql & 4) << 1) | ((ql & 8) >> 1) | (ql & 3);
    const bf16_t* kbase = Kb + (((size_t)(b * 8 + h)) << 18) + kperm * 16 + 8 * hf;
    const bf16_t* vbase = VT + (((size_t)(b * 8 + h)) << 18) + ql * 16 + 8 * hf;
    f32x16 o0, o1;
#pragma unroll
    for (int i = 0; i < 16; ++i) { o0[i] = 0.f; o1[i] = 0.f; }
    float cprod = 1.f;
    bf16x8 kf[4], vf[2][2];
    { const bf16_t* kp = kbase + (size_t)(q0 >> 5) * 2048; const bf16_t* vp = vbase + (size_t)(q0 >> 5) * 2048;
#pragma unroll
      for (int s = 0; s < 4; ++s) kf[s] = *(const bf16x8*)(kp + 512 * s);
#pragma unroll
      for (int s = 0; s < 2; ++s) { vf[s][0] = *(const bf16x8*)(vp + 512 * s); vf[s][1] = *(const bf16x8*)(vp + 1024 + 512 * s); } }
#define ATT_TILE(DIAG) { \
        f32x16 st; _Pragma("unroll") for (int i = 0; i < 16; ++i) st[i] = 0.f; \
        _Pragma("unroll") for (int s = 0; s < 4; ++s) st = __builtin_amdgcn_mfma_f32_32x32x16_bf16(kf[s], qf[s], st, 0, 0, 0); \
        const int kn = kb >= 32 ? kb - 32 : 0; const bf16_t* kp = kbase + (size_t)(kn >> 5) * 2048; const bf16_t* vp = vbase + (size_t)(kn >> 5) * 2048; \
        bf16x8 kf2[4], vf2[2][2]; \
        _Pragma("unroll") for (int s = 0; s < 4; ++s) kf2[s] = *(const bf16x8*)(kp + 512 * s); \
        _Pragma("unroll") for (int s = 0; s < 2; ++s) { vf2[s][0] = *(const bf16x8*)(vp + 512 * s); vf2[s][1] = *(const bf16x8*)(vp + 1024 + 512 * s); } \
        float sg[16], ns[16]; float PA = 1.f, PB = 1.f; \
        _Pragma("unroll") for (int r = 0; r < 16; ++r) { \
            const float t = st[r] * -1.4426950408889634f; \
            const float e = __builtin_amdgcn_exp2f(fminf(t, 115.0f));        \
            float sgm = __builtin_amdgcn_rcpf(1.0f + e);                     \
            float nsv = e * sgm;                                             \
            if (DIAG) { const int koff = 16 * (r >> 3) + 8 * hf + (r & 7); if (koff >= ql) { sgm = 0.f; nsv = 1.f; } } \
            sg[r] = sgm; ns[r] = nsv; if (r < 8) PA *= nsv; else PB *= nsv; } \
        const float PAo = __shfl_xor(PA, 32), PBo = __shfl_xor(PB, 32); \
        float runA = cprod * (PB * PBo) * (hf == 0 ? PAo : 1.f); float runB = cprod * (hf == 0 ? PBo : 1.f); \
        float w[16]; \
        _Pragma("unroll") for (int r = 7; r >= 0; --r) { w[r] = sg[r] * runA; runA *= ns[r]; } \
        _Pragma("unroll") for (int r = 15; r >= 8; --r) { w[r] = sg[r] * runB; runB *= ns[r]; } \
        cprod *= (PA * PAo) * (PB * PBo); \
        _Pragma("unroll") for (int s = 0; s < 2; ++s) { \
            u32x4 pw; pw.x = cvt_pk_bf16(w[8 * s], w[8 * s + 1]); pw.y = cvt_pk_bf16(w[8 * s + 2], w[8 * s + 3]); pw.z = cvt_pk_bf16(w[8 * s + 4], w[8 * s + 5]); pw.w = cvt_pk_bf16(w[8 * s + 6], w[8 * s + 7]); \
            const bf16x8 wf = __builtin_bit_cast(bf16x8, pw); \
            o0 = __builtin_amdgcn_mfma_f32_32x32x16_bf16(wf, vf[s][0], o0, 0, 0, 0); \
            o1 = __builtin_amdgcn_mfma_f32_32x32x16_bf16(wf, vf[s][1], o1, 0, 0, 0); } \
        _Pragma("unroll") for (int s = 0; s < 4; ++s) kf[s] = kf2[s]; \
        _Pragma("unroll") for (int s = 0; s < 2; ++s) { vf[s][0] = vf2[s][0]; vf[s][1] = vf2[s][1]; } \
        kb -= 32; }
    { int kb = q0;
      ATT_TILE(true)
      if (kb >= 0 && !__all(cprod < 1.17549435e-38f)) {
          _Pragma("nounroll") for (;;) { ATT_TILE(false) if (kb < 0 || __all(cprod < 1.17549435e-38f)) break; } } }
#undef ATT_TILE
#pragma unroll
    for (int r = 0; r < 16; ++r) {
        const size_t tok = (size_t)(b * SEQ + q0 + 8 * (r >> 2) + 4 * hf + (r & 3));
        const float g0 = __uint_as_float((unsigned)GA[tok * 512 + h * 64 + ql] << 16), g1 = __uint_as_float((unsigned)GA[tok * 512 + h * 64 + 32 + ql] << 16);
        const unsigned w = cvt_pk_bf16(o0[r] * g0, o1[r] * g1);
        cat[tok * 1024 + 512 + h * 64 + ql] = (bf16_t)(w & 0xffffu);
        cat[tok * 1024 + 512 + h * 64 + 32 + ql] = (bf16_t)(w >> 16);
    }
}

DI void sincos_d(double ang, double& s, double& c) {
    const double k = rint(ang * 0.63661977236758134308);
    double y = fma(-k, 1.5707963267948966192, ang); y = fma(-k, 6.123233995736766e-17, y);
    const double y2 = y * y;
    const double sp = y * (1.0 - y2 * (1.0 / 6.0) * (1.0 - y2 * (1.0 / 20.0) * (1.0 - y2 * (1.0 / 42.0) * (1.0 - y2 * (1.0 / 72.0) * (1.0 - y2 * (1.0 / 110.0) * (1.0 - y2 * (1.0 / 156.0) * (1.0 - y2 * (1.0 / 210.0) * (1.0 - y2 * (1.0 / 272.0)))))))));
    const double cp = 1.0 - y2 * (1.0 / 2.0) * (1.0 - y2 * (1.0 / 12.0) * (1.0 - y2 * (1.0 / 30.0) * (1.0 - y2 * (1.0 / 56.0) * (1.0 - y2 * (1.0 / 90.0) * (1.0 - y2 * (1.0 / 132.0) * (1.0 - y2 * (1.0 / 182.0) * (1.0 - y2 * (1.0 / 240.0))))))));
    const int q = (int)((long long)k & 3);
    s = (q == 0) ? sp : (q == 1) ? cp : (q == 2) ? -sp : -cp;
    c = (q == 0) ? cp : (q == 1) ? -sp : (q == 2) ? -cp : sp;
}
DI double exp_d(double x) {
    const double k = rint(x * 1.4426950408889634074); const double r = fma(-k, 0.69314718055994530942, x);
    double t = 1.0;
#pragma unroll
    for (int i = 14; i >= 1; --i) t = 1.0 + t * r * (1.0 / (double)i);
    return ldexp(t, (int)k);
}

template <int MODE>
DI int colmap(int n) {
    if (MODE == 1) { const int pn = n >> 8, r = n & 255, bj = r >> 7, wc = (r >> 5) & 3, c = r & 31; return 256 * pn + 64 * wc + 32 * bj + c; }
    if (MODE == 2) { const int pn = n >> 8, r = n & 255; return r < 128 ? 128 * pn + r : 512 + 128 * pn + (r - 128); }
    return n;
}
template <int MODE>
DI void transpose_w(const float* W, int K, int N, bf16_t* WT, const float* kscale, LAS float* scr, int gw, int nw, int lane) {
    const int nblk = N >> 5, items = (K >> 6) * nblk;
    for (int item = gw; item < items; item += nw) {
        const int kb = item / nblk, nb = item - kb * nblk, k0 = 64 * kb, n0 = 32 * nb, col0 = colmap<MODE>(n0);
        float tv[32];
#pragma unroll
        for (int i = 0; i < 32; ++i) { const int kk = 2 * i + (lane >> 5); tv[i] = W[(size_t)(k0 + kk) * N + col0 + (lane & 31)]; }
        if (kscale) {
#pragma unroll
            for (int i = 0; i < 32; ++i) tv[i] *= kscale[k0 + 2 * i + (lane >> 5)]; }
#pragma unroll
        for (int i = 0; i < 32; ++i) { const int kk = 2 * i + (lane >> 5); scr[kk * 33 + (lane & 31)] = tv[i]; }
        asm volatile("s_waitcnt lgkmcnt(0)" ::: "memory");
        const int cc = lane & 7;
#pragma unroll
        for (int j = 0; j < 4; ++j) { const int n = (lane >> 3) + 8 * j; const LAS float* sp = scr + (8 * cc) * 33 + n;
            u32x4 o; o.x = cvt_pk_bf16(sp[0 * 33], sp[1 * 33]); o.y = cvt_pk_bf16(sp[2 * 33], sp[3 * 33]); o.z = cvt_pk_bf16(sp[4 * 33], sp[5 * 33]); o.w = cvt_pk_bf16(sp[6 * 33], sp[7 * 33]);
            *(u32x4*)(WT + (size_t)(n0 + n) * K + k0 + 8 * cc) = o; }
        asm volatile("s_waitcnt lgkmcnt(0)" ::: "memory");
    }
}

DI void ssm_prep(const Params& P, int lg, int qd, LAS unsigned char* lds, int tid) {
    LAS float* apr = (LAS float*)lds;
    LAS float* api = apr + 33 * 64;
    LAS float* bbr = api + 33 * 64;
    LAS float* bbi = bbr + 1024;
    LAS float* cr = bbi + 1024;
    LAS float* ci = cr + 1024;
    LAS float* ktab = ci + 1024;
    LAS float* part = ktab + 8192;
    LAS double* fz = (LAS double*)(part + 8192);
    const double dt = exp_d((double)P.log_dt[lg]);
    for (int idx = tid; idx < 33 * 64; idx += 512) {
        const int tau = idx >> 6, p = idx & 63;
        const double lr = (double)P.a_re[lg * 64 + p], li = (double)P.a_im[lg * 64 + p];
        const double mag = exp_d(lr * dt * (double)tau); double s, c; sincos_d(li * dt * (double)tau, s, c);
        apr[idx] = (float)(mag * c); api[idx] = (float)(mag * s);
        if (tau == 32 && qd == 0) { float* a32 = (float*)(P.ws + WS_MISC) + (size_t)(lg * 64 + p) * 2; a32[0] = (float)(mag * c); a32[1] = (float)(mag * s); }
        if (tau == 1) {
            const double nr = mag * c - 1.0, ni = mag * s, den = lr * lr + li * li;
            fz[2 * p] = (nr * lr + ni * li) / den; fz[2 * p + 1] = (ni * lr - nr * li) / den; }
    }
    for (int idx = tid; idx < 1024; idx += 512) { cr[idx] = P.c_re[(size_t)lg * 1024 + idx]; ci[idx] = P.c_im[(size_t)lg * 1024 + idx]; }
    __syncthreads();
    for (int idx = tid; idx < 1024; idx += 512) { const int p = idx >> 4; const double fr_ = fz[2 * p], fi_ = fz[2 * p + 1];
        const double br = (double)P.b_re[(size_t)lg * 1024 + idx], bi = (double)P.b_im[(size_t)lg * 1024 + idx];
        bbr[idx] = (float)(fr_ * br - fi_ * bi); bbi[idx] = (float)(fr_ * bi + fi_ * br); }
    __syncthreads();
    {
        const int hh = tid & 255, hp = hh >> 4, h = hh & 15, ph = tid >> 8;
        float cbr[32], cbi[32];
#pragma unroll
        for (int i = 0; i < 32; ++i) { const int p = 32 * ph + i; const float c_r = cr[h * 64 + p], c_i = ci[h * 64 + p], x_r = bbr[p * 16 + hp], x_i = bbi[p * 16 + hp];
            cbr[i] = c_r * x_r - c_i * x_i; cbi[i] = c_r * x_i + c_i * x_r; }
        for (int tau = 0; tau < 32; ++tau) { float acc = 0.f;
#pragma unroll
            for (int i = 0; i < 32; ++i) acc += apr[tau * 64 + 32 * ph + i] * cbr[i] - api[tau * 64 + 32 * ph + i] * cbi[i];
            if (ph) part[tau * 256 + hh] = acc; else ktab[tau * 256 + hh] = acc; }
    }
    __syncthreads();
    for (int o = tid; o < 8192; o += 512) ktab[o] += part[o];
    __syncthreads();
    bf16_t* W1 = (bf16_t*)(P.ws + WS_W1) + (size_t)lg * 256 * 512;
    for (int it = tid; it < 128 * 64; it += 512) {
        const int n = 128 * qd + (it >> 6), k8 = it & 63, s = k8 >> 1, hp0 = (k8 & 1) * 8; float v[8];
#pragma unroll
        for (int i = 0; i < 8; ++i) {
            if (n < 128) { const int p = n & 63; const float ar = apr[(31 - s) * 64 + p], ai = api[(31 - s) * 64 + p], xr = bbr[p * 16 + hp0 + i], xi = bbi[p * 16 + hp0 + i];
                v[i] = n < 64 ? ar * xr - ai * xi : ar * xi + ai * xr; }
            else v[i] = 0.f;
        }
        u32x4 o; o.x = cvt_pk_bf16(v[0], v[1]); o.y = cvt_pk_bf16(v[2], v[3]); o.z = cvt_pk_bf16(v[4], v[5]); o.w = cvt_pk_bf16(v[6], v[7]);
        *(u32x4*)(W1 + (size_t)n * 512 + k8 * 8) = o;
    }
    bf16_t* TP = (bf16_t*)(P.ws + WS_TOEP) + (size_t)lg * 512 * 640;
    for (int it = tid; it < 256 * 80; it += 512) {
        const int n = 256 * qd + it / 80, k8 = it % 80, t = n >> 4, h = n & 15; float v[8];
        if (k8 < 64) { const int s = k8 >> 1, hp0 = (k8 & 1) * 8;
#pragma unroll
            for (int i = 0; i < 8; ++i) v[i] = (s <= t) ? ktab[(t - s) * 256 + (hp0 + i) * 16 + h] : 0.f;
        } else if (k8 < 72) {
#pragma unroll
            for (int i = 0; i < 8; ++i) { const int p = (k8 - 64) * 8 + i; v[i] = cr[h * 64 + p] * apr[(t + 1) * 64 + p] - ci[h * 64 + p] * api[(t + 1) * 64 + p]; }
        } else {
#pragma unroll
            for (int i = 0; i < 8; ++i) { const int p = (k8 - 72) * 8 + i; v[i] = -(cr[h * 64 + p] * api[(t + 1) * 64 + p] + ci[h * 64 + p] * apr[(t + 1) * 64 + p]); }
        }
        u32x4 o; o.x = cvt_pk_bf16(v[0], v[1]); o.y = cvt_pk_bf16(v[2], v[3]); o.z = cvt_pk_bf16(v[4], v[5]); o.w = cvt_pk_bf16(v[6], v[7]);
        *(u32x4*)(TP + (size_t)n * 640 + k8 * 8) = o;
    }
    __syncthreads();
}

#define XB_TMO      128
#define XB_XCNT(j)  (256  + 64 * (j))
#define XB_XSUB(j)  (1280 + 64 * (j))
#define XB_XGEN(j)  (2304 + 64 * (j))
#define XB_TOP      3328
#define XB_TOPGEN   3392
#define XCD_BAR_WORDS 3456
#define XB_SPIN_CAP (1u << 18)
DI unsigned xb_ld(unsigned* p) { return __hip_atomic_load(p, __ATOMIC_RELAXED, __HIP_MEMORY_SCOPE_AGENT); }
DI unsigned xb_add(unsigned* p, unsigned v) { return __hip_atomic_fetch_add(p, v, __ATOMIC_RELAXED, __HIP_MEMORY_SCOPE_AGENT); }
DI unsigned xb_xcc_id() { return (unsigned)__builtin_amdgcn_s_getreg((3 << 11) | 20) & 0xFu; }
#define XB_SPIN(cond, bar) do { unsigned _sp = 0; while (cond) { __builtin_amdgcn_s_sleep(1); \
    if ((++_sp & 255u) == 0u) { if (xb_ld(&(bar)[XB_TMO])) break; if (_sp > XB_SPIN_CAP) { atomicAdd(&(bar)[XB_TMO], 1u); break; } } } } while (0)
DI void xcd_barrier_complete(unsigned* bar, unsigned x, unsigned G, unsigned& nloc, unsigned& nx) {
    unsigned sum, cnt, mine, sp = 0u;
    for (;;) {
        sum = 0u; cnt = 0u; mine = 0u;
#pragma unroll 1
        for (unsigned j = 0; j < 16; ++j) { const unsigned cj = xb_ld(&bar[XB_XCNT(j)]); sum += cj; cnt += (cj > 0u) ? 1u : 0u; mine = (j == x) ? cj : mine; }
        if (sum == G) break;
        __builtin_amdgcn_s_sleep(1);
        if ((++sp & 255u) == 0u) { if (xb_ld(&bar[XB_TMO])) break; if (sp > XB_SPIN_CAP) { atomicAdd(&bar[XB_TMO], 1u); break; } }
    }
    nloc = mine > 0u ? mine : 1u; nx = cnt > 0u ? cnt : 1u;
}
DI void xcd_barrier(unsigned* bar, volatile LAS unsigned* st, const int wid) {
    asm volatile("" : "+s"(bar));
    asm volatile("s_waitcnt vmcnt(0)" ::: "memory");
    __syncthreads();
    if (wid == 0 && lane_fresh() == 0) {
        const unsigned x = xb_xcc_id();
        __builtin_amdgcn_s_waitcnt(0);
        const unsigned nloc = st[0], nx = st[1];
        const unsigned old = xb_add(&bar[XB_XSUB(x)], 1u);
        const unsigned gen = old / nloc;
        if (old + 1u == (gen + 1u) * nloc) {
            __builtin_amdgcn_fence(__ATOMIC_RELEASE, "agent");
            asm volatile("s_waitcnt vmcnt(0)" ::: "memory");
            const unsigned og = xb_add(&bar[XB_TOP], 1u);
            const unsigned tg = og / nx;
            if (og + 1u == (tg + 1u) * nx) xb_add(&bar[XB_TOPGEN], 1u);
            else XB_SPIN(xb_ld(&bar[XB_TOPGEN]) == tg, bar);
            __builtin_amdgcn_fence(__ATOMIC_ACQUIRE, "agent");
            xb_add(&bar[XB_XGEN(x)], 1u);
            asm volatile("s_waitcnt vmcnt(0)" ::: "memory");
        } else {
            XB_SPIN(xb_ld(&bar[XB_XGEN(x)]) == gen, bar);
            __builtin_amdgcn_fence(__ATOMIC_ACQUIRE, "agent");
            asm volatile("s_waitcnt vmcnt(0)" ::: "memory");
        }
    }
    __syncthreads();
}

__global__ void __launch_bounds__(512) mega(Params P) {
    extern __shared__ __attribute__((aligned(16))) unsigned char shm[];
    LAS unsigned char* lds = (LAS unsigned char*)shm;
    cg::grid_group grid = cg::this_grid();
    const int wid = __builtin_amdgcn_readfirstlane(threadIdx.x >> 6);
    const int G = gridDim.x, c = blockIdx.x;
    const int gthreads = G * 512;
#define LANE lane_fresh()
#define TID (wid * 64 + lane_fresh())
#define GTID (c * 512 + wid * 64 + lane_fresh())
    unsigned char* ws = P.ws;
    float* ssb = (float*)(ws + WS_MISC + 65536);
    bf16_t* hbA = (bf16_t*)(ws + WS_HBA);
    bf16_t* Ucat = (bf16_t*)(ws + WS_UCAT);
    bf16_t* SG = (bf16_t*)(ws + WS_SGGA); bf16_t* GA = SG + (size_t)T * 512; bf16_t* hbB = SG;
    bf16_t* Qb = (bf16_t*)(ws + WS_QK); bf16_t* Kb = Qb + (size_t)T * 512; bf16_t* pp = Qb;
    bf16_t* VT = (bf16_t*)(ws + WS_VT); bf16_t* zb = (bf16_t*)(ws + WS_ZB);
    bf16_t* cat = (bf16_t*)(ws + WS_CAT);
    float* Sbuf = (float*)(ws + WS_SBUF);
    bf16_t* pb = (bf16_t*)(ws + WS_PB);

    unsigned* bar = (unsigned*)(ws + WS_MISC + 786432);
    volatile LAS unsigned* xst = (volatile LAS unsigned*)(lds + STAGE_BYTES);
#define GSYNC() xcd_barrier(bar, xst, wid)
    if (wid == 0 && LANE == 0) { xst[0] = 0u; xst[1] = 0u; (void)xb_add(&bar[XB_XCNT(xb_xcc_id())], 1u); }
    if (P.ws == nullptr) grid.sync();
    for (int rep = 0; rep < REP_P0; ++rep) {
    const int role = (c >> 3) & 1, sc = ((c >> 4) << 3) | (c & 7), SG_ = G >> 1;
    const int sthreads = SG_ * 512;
    if (role == 0) ssm_prep(P, sc >> 1, sc & 1, lds, TID);
    { const int lane = LANE; LAS float* scr = (LAS float*)lds + wid * (64 * 33); const int l = role == 0 ? 1 : 0;
    for (int i = sc * 512 + TID; i < 3 * T; i += SG_ * 512) if (role == 1) ssb[T + i] = 0.f;
    {
        transpose_w<1>(P.w_in + (size_t)l * 1024 * 3072, 1024, 3072, (bf16_t*)(ws + WS_WIN) + (size_t)l * 3072 * 1024, P.mix_g + l * 1024, scr, sc * 8 + wid, SG_ * 8, lane);
        transpose_w<2>(P.w_glu + (size_t)l * 512 * 1024, 512, 1024, (bf16_t*)(ws + WS_WGLU) + (size_t)l * 1024 * 512, nullptr, scr, sc * 8 + wid, SG_ * 8, lane);
        transpose_w<0>(P.w_out + (size_t)l * 1024 * 1024, 1024, 1024, (bf16_t*)(ws + WS_WOUT) + (size_t)l * 1024 * 1024, nullptr, scr, sc * 8 + wid, SG_ * 8, lane);
        transpose_w<0>(P.w_pg + (size_t)l * 1024 * 1024, 1024, 1024, (bf16_t*)(ws + WS_WPG) + (size_t)l * 1024 * 1024, P.ple_g + l * 1024, scr, sc * 8 + wid, SG_ * 8, lane);
        transpose_w<0>(P.w_pp + (size_t)l * 256 * 1024, 256, 1024, (bf16_t*)(ws + WS_WPP) + (size_t)l * 1024 * 256, nullptr, scr, sc * 8 + wid, SG_ * 8, lane);
    } }
    if (role == 1)
    for (int row = (sc * 8 + wid) * 2; row < T; row += SG_ * 16) {
        const int lane = LANE;
        const f32x4* xr = (const f32x4*)(P.x + (size_t)row * 1024); f32x4 v[2][4];
#pragma unroll
        for (int r2 = 0; r2 < 2; ++r2)
#pragma unroll
            for (int j = 0; j < 4; ++j) v[r2][j] = xr[r2 * 256 + lane + 64 * j];
#pragma unroll
        for (int r2 = 0; r2 < 2; ++r2) { float s = 0.f;
#pragma unroll
            for (int j = 0; j < 4; ++j) { const f32x4 q = v[r2][j]; s += (q[0] * q[0] + q[1] * q[1]) + (q[2] * q[2] + q[3] * q[3]);
                u32x2 w; w.x = cvt_pk_bf16(q[0], q[1]); w.y = cvt_pk_bf16(q[2], q[3]); *(u32x2*)(hbA + (size_t)(row + r2) * 1024 + (lane + 64 * j) * 4) = w; }
#pragma unroll
            for (int o = 1; o < 64; o <<= 1) s += __shfl_xor(s, o);
            if (lane == 0) ssb[row + r2] = s; }
    }
    { const size_t pbase = (size_t)(role == 0 ? 1 : 0) * T * 256 / 8, pend = pbase + (size_t)T * 256 / 8;
    for (size_t i = pbase + sc * 512 + TID; i < pend; i += (size_t)4 * sthreads) {
        f32x4 a[4], b[4];
#pragma unroll
        for (int q = 0; q < 4; ++q) { const size_t ii = i + (size_t)q * sthreads; if (ii < pend) { a[q] = ((const f32x4*)P.p)[2 * ii]; b[q] = ((const f32x4*)P.p)[2 * ii + 1]; } }
#pragma unroll
        for (int q = 0; q < 4; ++q) { const size_t ii = i + (size_t)q * sthreads; if (ii < pend) {
            u32x4 o; o.x = cvt_pk_bf16(a[q][0], a[q][1]); o.y = cvt_pk_bf16(a[q][2], a[q][3]); o.z = cvt_pk_bf16(b[q][0], b[q][1]); o.w = cvt_pk_bf16(b[q][2], b[q][3]);
            ((u32x4*)pb)[ii] = o; } }
    }
    }
    }
    if (wid == 0 && LANE == 0) { unsigned nloc, nx; xcd_barrier_complete(bar, xb_xcc_id(), G, nloc, nx); xst[0] = nloc; xst[1] = nx; }
    GSYNC();

    auto layer = [&](const int l) __attribute__((always_inline)) {
        float* ssIn = ssb + (size_t)(2 * l) * T; float* ssMid = ssb + (size_t)(2 * l + 1) * T; float* ssNext = ssb + (size_t)(2 * l + 2 > 3 ? 3 : 2 * l + 2) * T;
        { Gemm g{hbA, (const bf16_t*)(ws + WS_WIN) + (size_t)l * 3072 * 1024, 1024, 1024, 1024, 0, 0};
          Order S; S.init(T / 256, 12, 1, G, c);
          EpiIn E{ssIn, Ucat, SG, GA, Qb, Kb, VT, P.q_g + l * 64, P.k_g + l * 64};
          for (int rep = 0; rep < REP_INPROJ; ++rep) gemm_phase(lds, g, S, E, wid); }
        GSYNC();
        { Gemm g{Ucat, (const bf16_t*)(ws + WS_W1) + (size_t)l * 32 * 256 * 512, 640, 512, 512, (size_t)1024 * 640, (size_t)256 * 512};
          Order S; S.init(4, 1, 32, G, c);
          EpiS E{Sbuf};
          for (int rep = 0; rep < REP_GEMMS; ++rep) gemm_phase(lds, g, S, E, wid); }
        if (c < 128) {
            asm volatile("s_waitcnt vmcnt(0)" ::: "memory"); __syncthreads();
            const int lane = LANE, seg = lane >> 4, pl = lane & 15;
            const int q_ = c >> 3, L_ = ((c & 7) * 4 + (q_ >> 2)) * 4 + (q_ & 3);
            const int pq = wid & 3, g = L_ >> 2, b = 2 * (L_ & 3) + (wid >> 2), p = pq * 16 + pl;
            const float* a32 = (const float*)(ws + WS_MISC) + (size_t)((l * 32 + g) * 64 + p) * 2; const float ar = a32[0], ai = a32[1];
            const size_t row0 = (size_t)g * 1024 + b * 128 + seg * 32;
            const float* __restrict__ Sp = Sbuf + row0 * 128 + p;
            float sr[32], si[32];
#pragma unroll
            for (int j = 0; j < 32; ++j) { sr[j] = Sp[(size_t)j * 128]; si[j] = Sp[(size_t)j * 128 + 64]; }
            float hr = 0.f, hi = 0.f, wr_ = 1.f, wi_ = 0.f;
#pragma unroll
            for (int j = 0; j < 32; ++j) { const float nr = ar * hr - ai * hi + sr[j], ni = ar * hi + ai * hr + si[j]; hr = nr; hi = ni;
                const float xr = ar * wr_ - ai * wi_, xi = ar * wi_ + ai * wr_; wr_ = xr; wi_ = xi; }
            const float e0r = __shfl(hr, pl), e0i = __shfl(hi, pl), e1r = __shfl(hr, pl + 16), e1i = __shfl(hi, pl + 16), e2r = __shfl(hr, pl + 32), e2i = __shfl(hi, pl + 32);
            const float h1r = e0r, h1i = e0i;
            const float h2r = wr_ * h1r - wi_ * h1i + e1r, h2i = wr_ * h1i + wi_ * h1r + e1i;
            const float h3r = wr_ * h2r - wi_ * h2i + e2r, h3i = wr_ * h2i + wi_ * h2r + e2i;
            const float cinr = seg == 0 ? 0.f : seg == 1 ? h1r : seg == 2 ? h2r : h3r, cini = seg == 0 ? 0.f : seg == 1 ? h1i : seg == 2 ? h2i : h3i;
            bf16_t* __restrict__ Up = Ucat + row0 * 640 + 512 + p;
            hr = 0.f; hi = 0.f; float cr_ = cinr, ci_ = cini;
#pragma unroll
            for (int j = 0; j < 32; ++j) {
                const unsigned pk = cvt_pk_bf16(hr + cr_, hi + ci_);
                Up[(size_t)j * 640] = (bf16_t)(pk & 0xffffu); Up[(size_t)j * 640 + 64] = (bf16_t)(pk >> 16);
                const float nr = ar * hr - ai * hi + sr[j], ni = ar * hi + ai * hr + si[j]; hr = nr; hi = ni;
                const float xr = ar * cr_ - ai * ci_, xi = ar * ci_ + ai * cr_; cr_ = xr; ci_ = xi; }
            asm volatile("s_waitcnt vmcnt(0)" ::: "memory"); __syncthreads();
            { Gemm gy{Ucat, (const bf16_t*)(ws + WS_TOEP) + (size_t)l * 32 * 512 * 640, 640, 640, 640, (size_t)1024 * 640, (size_t)512 * 640};
              Order SY; SY.nwg = -1; SY.nM = g; SY.nN = L_ & 3; SY.lim = 2; SY.total = 0; SY.G = 0; SY.c = 0;
              EpiY EY{Ucat, P.dsk + l * 512, zb};
              for (int rep = 0; rep < REP_Y; ++rep) gemm_phase(lds, gy, SY, EY, wid); }
        }
        for (int rep = 0; rep < REP_ATTN; ++rep)
        {
            const int nit = c < 128 ? 1 : 7, base = c < 128 ? (c * 8 + wid) : 1024 + (c - 128) * 56 + wid;
            for (int j = 0; j < nit; ++j) attn_item(base + 8 * j, Qb, Kb, VT, GA, cat, LANE); }
        GSYNC();
        { Gemm g{zb, (const bf16_t*)(ws + WS_WGLU) + (size_t)l * 1024 * 512, 512, 512, 512, 0, 0};
          Order S; S.init(T / 256, 4, 1, G, c);
          EpiGlu E{P.b_glu + l * 1024, SG, cat};
          for (int rep = 0; rep < REP_GLU; ++rep) gemm_phase(lds, g, S, E, wid); }
        { Gemm g{pb + (size_t)l * T * 256, (const bf16_t*)(ws + WS_WPP) + (size_t)l * 1024 * 256, 256, 256, 256, 0, 0};
          Order S; S.init(T / 256, 4, 1, G, c);
          EpiPP E{pp};
          for (int rep = 0; rep < REP_PP; ++rep) gemm_phase(lds, g, S, E, wid); }
        GSYNC();
        { Gemm g{cat, (const bf16_t*)(ws + WS_WOUT) + (size_t)l * 1024 * 1024, 1024, 1024, 1024, 0, 0};
          Order S; S.init(T / 256, 4, 1, G, c);
          EpiOut E{hbA, hbB, ssMid};
          gemm_phase(lds, g, S, E, wid); }
        GSYNC();
        { Gemm g{hbB, (const bf16_t*)(ws + WS_WPG) + (size_t)l * 1024 * 1024, 1024, 1024, 1024, 0, 0};
          Order S; S.init(T / 256, 4, 1, G, c);
          EpiPle E{ssMid, hbB, P.out, pp, hbA, ssNext, l == 1 ? 1 : 0};
          gemm_phase(lds, g, S, E, wid); }
        if (l == 0) GSYNC();
    };
    layer(0); layer(1);
}

extern "C" void kernel_launch(void* const* d_in, const int* in_sizes, int n_in, void* d_out, int out_size, void* d_ws, size_t ws_size, hipStream_t stream) {
    static int grid = 0;
    if (grid == 0) {
        if (n_in != 20 || ws_size < WS_END) { fprintf(stderr, "kernel_launch: unexpected inputs (n_in %d, ws %zu < %zu)\n", n_in, ws_size, (size_t)WS_END); grid = -1; return; }
        int dev = 0, cus = 0, per_cu = 0;
        hipGetDevice(&dev); hipDeviceGetAttribute(&cus, hipDeviceAttributeMultiprocessorCount, dev);
        if (hipFuncSetAttribute((const void*)mega, hipFuncAttributeMaxDynamicSharedMemorySize, LDS_BYTES) != hipSuccess) { fprintf(stderr, "hipFuncSetAttribute failed\n"); grid = -1; return; }
        if (hipOccupancyMaxActiveBlocksPerMultiprocessor(&per_cu, (const void*)mega, 512, LDS_BYTES) != hipSuccess || per_cu < 1) { fprintf(stderr, "occupancy query: %d\n", per_cu); per_cu = 1; }
        (void)hipGetLastError();
        if (cus < 256) { fprintf(stderr, "kernel_launch: built for a 256-CU device (static work partition over 256 workgroups), found %d CUs; nothing launched\n", cus); grid = -1; return; }
        grid = 256;
    }
    if (grid < 0) return;
    if (hipMemsetAsync((char*)d_ws + WS_MISC + 786432, 0, XCD_BAR_WORDS * 4, stream) != hipSuccess) { fprintf(stderr, "kernel_launch: hipMemsetAsync failed\n"); return; }
    Params P{};
    const float** pp = (const float**)&P;
    for (int i = 0; i < 20; ++i) pp[i] = (const float*)d_in[i];
    P.out = (float*)d_out; P.ws = (unsigned char*)d_ws;
    void* args[] = {&P};
    hipError_t e = hipLaunchCooperativeKernel((const void*)mega, dim3(grid), dim3(512), args, LDS_BYTES, stream);
    if (e != hipSuccess) fprintf(stderr, "cooperative launch failed: %s (grid %d)\n", hipGetErrorString(e), grid);
}
```

```cpp
#ifndef REP_P0
#define REP_P0 1
#define REP_INPROJ 1
#define REP_ATTN 1
#define REP_SCAN 1
#define REP_SYNC 1
#define REP_GEMMS 1
#define REP_PP 1
#define REP_Y 1
#define REP_GLU 1
#endif
#include <hip/hip_runtime.h>
#include <hip/hip_cooperative_groups.h>
#include <cstdio>
namespace cg = cooperative_groups;

#define LAS __attribute__((address_space(3)))
#define DI __device__ __forceinline__
typedef unsigned short bf16_t;
typedef short bf16x8 __attribute__((ext_vector_type(8)));
typedef float f32x4 __attribute__((ext_vector_type(4)));
typedef float f32x16 __attribute__((ext_vector_type(16)));
typedef unsigned u32x4 __attribute__((ext_vector_type(4)));
typedef unsigned u32x2 __attribute__((ext_vector_type(2)));

constexpr int T = 32768, SEQ = 4096;
constexpr int BM = 256, BK = 64, HALF = 128, HTB = HALF * BK * 2, STAGE_BYTES = 8 * HTB, NXCD = 8, WGM = 2;
constexpr int LDS_DUMMY = STAGE_BYTES + 16;
constexpr int LDS_BYTES = STAGE_BYTES + 16 + 2048;

constexpr size_t MBy = 1u << 20;
constexpr size_t WS_WIN = 0;
constexpr size_t WS_WGLU = WS_WIN + 12 * MBy;
constexpr size_t WS_WOUT = WS_WGLU + 2 * MBy;
constexpr size_t WS_WPG = WS_WOUT + 4 * MBy;
constexpr size_t WS_WPP = WS_WPG + 4 * MBy;
constexpr size_t WS_W1 = WS_WPP + 1 * MBy;
constexpr size_t WS_TOEP = WS_W1 + 16 * MBy;
constexpr size_t WS_MISC = WS_TOEP + 40 * MBy;
constexpr size_t WS_HBA = WS_MISC + 1 * MBy;
constexpr size_t WS_UCAT = WS_HBA + 64 * MBy;
constexpr size_t WS_SGGA = WS_UCAT + 40 * MBy;
constexpr size_t WS_QK = WS_SGGA + 64 * MBy;
constexpr size_t WS_VT = WS_QK + 64 * MBy;
constexpr size_t WS_CAT = WS_VT + 32 * MBy;
constexpr size_t WS_SBUF = WS_CAT + 64 * MBy;
constexpr size_t WS_PB = WS_SBUF + 16 * MBy;
constexpr size_t WS_ZB = WS_PB + 32 * MBy;
constexpr size_t WS_END = WS_ZB + 32 * MBy;

struct Params {
    const float *x, *p, *mix_g, *w_in, *a_re, *a_im, *log_dt, *b_re, *b_im, *c_re, *c_im, *dsk, *w_glu, *b_glu, *q_g, *k_g, *w_out, *ple_g, *w_pg, *w_pp;
    float* out; unsigned char* ws;
};

DI int lane_fresh() { int l; asm volatile("v_mbcnt_lo_u32_b32 %0, -1, 0\n\tv_mbcnt_hi_u32_b32 %0, -1, %0" : "=v"(l)); return l; }
DI unsigned cvt_pk_bf16(float lo, float hi) { unsigned r; asm volatile("v_cvt_pk_bf16_f32 %0, %1, %2" : "=v"(r) : "v"(lo), "v"(hi)); return r; }
DI float bf_lo(unsigned w) { return __uint_as_float(w << 16); }
DI float bf_hi(unsigned w) { return __uint_as_float(w & 0xffff0000u); }
DI float fsigmoid(float x) { return __builtin_amdgcn_rcpf(1.0f + __expf(-x)); }
DI float fsilu(float x) { return x * fsigmoid(x); }
DI float fgelu_tanh(float y) { const float u2 = 1.5957691216057308f * (y + 0.044715f * y * y * y); return y * fsigmoid(u2); }

DI int lds_byte(int r, int c) { const int st = (r >> 4) * 2 + (c >> 5), rr = r & 15, cc = c & 31, ob = rr * 64 + cc * 2; return st * 1024 + (ob ^ (((ob >> 9) & 1) << 5)); }
DI void stage_rc(int b, int& R, int& C) { const int st = b / 1024, sb = b % 1024, swz = sb ^ (((sb >> 9) & 1) << 5); R = (st >> 1) * 16 + swz / 64; C = (st & 1) * 32 + (swz % 64) / 2; }

struct Unit { int pm, pn, g; };
struct Gemm { const bf16_t* A; const bf16_t* Bt; int lda, ldb, K; size_t gsA, gsB; };
struct Order {
    int nM, nN, nwg, total, G, c, lim;
    DI void init(int nM_, int nN_, int nG, int G_, int c_) { nM = nM_; nN = nN_; nwg = nM * nN; total = nwg * nG; lim = total; G = G_; c = c_; asm volatile("" : "+s"(c)); }
    DI bool next(int i, Unit& u) const {
        if (nwg < 0) { if (i >= lim) return false; u.g = nM; u.pm = nN; u.pn = i; return true; }
        int L = i * G + c; if (L >= lim) return false;
        if (total > nwg) {
            const int gpx = (total / nwg) >> 3, q = (c >> 3) + (G >> 3) * i; if (q >= gpx * nwg) return false;
            L = ((c & 7) * gpx + q / nwg) * nwg + q % nwg; }
        u.g = L / nwg; int wgid = L - u.g * nwg;
        { const int q = nwg / NXCD, r = nwg % NXCD, xcd = wgid % NXCD, off = wgid / NXCD; wgid = (xcd < r ? xcd * (q + 1) : r * (q + 1) + (xcd - r) * q) + off; }
        const int nig = WGM * nN, gid = wgid / nig, fm = gid * WGM, gsz = (nM - fm) < WGM ? (nM - fm) : WGM;
        u.pm = fm + ((wgid % nig) % gsz); u.pn = (wgid % nig) / gsz; return true;
    }
};

template <class Epi>
DI void gemm_phase(LAS unsigned char* lds, const Gemm g, const Order& S, const Epi& E, const int wid) {
    const int lane = lane_fresh(), tid = wid * 64 + lane, wr = wid >> 2, wc = wid & 3, fr = lane & 15, fq = lane >> 4;
    const int K = g.K, nt = K / BK;
    unsigned voffA[2], voffB[2];
#pragma unroll
    for (int i = 0; i < 2; ++i) { int R, C; stage_rc(tid * 16 + i * 8192, R, C); voffA[i] = (unsigned)(R * g.lda + C) * 2u; voffB[i] = (unsigned)(R * g.ldb + C) * 2u; }
    const size_t kstep = (size_t)(BK * 2);
    const size_t hstepA = (size_t)HALF * g.lda * 2, hstepB = (size_t)HALF * g.ldb * 2;
    const size_t tstepA = 2 * hstepA, tstepB = 2 * hstepB;
    const unsigned ldsw = (unsigned)wid * 1024u;
    const int aoff = lds_byte(wr * 64 + fr, fq * 8), boff = lds_byte(wc * 32 + fr, fq * 8);
#define PG8_SA(b, h) (((b) * 2 + (h)) * HTB)
#define PG8_SB(b, h) ((4 + (b) * 2 + (h)) * HTB)
#define PG8_STAGE(bufoff, gbase, voff) do { _Pragma("unroll") for (int _i = 0; _i < 2; ++_i) \
        __builtin_amdgcn_global_load_lds((const unsigned*)((const char*)(gbase) + (voff)[_i]), (LAS unsigned*)(lds + (bufoff) + ldsw + _i * 8192), 16, 0, 0); } while (0)
#define PG8_LDA(dst, b, h) do { _Pragma("unroll") for (int m = 0; m < 4; ++m) _Pragma("unroll") for (int k = 0; k < 2; ++k) dst[m][k] = *(const LAS bf16x8*)(lds + PG8_SA(b, h) + aoff + m * 2048 + k * 1024); } while (0)
#define PG8_LDB(dst, b, h) do { _Pragma("unroll") for (int n = 0; n < 2; ++n) _Pragma("unroll") for (int k = 0; k < 2; ++k) dst[n][k] = *(const LAS bf16x8*)(lds + PG8_SB(b, h) + boff + n * 2048 + k * 1024); } while (0)
#define PG8_MMA(ai, bj, At, Bt) do { __builtin_amdgcn_s_setprio(1); _Pragma("unroll") for (int m = 0; m < 4; ++m) _Pragma("unroll") for (int n = 0; n < 2; ++n) _Pragma("unroll") for (int k = 0; k < 2; ++k) \
        acc[ai][bj][m][n] = __builtin_amdgcn_mfma_f32_16x16x32_bf16(Bt[n][k], At[m][k], acc[ai][bj][m][n], 0, 0, 0); __builtin_amdgcn_s_setprio(0); } while (0)
#define PG8_WAIT_V(n) asm volatile("s_waitcnt vmcnt(" #n ")" ::: "memory")
#define PG8_WAIT_L(n) asm volatile("s_waitcnt lgkmcnt(" #n ")" ::: "memory")
#define PG8_BAR __builtin_amdgcn_s_barrier()
#define PG8_SCHED __builtin_amdgcn_sched_barrier(0)
    Unit cur, nxt; int ui = 0;
    if (!S.next(0, cur)) return;
    f32x4 acc[2][2][4][2];
#pragma unroll
    for (int a = 0; a < 2; ++a)
#pragma unroll
        for (int b = 0; b < 2; ++b)
#pragma unroll
            for (int m = 0; m < 4; ++m)
#pragma unroll
                for (int n = 0; n < 2; ++n) acc[a][b][m][n] = (f32x4){0.f, 0.f, 0.f, 0.f};
    bf16x8 At[4][2], B0[2][2], B1[2][2];
    const char* cA = (const char*)(g.A + (size_t)cur.g * g.gsA) + (size_t)cur.pm * tstepA;
    const char* cB = (const char*)(g.Bt + (size_t)cur.g * g.gsB) + (size_t)cur.pn * tstepB;
    PG8_STAGE(PG8_SB(0, 0), cB, voffB); PG8_STAGE(PG8_SB(0, 1), cB + hstepB, voffB); PG8_STAGE(PG8_SA(0, 0), cA, voffA); PG8_STAGE(PG8_SA(0, 1), cA + hstepA, voffA);
    if (wr == 1) PG8_BAR;
    PG8_WAIT_V(2); PG8_BAR;
    PG8_STAGE(PG8_SB(1, 0), cB + kstep, voffB); PG8_STAGE(PG8_SA(1, 0), cA + kstep, voffA); PG8_STAGE(PG8_SB(1, 1), cB + hstepB + kstep, voffB);
    PG8_WAIT_V(6); PG8_BAR;
    for (;;) {
        const bool has_next = S.next(ui + 1, nxt);
        const char* nA = has_next ? (const char*)(g.A + (size_t)nxt.g * g.gsA) + (size_t)nxt.pm * tstepA : cA;
        const char* nB = has_next ? (const char*)(g.Bt + (size_t)nxt.g * g.gsB) + (size_t)nxt.pn * tstepB : cB;
        for (int t = 0; t < nt; t += 2) {
            const bool last = (t == nt - 2);
            const char* a1 = cA + (size_t)(t + 1) * kstep;
            const char* a2 = last ? nA : cA + (size_t)(t + 2) * kstep; const char* b2 = last ? nB : cB + (size_t)(t + 2) * kstep;
            const char* a3 = a2 + kstep; const char* b3 = b2 + kstep;
            if (t == nt - 2) E.prefetch(cur, lds, wid);
            PG8_LDB(B0, 0, 0); PG8_LDB(B1, 0, 1); PG8_SCHED; PG8_LDA(At, 0, 0); PG8_STAGE(PG8_SA(1, 1), a1 + hstepA, voffA);
            PG8_WAIT_V(8); PG8_WAIT_L(0); PG8_BAR; PG8_MMA(0, 0, At, B0); PG8_MMA(0, 1, At, B1); PG8_BAR; PG8_SCHED;
            PG8_LDA(At, 0, 1); PG8_STAGE(PG8_SB(0, 0), b2, voffB); PG8_STAGE(PG8_SB(0, 1), b2 + hstepB, voffB); PG8_STAGE(PG8_SA(0, 0), a2, voffA);
            PG8_WAIT_V(8); PG8_WAIT_L(0); PG8_BAR; PG8_MMA(1, 0, At, B0); PG8_MMA(1, 1, At, B1); PG8_BAR; PG8_SCHED;
            PG8_LDB(B0, 1, 0); PG8_LDB(B1, 1, 1); PG8_SCHED; PG8_LDA(At, 1, 0); PG8_STAGE(PG8_SA(0, 1), a2 + hstepA, voffA);
            PG8_WAIT_V(8); PG8_WAIT_L(0); PG8_BAR; PG8_MMA(0, 0, At, B0); PG8_MMA(0, 1, At, B1); PG8_BAR; PG8_SCHED;
            PG8_LDA(At, 1, 1); PG8_STAGE(PG8_SB(1, 0), b3, voffB); PG8_STAGE(PG8_SB(1, 1), b3 + hstepB, voffB); PG8_STAGE(PG8_SA(1, 0), a3, voffA);
            PG8_WAIT_V(8); PG8_WAIT_L(0); PG8_BAR; PG8_MMA(1, 0, At, B0); PG8_MMA(1, 1, At, B1); PG8_BAR; PG8_SCHED;
        }
        if (wr == 0) PG8_BAR;
        { const int le = lane_fresh(); E(acc, cur, wr, wc, le & 15, le >> 4); }
        if (!has_next) break;
#pragma unroll
        for (int a = 0; a < 2; ++a)
#pragma unroll
            for (int b = 0; b < 2; ++b)
#pragma unroll
                for (int m = 0; m < 4; ++m)
#pragma unroll
                    for (int n = 0; n < 2; ++n) acc[a][b][m][n] = (f32x4){0.f, 0.f, 0.f, 0.f};
        cur = nxt; cA = nA; cB = nB; ++ui;
        if (wr == 1) PG8_BAR;
    }
    PG8_WAIT_V(0);
    PG8_BAR;
#undef PG8_SA
#undef PG8_SB
#undef PG8_STAGE
#undef PG8_LDA
#undef PG8_LDB
#undef PG8_MMA
#undef PG8_WAIT_V
#undef PG8_WAIT_L
#undef PG8_BAR
#undef PG8_SCHED
}

#define EPI_ROWS _Pragma("unroll") for (int ai = 0; ai < 2; ++ai) _Pragma("unroll") for (int m = 0; m < 4; ++m) if ((__extension__({ if ((m & 1) == 0) asm volatile("" ::: "memory"); 1; })))
#define EPI_ROWS_NF _Pragma("unroll") for (int ai = 0; ai < 2; ++ai) _Pragma("unroll") for (int m = 0; m < 4; ++m)
#define EPI_COLS _Pragma("unroll") for (int bj = 0; bj < 2; ++bj) _Pragma("unroll") for (int n = 0; n < 2; ++n)

struct EpiIn {
    DI void prefetch(const Unit& u, LAS unsigned char* lds, int wid) const {
        if (wid < 4) __builtin_amdgcn_global_load_lds((const unsigned*)(ss + u.pm * BM + wid * 64 + lane_fresh()), (LAS unsigned*)(lds + LDS_DUMMY + wid * 256), 4, 0, 0);
    }
    const float* ss; bf16_t *Ucat, *SG, *GA, *Q, *Kb, *VT; const float *qg, *kg;
    DI void operator()(const f32x4 (&acc)[2][2][4][2], const Unit& u, int wr, int wc, int fr, int fq) const {
        const int type = u.pn >> 1, hf = u.pn & 1;
        float rsv[2][4];
        EPI_ROWS_NF rsv[ai][m] = ss[u.pm * BM + ai * HALF + wr * 64 + m * 16 + fr];
        EPI_ROWS_NF rsv[ai][m] = rsqrtf(rsv[ai][m] * (1.f / 1024.f) + 1e-6f);
        if (type == 0) {
            EPI_ROWS_NF { const int row = u.pm * BM + ai * HALF + wr * 64 + m * 16 + fr; const float rs = rsv[ai][m];
                EPI_COLS { const f32x4 v = acc[ai][bj][m][n] * rs; const int g = 16 * hf + 4 * wc + 2 * bj + n;
                    u32x2 w; w.x = cvt_pk_bf16(v[0], v[1]); w.y = cvt_pk_bf16(v[2], v[3]);
                    *(u32x2*)(Ucat + ((size_t)(g * 1024 + (row >> 5)) * 640 + (row & 31) * 16 + 4 * fq)) = w; } }
        } else if (type == 1 || type == 5) {
            bf16_t* dst = type == 1 ? SG : GA;
            EPI_ROWS_NF { const int row = u.pm * BM + ai * HALF + wr * 64 + m * 16 + fr; const float rs = rsv[ai][m];
                EPI_COLS { const f32x4 v = acc[ai][bj][m][n] * rs; const int cs = 256 * hf + 64 * wc + 32 * bj + 16 * n + 4 * fq;
                    u32x2 w; w.x = cvt_pk_bf16(fsilu(v[0]), fsilu(v[1])); w.y = cvt_pk_bf16(fsilu(v[2]), fsilu(v[3]));
                    *(u32x2*)(dst + (size_t)row * 512 + cs) = w; } }
        } else if (type == 2 || type == 3) {
            bf16_t* dst = type == 2 ? Q : Kb; const float* gam = type == 2 ? qg : kg; const float sc = type == 2 ? 0.125f : 1.0f;
            f32x4 gv[2][2];
            EPI_COLS gv[bj][n] = *(const f32x4*)(gam + 32 * bj + 16 * n + 4 * fq) * sc;
            EPI_ROWS_NF { const int row = u.pm * BM + ai * HALF + wr * 64 + m * 16 + fr; const float rs = rsv[ai][m];
                f32x4 v[2][2]; float s = 0.f;
                EPI_COLS { v[bj][n] = acc[ai][bj][m][n] * rs; s += (v[bj][n][0] * v[bj][n][0] + v[bj][n][1] * v[bj][n][1]) + (v[bj][n][2] * v[bj][n][2] + v[bj][n][3] * v[bj][n][3]); }
                s += __shfl_xor(s, 16); s += __shfl_xor(s, 32);
                const float ri = rsqrtf(s * (1.f / 64.f) + 1e-6f);
                EPI_COLS { const f32x4 o = v[bj][n] * ri * gv[bj][n]; const int cs = 256 * hf + 64 * wc + 32 * bj + 16 * n + 4 * fq;
                    u32x2 w; w.x = cvt_pk_bf16(o[0], o[1]); w.y = cvt_pk_bf16(o[2], o[3]);
                    if (type == 2) *(u32x2*)(dst + (size_t)row * 512 + cs) = w;
                    else {
                        const int key = row & 4095;
                        *(u32x2*)(dst + (((size_t)((row >> 12) * 8 + 4 * hf + wc)) << 18) + (key >> 5) * 2048 + (2 * bj + n) * 512 + (key & 31) * 16 + 4 * fq) = w; } } }
        } else {
            EPI_ROWS_NF { const int row = u.pm * BM + ai * HALF + wr * 64 + m * 16 + fr; const float rs = rsv[ai][m];
                const int b = row >> 12, s = row & 4095, head = 4 * hf + wc;
                EPI_COLS { const f32x4 v = acc[ai][bj][m][n] * rs; const int d = 32 * bj + 16 * n + 4 * fq;
                    const unsigned w0 = cvt_pk_bf16(v[0], v[1]), w1 = cvt_pk_bf16(v[2], v[3]);
                    bf16_t* o = VT + (((size_t)(b * 8 + head)) << 18) + (s >> 5) * 2048 + bj * 1024 + ((s >> 4) & 1) * 512 + (16 * n + 4 * fq) * 16 + (s & 15);
                    (void)d; o[0] = (bf16_t)(w0 & 0xffffu); o[16] = (bf16_t)(w0 >> 16); o[32] = (bf16_t)(w1 & 0xffffu); o[48] = (bf16_t)(w1 >> 16); } }
        }
    }
};
struct EpiS {
    DI void prefetch(const Unit&, LAS unsigned char*, int) const {}
    float* Sbuf;
    DI void operator()(const f32x4 (&acc)[2][2][4][2], const Unit& u, int wr, int wc, int fr, int fq) const {
        EPI_ROWS { const int R = u.pm * BM + ai * HALF + wr * 64 + m * 16 + fr;
#pragma unroll
            for (int n = 0; n < 2; ++n) *(f32x4*)(Sbuf + ((size_t)(u.g * 1024 + R) * 128 + 32 * wc + 16 * n + 4 * fq)) = acc[ai][0][m][n]; }
    }
};
struct EpiY {
    DI void prefetch(const Unit&, LAS unsigned char*, int) const {}
    const bf16_t* Ucat; const float* dsk; bf16_t* zb;
    DI void operator()(const f32x4 (&acc)[2][2][4][2], const Unit& u, int wr, int wc, int fr, int fq) const {
        const f32x4 dv = *(const f32x4*)(dsk + u.g * 16 + 4 * fq);
        EPI_ROWS { const int R = u.pm * BM + ai * HALF + wr * 64 + m * 16 + fr;
            EPI_COLS { const int ncol = u.pn * BM + bj * HALF + 32 * wc + 16 * n + 4 * fq;
                const u32x2 ub = *(const u32x2*)(Ucat + ((size_t)(u.g * 1024 + R) * 640 + ncol));
                f32x4 y = acc[ai][bj][m][n];
                y[0] += dv[0] * bf_lo(ub.x); y[1] += dv[1] * bf_hi(ub.x); y[2] += dv[2] * bf_lo(ub.y); y[3] += dv[3] * bf_hi(ub.y);
                u32x2 w; w.x = cvt_pk_bf16(fgelu_tanh(y[0]), fgelu_tanh(y[1])); w.y = cvt_pk_bf16(fgelu_tanh(y[2]), fgelu_tanh(y[3]));
                const int token = R * 32 + (ncol >> 4);
                *(u32x2*)(zb + (size_t)token * 512 + u.g * 16 + 4 * fq) = w; } }
    }
};
struct EpiGlu {
    DI void prefetch(const Unit& u, LAS unsigned char* lds, int wid) const {
        const int id = wid * 64 + lane_fresh(), row = id >> 1, seg = id & 1;
        __builtin_amdgcn_global_load_lds((const unsigned*)(SG + (size_t)(u.pm * BM + row) * 512 + u.pn * 128 + seg * 64), (LAS unsigned*)(lds + LDS_DUMMY + wid * 256), 4, 0, 0);
    }
    const float* bglu; const bf16_t* SG; bf16_t* cat;
    DI void operator()(const f32x4 (&acc)[2][2][4][2], const Unit& u, int wr, int wc, int fr, int fq) const {
        f32x4 bv[2], bg[2];
#pragma unroll
        for (int n = 0; n < 2; ++n) { const int ch = u.pn * 128 + 32 * wc + 16 * n + 4 * fq; bv[n] = *(const f32x4*)(bglu + ch); bg[n] = *(const f32x4*)(bglu + 512 + ch); }
        EPI_ROWS { const int row = u.pm * BM + ai * HALF + wr * 64 + m * 16 + fr;
#pragma unroll
            for (int n = 0; n < 2; ++n) { const int ch = u.pn * 128 + 32 * wc + 16 * n + 4 * fq;
                const f32x4 val = acc[ai][0][m][n] + bv[n], gt = acc[ai][1][m][n] + bg[n];
                const u32x2 sg = *(const u32x2*)(SG + (size_t)row * 512 + ch);
                const float o0 = val[0] * fsigmoid(gt[0]) * bf_lo(sg.x), o1 = val[1] * fsigmoid(gt[1]) * bf_hi(sg.x), o2 = val[2] * fsigmoid(gt[2]) * bf_lo(sg.y), o3 = val[3] * fsigmoid(gt[3]) * bf_hi(sg.y);
                u32x2 w; w.x = cvt_pk_bf16(o0, o1); w.y = cvt_pk_bf16(o2, o3);
                *(u32x2*)(cat + (size_t)row * 1024 + ch) = w; } }
    }
};
struct EpiOut {
    DI void prefetch(const Unit& u, LAS unsigned char* lds, int wid) const {
        const int tid = wid * 64 + lane_fresh();
#pragma unroll
        for (int i = 0; i < 2; ++i) { const int id = tid + 512 * i, row = id >> 2, seg = id & 3;
            __builtin_amdgcn_global_load_lds((const unsigned*)(hin + (size_t)(u.pm * BM + row) * 1024 + u.pn * BM + seg * 64), (LAS unsigned*)(lds + LDS_DUMMY + wid * 256), 4, 0, 0); }
    }
    const bf16_t* hin; bf16_t* hb; float* ss;
    DI void operator()(const f32x4 (&acc)[2][2][4][2], const Unit& u, int wr, int wc, int fr, int fq) const {
        EPI_ROWS { const int row = u.pm * BM + ai * HALF + wr * 64 + m * 16 + fr; float s = 0.f;
#pragma unroll
            for (int bj = 0; bj < 2; ++bj) { const size_t off = (size_t)row * 1024 + u.pn * BM + bj * HALF + 32 * wc + 8 * fq;
                const u32x4 rw = *(const u32x4*)(hin + off); f32x4 h0 = acc[ai][bj][m][0], h1_ = acc[ai][bj][m][1];
                h0[0] += bf_lo(rw.x); h0[1] += bf_hi(rw.x); h0[2] += bf_lo(rw.y); h0[3] += bf_hi(rw.y); h1_[0] += bf_lo(rw.z); h1_[1] += bf_hi(rw.z); h1_[2] += bf_lo(rw.w); h1_[3] += bf_hi(rw.w);
                u32x4 w; w.x = cvt_pk_bf16(h0[0], h0[1]); w.y = cvt_pk_bf16(h0[2], h0[3]); w.z = cvt_pk_bf16(h1_[0], h1_[1]); w.w = cvt_pk_bf16(h1_[2], h1_[3]); *(u32x4*)(hb + off) = w;
                s += ((h0[0] * h0[0] + h0[1] * h0[1]) + (h0[2] * h0[2] + h0[3] * h0[3])) + ((h1_[0] * h1_[0] + h1_[1] * h1_[1]) + (h1_[2] * h1_[2] + h1_[3] * h1_[3])); }
            s += __shfl_xor(s, 16); s += __shfl_xor(s, 32);
            if (fq == 0) atomicAdd(ss + row, s); }
    }
};
struct EpiPle {
    DI void prefetch(const Unit& u, LAS unsigned char* lds, int wid) const {
        const int tid = wid * 64 + lane_fresh();
#pragma unroll
        for (int i = 0; i < 2; ++i) { const int id = tid + 512 * i, row = id >> 2, seg = id & 3; const size_t off = (size_t)(u.pm * BM + row) * 1024 + u.pn * BM + seg * 64;
            __builtin_amdgcn_global_load_lds((const unsigned*)(h1 + off), (LAS unsigned*)(lds + LDS_DUMMY + wid * 256), 4, 0, 0);
            __builtin_amdgcn_global_load_lds((const unsigned*)(pp + off), (LAS unsigned*)(lds + LDS_DUMMY + wid * 256), 4, 0, 0); }
        if (wid < 4) __builtin_amdgcn_global_load_lds((const unsigned*)(ss1 + u.pm * BM + tid), (LAS unsigned*)(lds + LDS_DUMMY + wid * 256), 4, 0, 0);
    }
    const float* ss1; const bf16_t* h1; float* h; const bf16_t* pp; bf16_t* hb; float* ss2; int last;
    DI void operator()(const f32x4 (&acc)[2][2][4][2], const Unit& u, int wr, int wc, int fr, int fq) const {
        float rsv[2][4];
        EPI_ROWS_NF rsv[ai][m] = ss1[u.pm * BM + ai * HALF + wr * 64 + m * 16 + fr];
        EPI_ROWS_NF rsv[ai][m] = rsqrtf(rsv[ai][m] * (1.f / 1024.f) + 1e-6f);
        EPI_ROWS { const int row = u.pm * BM + ai * HALF + wr * 64 + m * 16 + fr; float s = 0.f;
            const float rs = rsv[ai][m];
#pragma unroll
            for (int bj = 0; bj < 2; ++bj) { const size_t off = (size_t)row * 1024 + u.pn * BM + bj * HALF + 32 * wc + 8 * fq;
                const f32x4 a0 = acc[ai][bj][m][0] * rs, a1 = acc[ai][bj][m][1] * rs; const u32x4 pw = *(const u32x4*)(pp + off); const u32x4 hw = *(const u32x4*)(h1 + off);
                f32x4 h0, h1_;
                h0[0] = bf_lo(hw.x) + fsigmoid(a0[0]) * bf_lo(pw.x); h0[1] = bf_hi(hw.x) + fsigmoid(a0[1]) * bf_hi(pw.x); h0[2] = bf_lo(hw.y) + fsigmoid(a0[2]) * bf_lo(pw.y); h0[3] = bf_hi(hw.y) + fsigmoid(a0[3]) * bf_hi(pw.y);
                h1_[0] = bf_lo(hw.z) + fsigmoid(a1[0]) * bf_lo(pw.z); h1_[1] = bf_hi(hw.z) + fsigmoid(a1[1]) * bf_hi(pw.z); h1_[2] = bf_lo(hw.w) + fsigmoid(a1[2]) * bf_lo(pw.w); h1_[3] = bf_hi(hw.w) + fsigmoid(a1[3]) * bf_hi(pw.w);
                if (last) { *(f32x4*)(h + off) = h0; *(f32x4*)(h + off + 4) = h1_; }
                if (!last) { u32x4 w; w.x = cvt_pk_bf16(h0[0], h0[1]); w.y = cvt_pk_bf16(h0[2], h0[3]); w.z = cvt_pk_bf16(h1_[0], h1_[1]); w.w = cvt_pk_bf16(h1_[2], h1_[3]); *(u32x4*)(hb + off) = w;
                    s += ((h0[0] * h0[0] + h0[1] * h0[1]) + (h0[2] * h0[2] + h0[3] * h0[3])) + ((h1_[0] * h1_[0] + h1_[1] * h1_[1]) + (h1_[2] * h1_[2] + h1_[3] * h1_[3])); } }
            if (!last) { s += __shfl_xor(s, 16); s += __shfl_xor(s, 32); if (fq == 0) atomicAdd(ss2 + row, s); } }
    }
};
struct EpiPP {
    DI void prefetch(const Unit&, LAS unsigned char*, int) const {}
    bf16_t* pp;
    DI void operator()(const f32x4 (&acc)[2][2][4][2], const Unit& u, int wr, int wc, int fr, int fq) const {
        EPI_ROWS { const int row = u.pm * BM + ai * HALF + wr * 64 + m * 16 + fr;
#pragma unroll
            for (int bj = 0; bj < 2; ++bj) { const size_t off = (size_t)row * 1024 + u.pn * BM + bj * HALF + 32 * wc + 8 * fq; const f32x4 a0 = acc[ai][bj][m][0] * 1.0f, a1 = acc[ai][bj][m][1] * 1.0f;
                u32x4 w; w.x = cvt_pk_bf16(a0[0], a0[1]); w.y = cvt_pk_bf16(a0[2], a0[3]); w.z = cvt_pk_bf16(a1[0], a1[1]); w.w = cvt_pk_bf16(a1[2], a1[3]); *(u32x4*)(pp + off) = w; } }
    }
};

DI void attn_item(int item, const bf16_t* Q, const bf16_t* Kb, const bf16_t* VT, const bf16_t* GA, bf16_t* cat, int lane) {
    const int qb = item & 127, h = (item >> 7) & 7, b = item >> 10;
    const int q0 = qb * 32, hf = lane >> 5, ql = lane & 31;
    const bf16_t* qp = Q + (size_t)(b * SEQ + q0 + ql) * 512 + h * 64 + 8 * hf;
    bf16x8 qf[4];
#pragma unroll
    for (int s = 0; s < 4; ++s) qf[s] = *(const bf16x8*)(qp + 16 * s);
    const int kperm = (ql & 16) | ((ql & 4) << 1) | ((ql & 8) >> 1) | (ql & 3);
    const bf16_t* kbase = Kb + (((size_t)(b * 8 + h)) << 18) + kperm * 16 + 8 * hf;
    const bf16_t* vbase = VT + (((size_t)(b * 8 + h)) << 18) + ql * 16 + 8 * hf;
    f32x16 o0, o1;
#pragma unroll
    for (int i = 0; i < 16; ++i) { o0[i] = 0.f; o1[i] = 0.f; }
    float cprod = 1.f;
    bf16x8 kf[4], vf[2][2];
    { const bf16_t* kp = kbase + (size_t)(q0 >> 5) * 2048; const bf16_t* vp = vbase + (size_t)(q0 >> 5) * 2048;
#pragma unroll
      for (int s = 0; s < 4; ++s) kf[s] = *(const bf16x8*)(kp + 512 * s);
#pragma unroll
      for (int s = 0; s < 2; ++s) { vf[s][0] = *(const bf16x8*)(vp + 512 * s); vf[s][1] = *(const bf16x8*)(vp + 1024 + 512 * s); } }
#define ATT_TILE(DIAG) { \
        f32x16 st; _Pragma("unroll") for (int i = 0; i < 16; ++i) st[i] = 0.f; \
        _Pragma("unroll") for (int s = 0; s < 4; ++s) st = __builtin_amdgcn_mfma_f32_32x32x16_bf16(kf[s], qf[s], st, 0, 0, 0); \
        const int kn = kb >= 32 ? kb - 32 : 0; const bf16_t* kp = kbase + (size_t)(kn >> 5) * 2048; const bf16_t* vp = vbase + (size_t)(kn >> 5) * 2048; \
        bf16x8 kf2[4], vf2[2][2]; \
        _Pragma("unroll") for (int s = 0; s < 4; ++s) kf2[s] = *(const bf16x8*)(kp + 512 * s); \
        _Pragma("unroll") for (int s = 0; s < 2; ++s) { vf2[s][0] = *(const bf16x8*)(vp + 512 * s); vf2[s][1] = *(const bf16x8*)(vp + 1024 + 512 * s); } \
        float sg[16], ns[16]; float PA = 1.f, PB = 1.f; \
        _Pragma("unroll") for (int r = 0; r < 16; ++r) { \
            const float t = st[r] * -1.4426950408889634f; \
            const float e = __builtin_amdgcn_exp2f(fminf(t, 115.0f));        \
            float sgm = __builtin_amdgcn_rcpf(1.0f + e);                     \
            float nsv = e * sgm;                                             \
            if (DIAG) { const int koff = 16 * (r >> 3) + 8 * hf + (r & 7); if (koff >= ql) { sgm = 0.f; nsv = 1.f; } } \
            sg[r] = sgm; ns[r] = nsv; if (r < 8) PA *= nsv; else PB *= nsv; } \
        const float PAo = __shfl_xor(PA, 32), PBo = __shfl_xor(PB, 32); \
        float runA = cprod * (PB * PBo) * (hf == 0 ? PAo : 1.f); float runB = cprod * (hf == 0 ? PBo : 1.f); \
        float w[16]; \
        _Pragma("unroll") for (int r = 7; r >= 0; --r) { w[r] = sg[r] * runA; runA *= ns[r]; } \
        _Pragma("unroll") for (int r = 15; r >= 8; --r) { w[r] = sg[r] * runB; runB *= ns[r]; } \
        cprod *= (PA * PAo) * (PB * PBo); \
        _Pragma("unroll") for (int s = 0; s < 2; ++s) { \
            u32x4 pw; pw.x = cvt_pk_bf16(w[8 * s], w[8 * s + 1]); pw.y = cvt_pk_bf16(w[8 * s + 2], w[8 * s + 3]); pw.z = cvt_pk_bf16(w[8 * s + 4], w[8 * s + 5]); pw.w = cvt_pk_bf16(w[8 * s + 6], w[8 * s + 7]); \
            const bf16x8 wf = __builtin_bit_cast(bf16x8, pw); \
            o0 = __builtin_amdgcn_mfma_f32_32x32x16_bf16(wf, vf[s][0], o0, 0, 0, 0); \
            o1 = __builtin_amdgcn_mfma_f32_32x32x16_bf16(wf, vf[s][1], o1, 0, 0, 0); } \
        _Pragma("unroll") for (int s = 0; s < 4; ++s) kf[s] = kf2[s]; \
        _Pragma("unroll") for (int s = 0; s < 2; ++s) { vf[s][0] = vf2[s][0]; vf[s][1] = vf2[s][1]; } \
        kb -= 32; }
    { int kb = q0;
      ATT_TILE(true)
      if (kb >= 0 && !__all(cprod < 1.17549435e-38f)) {
          _Pragma("nounroll") for (;;) { ATT_TILE(false) if (kb < 0 || __all(cprod < 1.17549435e-38f)) break; } } }
#undef ATT_TILE
#pragma unroll
    for (int r = 0; r < 16; ++r) {
        const size_t tok = (size_t)(b * SEQ + q0 + 8 * (r >> 2) + 4 * hf + (r & 3));
        const float g0 = __uint_as_float((unsigned)GA[tok * 512 + h * 64 + ql] << 16), g1 = __uint_as_float((unsigned)GA[tok * 512 + h * 64 + 32 + ql] << 16);
        const unsigned w = cvt_pk_bf16(o0[r] * g0, o1[r] * g1);
        cat[tok * 1024 + 512 + h * 64 + ql] = (bf16_t)(w & 0xffffu);
        cat[tok * 1024 + 512 + h * 64 + 32 + ql] = (bf16_t)(w >> 16);
    }
}

DI void sincos_d(double ang, double& s, double& c) {
    const double k = rint(ang * 0.63661977236758134308);
    double y = fma(-k, 1.5707963267948966192, ang); y = fma(-k, 6.123233995736766e-17, y);
    const double y2 = y * y;
    const double sp = y * (1.0 - y2 * (1.0 / 6.0) * (1.0 - y2 * (1.0 / 20.0) * (1.0 - y2 * (1.0 / 42.0) * (1.0 - y2 * (1.0 / 72.0) * (1.0 - y2 * (1.0 / 110.0) * (1.0 - y2 * (1.0 / 156.0) * (1.0 - y2 * (1.0 / 210.0) * (1.0 - y2 * (1.0 / 272.0)))))))));
    const double cp = 1.0 - y2 * (1.0 / 2.0) * (1.0 - y2 * (1.0 / 12.0) * (1.0 - y2 * (1.0 / 30.0) * (1.0 - y2 * (1.0 / 56.0) * (1.0 - y2 * (1.0 / 90.0) * (1.0 - y2 * (1.0 / 132.0) * (1.0 - y2 * (1.0 / 182.0) * (1.0 - y2 * (1.0 / 240.0))))))));
    const int q = (int)((long long)k & 3);
    s = (q == 0) ? sp : (q == 1) ? cp : (q == 2) ? -sp : -cp;
    c = (q == 0) ? cp : (q == 1) ? -sp : (q == 2) ? -cp : sp;
}
DI double exp_d(double x) {
    const double k = rint(x * 1.4426950408889634074); const double r = fma(-k, 0.69314718055994530942, x);
    double t = 1.0;
#pragma unroll
    for (int i = 14; i >= 1; --i) t = 1.0 + t * r * (1.0 / (double)i);
    return ldexp(t, (int)k);
}

template <int MODE>
DI int colmap(int n) {
    if (MODE == 1) { const int pn = n >> 8, r = n & 255, bj = r >> 7, wc = (r >> 5) & 3, c = r & 31; return 256 * pn + 64 * wc + 32 * bj + c; }
    if (MODE == 2) { const int pn = n >> 8, r = n & 255; return r < 128 ? 128 * pn + r : 512 + 128 * pn + (r - 128); }
    if (MODE == 3) { const int rho = n & 31, nn = rho >> 4, i = rho & 15; return (n & ~31) + 8 * (i >> 2) + 4 * nn + (i & 3); }
    return n;
}
template <int MODE>
DI void transpose_w(const float* W, int K, int N, bf16_t* WT, const float* kscale, LAS float* scr, int gw, int nw, int lane) {
    const int nblk = N >> 5, items = (K >> 6) * nblk;
    for (int item = gw; item < items; item += nw) {
        const int kb = item / nblk, nb = item - kb * nblk, k0 = 64 * kb, n0 = 32 * nb, colL = colmap<MODE>(n0 + (lane & 31));
        float tv[32];
#pragma unroll
        for (int i = 0; i < 32; ++i) { const int kk = 2 * i + (lane >> 5); tv[i] = W[(size_t)(k0 + kk) * N + colL]; }
        if (kscale) {
#pragma unroll
            for (int i = 0; i < 32; ++i) tv[i] *= kscale[k0 + 2 * i + (lane >> 5)]; }
#pragma unroll
        for (int i = 0; i < 32; ++i) { const int kk = 2 * i + (lane >> 5); scr[kk * 33 + (lane & 31)] = tv[i]; }
        asm volatile("s_waitcnt lgkmcnt(0)" ::: "memory");
        const int cc = lane & 7;
#pragma unroll
        for (int j = 0; j < 4; ++j) { const int n = (lane >> 3) + 8 * j; const LAS float* sp = scr + (8 * cc) * 33 + n;
            u32x4 o; o.x = cvt_pk_bf16(sp[0 * 33], sp[1 * 33]); o.y = cvt_pk_bf16(sp[2 * 33], sp[3 * 33]); o.z = cvt_pk_bf16(sp[4 * 33], sp[5 * 33]); o.w = cvt_pk_bf16(sp[6 * 33], sp[7 * 33]);
            *(u32x4*)(WT + (size_t)(n0 + n) * K + k0 + 8 * cc) = o; }
        asm volatile("s_waitcnt lgkmcnt(0)" ::: "memory");
    }
}

DI void ssm_prep(const Params& P, int lg, int qd, LAS unsigned char* lds, int tid) {
    LAS float* apr = (LAS float*)lds;
    LAS float* api = apr + 33 * 64;
    LAS float* bbr = api + 33 * 64;
    LAS float* bbi = bbr + 1024;
    LAS float* cr = bbi + 1024;
    LAS float* ci = cr + 1024;
    LAS float* ktab = ci + 1024;
    LAS float* part = ktab + 8192;
    LAS double* fz = (LAS double*)(part + 8192);
    const double dt = exp_d((double)P.log_dt[lg]);
    for (int idx = tid; idx < 33 * 64; idx += 512) {
        const int tau = idx >> 6, p = idx & 63;
        const double lr = (double)P.a_re[lg * 64 + p], li = (double)P.a_im[lg * 64 + p];
        const double mag = exp_d(lr * dt * (double)tau); double s, c; sincos_d(li * dt * (double)tau, s, c);
        apr[idx] = (float)(mag * c); api[idx] = (float)(mag * s);
        if (tau == 32 && qd == 0) { float* a32 = (float*)(P.ws + WS_MISC) + (size_t)(lg * 64 + p) * 2; a32[0] = (float)(mag * c); a32[1] = (float)(mag * s); }
        if (tau == 1) {
            const double nr = mag * c - 1.0, ni = mag * s, den = lr * lr + li * li;
            fz[2 * p] = (nr * lr + ni * li) / den; fz[2 * p + 1] = (ni * lr - nr * li) / den; }
    }
    for (int idx = tid; idx < 1024; idx += 512) { cr[idx] = P.c_re[(size_t)lg * 1024 + idx]; ci[idx] = P.c_im[(size_t)lg * 1024 + idx]; }
    __syncthreads();
    for (int idx = tid; idx < 1024; idx += 512) { const int p = idx >> 4; const double fr_ = fz[2 * p], fi_ = fz[2 * p + 1];
        const double br = (double)P.b_re[(size_t)lg * 1024 + idx], bi = (double)P.b_im[(size_t)lg * 1024 + idx];
        bbr[idx] = (float)(fr_ * br - fi_ * bi); bbi[idx] = (float)(fr_ * bi + fi_ * br); }
    __syncthreads();
    {
        const int hh = tid & 255, hp = hh >> 4, h = hh & 15, ph = tid >> 8;
        float cbr[32], cbi[32];
#pragma unroll
        for (int i = 0; i < 32; ++i) { const int p = 32 * ph + i; const float c_r = cr[h * 64 + p], c_i = ci[h * 64 + p], x_r = bbr[p * 16 + hp], x_i = bbi[p * 16 + hp];
            cbr[i] = c_r * x_r - c_i * x_i; cbi[i] = c_r * x_i + c_i * x_r; }
        for (int tau = 0; tau < 32; ++tau) { float acc = 0.f;
#pragma unroll
            for (int i = 0; i < 32; ++i) acc += apr[tau * 64 + 32 * ph + i] * cbr[i] - api[tau * 64 + 32 * ph + i] * cbi[i];
            if (ph) part[tau * 256 + hh] = acc; else ktab[tau * 256 + hh] = acc; }
    }
    __syncthreads();
    for (int o = tid; o < 8192; o += 512) ktab[o] += part[o];
    __syncthreads();
    bf16_t* W1 = (bf16_t*)(P.ws + WS_W1) + (size_t)lg * 256 * 512;
    for (int it = tid; it < 128 * 64; it += 512) {
        const int n = 128 * qd + (it >> 6), k8 = it & 63, s = k8 >> 1, hp0 = (k8 & 1) * 8; float v[8];
#pragma unroll
        for (int i = 0; i < 8; ++i) {
            if (n < 128) { const int p = n & 63; const float ar = apr[(31 - s) * 64 + p], ai = api[(31 - s) * 64 + p], xr = bbr[p * 16 + hp0 + i], xi = bbi[p * 16 + hp0 + i];
                v[i] = n < 64 ? ar * xr - ai * xi : ar * xi + ai * xr; }
            else v[i] = 0.f;
        }
        u32x4 o; o.x = cvt_pk_bf16(v[0], v[1]); o.y = cvt_pk_bf16(v[2], v[3]); o.z = cvt_pk_bf16(v[4], v[5]); o.w = cvt_pk_bf16(v[6], v[7]);
        *(u32x4*)(W1 + (size_t)n * 512 + k8 * 8) = o;
    }
    bf16_t* TP = (bf16_t*)(P.ws + WS_TOEP) + (size_t)lg * 512 * 640;
    for (int it = tid; it < 256 * 80; it += 512) {
        const int n = 256 * qd + it / 80, k8 = it % 80, t = n >> 4, h = n & 15; float v[8];
        if (k8 < 64) { const int s = k8 >> 1, hp0 = (k8 & 1) * 8;
#pragma unroll
            for (int i = 0; i < 8; ++i) v[i] = (s <= t) ? ktab[(t - s) * 256 + (hp0 + i) * 16 + h] : 0.f;
        } else if (k8 < 72) {
#pragma unroll
            for (int i = 0; i < 8; ++i) { const int p = (k8 - 64) * 8 + i; v[i] = cr[h * 64 + p] * apr[(t + 1) * 64 + p] - ci[h * 64 + p] * api[(t + 1) * 64 + p]; }
        } else {
#pragma unroll
            for (int i = 0; i < 8; ++i) { const int p = (k8 - 72) * 8 + i; v[i] = -(cr[h * 64 + p] * api[(t + 1) * 64 + p] + ci[h * 64 + p] * apr[(t + 1) * 64 + p]); }
        }
        u32x4 o; o.x = cvt_pk_bf16(v[0], v[1]); o.y = cvt_pk_bf16(v[2], v[3]); o.z = cvt_pk_bf16(v[4], v[5]); o.w = cvt_pk_bf16(v[6], v[7]);
        *(u32x4*)(TP + (size_t)n * 640 + k8 * 8) = o;
    }
    __syncthreads();
}

#define XB_TMO      128
#define XB_XCNT(j)  (256  + 64 * (j))
#define XB_XSUB(j)  (1280 + 64 * (j))
#define XB_XGEN(j)  (2304 + 64 * (j))
#define XB_TOP      3328
#define XB_TOPGEN   3392
#define XCD_BAR_WORDS 3456
#define XB_SPIN_CAP (1u << 18)
DI unsigned xb_ld(unsigned* p) { return __hip_atomic_load(p, __ATOMIC_RELAXED, __HIP_MEMORY_SCOPE_AGENT); }
DI unsigned xb_add(unsigned* p, unsigned v) { return __hip_atomic_fetch_add(p, v, __ATOMIC_RELAXED, __HIP_MEMORY_SCOPE_AGENT); }
DI unsigned xb_xcc_id() { return (unsigned)__builtin_amdgcn_s_getreg((3 << 11) | 20) & 0xFu; }
#define XB_SPIN(cond, bar) do { unsigned _sp = 0; while (cond) { __builtin_amdgcn_s_sleep(1); \
    if ((++_sp & 255u) == 0u) { if (xb_ld(&(bar)[XB_TMO])) break; if (_sp > XB_SPIN_CAP) { atomicAdd(&(bar)[XB_TMO], 1u); break; } } } } while (0)
DI void xcd_barrier_complete(unsigned* bar, unsigned x, unsigned G, unsigned& nloc, unsigned& nx) {
    unsigned sum, cnt, mine, sp = 0u;
    for (;;) {
        sum = 0u; cnt = 0u; mine = 0u;
#pragma unroll 1
        for (unsigned j = 0; j < 16; ++j) { const unsigned cj = xb_ld(&bar[XB_XCNT(j)]); sum += cj; cnt += (cj > 0u) ? 1u : 0u; mine = (j == x) ? cj : mine; }
        if (sum == G) break;
        __builtin_amdgcn_s_sleep(1);
        if ((++sp & 255u) == 0u) { if (xb_ld(&bar[XB_TMO])) break; if (sp > XB_SPIN_CAP) { atomicAdd(&bar[XB_TMO], 1u); break; } }
    }
    nloc = mine > 0u ? mine : 1u; nx = cnt > 0u ? cnt : 1u;
}
DI void xcd_barrier(unsigned* bar, volatile LAS unsigned* st, const int wid) {
    asm volatile("" : "+s"(bar));
    asm volatile("s_waitcnt vmcnt(0)" ::: "memory");
    __syncthreads();
    if (wid == 0 && lane_fresh() == 0) {
        const unsigned x = xb_xcc_id();
        __builtin_amdgcn_s_waitcnt(0);
        const unsigned nloc = st[0], nx = st[1];
        const unsigned old = xb_add(&bar[XB_XSUB(x)], 1u);
        const unsigned gen = old / nloc;
        if (old + 1u == (gen + 1u) * nloc) {
            __builtin_amdgcn_fence(__ATOMIC_RELEASE, "agent");
            asm volatile("s_waitcnt vmcnt(0)" ::: "memory");
            const unsigned og = xb_add(&bar[XB_TOP], 1u);
            const unsigned tg = og / nx;
            if (og + 1u == (tg + 1u) * nx) xb_add(&bar[XB_TOPGEN], 1u);
            else XB_SPIN(xb_ld(&bar[XB_TOPGEN]) == tg, bar);
            __builtin_amdgcn_fence(__ATOMIC_ACQUIRE, "agent");
            xb_add(&bar[XB_XGEN(x)], 1u);
            asm volatile("s_waitcnt vmcnt(0)" ::: "memory");
        } else {
            XB_SPIN(xb_ld(&bar[XB_XGEN(x)]) == gen, bar);
            __builtin_amdgcn_fence(__ATOMIC_ACQUIRE, "agent");
            asm volatile("s_waitcnt vmcnt(0)" ::: "memory");
        }
    }
    __syncthreads();
}

__global__ void __launch_bounds__(512) mega(Params P) {
    extern __shared__ __attribute__((aligned(16))) unsigned char shm[];
    LAS unsigned char* lds = (LAS unsigned char*)shm;
    cg::grid_group grid = cg::this_grid();
    const int wid = __builtin_amdgcn_readfirstlane(threadIdx.x >> 6);
    const int G = gridDim.x, c = blockIdx.x;
    const int gthreads = G * 512;
#define LANE lane_fresh()
#define TID (wid * 64 + lane_fresh())
#define GTID (c * 512 + wid * 64 + lane_fresh())
    unsigned char* ws = P.ws;
    float* ssb = (float*)(ws + WS_MISC + 65536);
    bf16_t* hbA = (bf16_t*)(ws + WS_HBA);
    bf16_t* Ucat = (bf16_t*)(ws + WS_UCAT);
    bf16_t* SG = (bf16_t*)(ws + WS_SGGA); bf16_t* GA = SG + (size_t)T * 512; bf16_t* hbB = SG;
    bf16_t* Qb = (bf16_t*)(ws + WS_QK); bf16_t* Kb = Qb + (size_t)T * 512; bf16_t* pp = Qb;
    bf16_t* VT = (bf16_t*)(ws + WS_VT); bf16_t* zb = (bf16_t*)(ws + WS_ZB);
    bf16_t* cat = (bf16_t*)(ws + WS_CAT);
    float* Sbuf = (float*)(ws + WS_SBUF);
    bf16_t* pb = (bf16_t*)(ws + WS_PB);

    unsigned* bar = (unsigned*)(ws + WS_MISC + 786432);
    volatile LAS unsigned* xst = (volatile LAS unsigned*)(lds + STAGE_BYTES);
#define GSYNC() xcd_barrier(bar, xst, wid)
    if (wid == 0 && LANE == 0) { xst[0] = 0u; xst[1] = 0u; (void)xb_add(&bar[XB_XCNT(xb_xcc_id())], 1u); }
    if (P.ws == nullptr) grid.sync();
    for (int rep = 0; rep < REP_P0; ++rep) {
    const int role = (c >> 3) & 1, sc = ((c >> 4) << 3) | (c & 7), SG_ = G >> 1;
    const int sthreads = SG_ * 512;
    if (role == 0) ssm_prep(P, sc >> 1, sc & 1, lds, TID);
    { const int lane = LANE; LAS float* scr = (LAS float*)lds + wid * (64 * 33); const int l = role == 0 ? 1 : 0;
    for (int i = sc * 512 + TID; i < 3 * T; i += SG_ * 512) if (role == 1) ssb[T + i] = 0.f;
    {
        transpose_w<1>(P.w_in + (size_t)l * 1024 * 3072, 1024, 3072, (bf16_t*)(ws + WS_WIN) + (size_t)l * 3072 * 1024, P.mix_g + l * 1024, scr, sc * 8 + wid, SG_ * 8, lane);
        transpose_w<2>(P.w_glu + (size_t)l * 512 * 1024, 512, 1024, (bf16_t*)(ws + WS_WGLU) + (size_t)l * 1024 * 512, nullptr, scr, sc * 8 + wid, SG_ * 8, lane);
        transpose_w<3>(P.w_out + (size_t)l * 1024 * 1024, 1024, 1024, (bf16_t*)(ws + WS_WOUT) + (size_t)l * 1024 * 1024, nullptr, scr, sc * 8 + wid, SG_ * 8, lane);
        transpose_w<3>(P.w_pg + (size_t)l * 1024 * 1024, 1024, 1024, (bf16_t*)(ws + WS_WPG) + (size_t)l * 1024 * 1024, P.ple_g + l * 1024, scr, sc * 8 + wid, SG_ * 8, lane);
        transpose_w<3>(P.w_pp + (size_t)l * 256 * 1024, 256, 1024, (bf16_t*)(ws + WS_WPP) + (size_t)l * 1024 * 256, nullptr, scr, sc * 8 + wid, SG_ * 8, lane);
    } }
    if (role == 1)
    for (int row = (sc * 8 + wid) * 2; row < T; row += SG_ * 16) {
        const int lane = LANE;
        const f32x4* xr = (const f32x4*)(P.x + (size_t)row * 1024); f32x4 v[2][4];
#pragma unroll
        for (int r2 = 0; r2 < 2; ++r2)
#pragma unroll
            for (int j = 0; j < 4; ++j) v[r2][j] = xr[r2 * 256 + lane + 64 * j];
#pragma unroll
        for (int r2 = 0; r2 < 2; ++r2) { float s = 0.f;
#pragma unroll
            for (int j = 0; j < 4; ++j) { const f32x4 q = v[r2][j]; s += (q[0] * q[0] + q[1] * q[1]) + (q[2] * q[2] + q[3] * q[3]);
                u32x2 w; w.x = cvt_pk_bf16(q[0], q[1]); w.y = cvt_pk_bf16(q[2], q[3]); *(u32x2*)(hbA + (size_t)(row + r2) * 1024 + (lane + 64 * j) * 4) = w; }
#pragma unroll
            for (int o = 1; o < 64; o <<= 1) s += __shfl_xor(s, o);
            if (lane == 0) ssb[row + r2] = s; }
    }
    { const size_t pbase = (size_t)(role == 0 ? 1 : 0) * T * 256 / 8, pend = pbase + (size_t)T * 256 / 8;
    for (size_t i = pbase + sc * 512 + TID; i < pend; i += (size_t)4 * sthreads) {
        f32x4 a[4], b[4];
#pragma unroll
        for (int q = 0; q < 4; ++q) { const size_t ii = i + (size_t)q * sthreads; if (ii < pend) { a[q] = ((const f32x4*)P.p)[2 * ii]; b[q] = ((const f32x4*)P.p)[2 * ii + 1]; } }
#pragma unroll
        for (int q = 0; q < 4; ++q) { const size_t ii = i + (size_t)q * sthreads; if (ii < pend) {
            u32x4 o; o.x = cvt_pk_bf16(a[q][0], a[q][1]); o.y = cvt_pk_bf16(a[q][2], a[q][3]); o.z = cvt_pk_bf16(b[q][0], b[q][1]); o.w = cvt_pk_bf16(b[q][2], b[q][3]);
            ((u32x4*)pb)[ii] = o; } }
    }
    }
    }
    if (wid == 0 && LANE == 0) { unsigned nloc, nx; xcd_barrier_complete(bar, xb_xcc_id(), G, nloc, nx); xst[0] = nloc; xst[1] = nx; }
    GSYNC();

    auto layer = [&](const int l) __attribute__((always_inline)) {
        float* ssIn = ssb + (size_t)(2 * l) * T; float* ssMid = ssb + (size_t)(2 * l + 1) * T; float* ssNext = ssb + (size_t)(2 * l + 2 > 3 ? 3 : 2 * l + 2) * T;
        { Gemm g{hbA, (const bf16_t*)(ws + WS_WIN) + (size_t)l * 3072 * 1024, 1024, 1024, 1024, 0, 0};
          Order S; S.init(T / 256, 12, 1, G, c);
          EpiIn E{ssIn, Ucat, SG, GA, Qb, Kb, VT, P.q_g + l * 64, P.k_g + l * 64};
          for (int rep = 0; rep < REP_INPROJ; ++rep) gemm_phase(lds, g, S, E, wid); }
        GSYNC();
        { Gemm g{Ucat, (const bf16_t*)(ws + WS_W1) + (size_t)l * 32 * 256 * 512, 640, 512, 512, (size_t)1024 * 640, (size_t)256 * 512};
          Order S; S.init(4, 1, 32, G, c);
          EpiS E{Sbuf};
          for (int rep = 0; rep < REP_GEMMS; ++rep) gemm_phase(lds, g, S, E, wid); }
        if (c < 128) {
            asm volatile("s_waitcnt vmcnt(0)" ::: "memory"); __syncthreads();
            const int lane = LANE, seg = lane >> 4, pl = lane & 15;
            const int q_ = c >> 3, L_ = ((c & 7) * 4 + (q_ >> 2)) * 4 + (q_ & 3);
            const int pq = wid & 3, g = L_ >> 2, b = 2 * (L_ & 3) + (wid >> 2), p = pq * 16 + pl;
            const float* a32 = (const float*)(ws + WS_MISC) + (size_t)((l * 32 + g) * 64 + p) * 2; const float ar = a32[0], ai = a32[1];
            const size_t row0 = (size_t)g * 1024 + b * 128 + seg * 32;
            const float* __restrict__ Sp = Sbuf + row0 * 128 + p;
            float sr[32], si[32];
#pragma unroll
            for (int j = 0; j < 32; ++j) { sr[j] = Sp[(size_t)j * 128]; si[j] = Sp[(size_t)j * 128 + 64]; }
            float hr = 0.f, hi = 0.f, wr_ = 1.f, wi_ = 0.f;
#pragma unroll
            for (int j = 0; j < 32; ++j) { const float nr = ar * hr - ai * hi + sr[j], ni = ar * hi + ai * hr + si[j]; hr = nr; hi = ni;
                const float xr = ar * wr_ - ai * wi_, xi = ar * wi_ + ai * wr_; wr_ = xr; wi_ = xi; }
            const float e0r = __shfl(hr, pl), e0i = __shfl(hi, pl), e1r = __shfl(hr, pl + 16), e1i = __shfl(hi, pl + 16), e2r = __shfl(hr, pl + 32), e2i = __shfl(hi, pl + 32);
            const float h1r = e0r, h1i = e0i;
            const float h2r = wr_ * h1r - wi_ * h1i + e1r, h2i = wr_ * h1i + wi_ * h1r + e1i;
            const float h3r = wr_ * h2r - wi_ * h2i + e2r, h3i = wr_ * h2i + wi_ * h2r + e2i;
            const float cinr = seg == 0 ? 0.f : seg == 1 ? h1r : seg == 2 ? h2r : h3r, cini = seg == 0 ? 0.f : seg == 1 ? h1i : seg == 2 ? h2i : h3i;
            bf16_t* __restrict__ Up = Ucat + row0 * 640 + 512 + p;
            hr = 0.f; hi = 0.f; float cr_ = cinr, ci_ = cini;
#pragma unroll
            for (int j = 0; j < 32; ++j) {
                const unsigned pk = cvt_pk_bf16(hr + cr_, hi + ci_);
                Up[(size_t)j * 640] = (bf16_t)(pk & 0xffffu); Up[(size_t)j * 640 + 64] = (bf16_t)(pk >> 16);
                const float nr = ar * hr - ai * hi + sr[j], ni = ar * hi + ai * hr + si[j]; hr = nr; hi = ni;
                const float xr = ar * cr_ - ai * ci_, xi = ar * ci_ + ai * cr_; cr_ = xr; ci_ = xi; }
            asm volatile("s_waitcnt vmcnt(0)" ::: "memory"); __syncthreads();
            { Gemm gy{Ucat, (const bf16_t*)(ws + WS_TOEP) + (size_t)l * 32 * 512 * 640, 640, 640, 640, (size_t)1024 * 640, (size_t)512 * 640};
              Order SY; SY.nwg = -1; SY.nM = g; SY.nN = L_ & 3; SY.lim = 2; SY.total = 0; SY.G = 0; SY.c = 0;
              EpiY EY{Ucat, P.dsk + l * 512, zb};
              for (int rep = 0; rep < REP_Y; ++rep) gemm_phase(lds, gy, SY, EY, wid); }
        }
        for (int rep = 0; rep < REP_ATTN; ++rep)
        {
            const int nit = c < 128 ? 1 : 7, base = c < 128 ? (c * 8 + wid) : 1024 + (c - 128) * 56 + wid;
            for (int j = 0; j < nit; ++j) attn_item(base + 8 * j, Qb, Kb, VT, GA, cat, LANE); }
        GSYNC();
        { Gemm g{zb, (const bf16_t*)(ws + WS_WGLU) + (size_t)l * 1024 * 512, 512, 512, 512, 0, 0};
          Order S; S.init(T / 256, 4, 1, G, c);
          EpiGlu E{P.b_glu + l * 1024, SG, cat};
          for (int rep = 0; rep < REP_GLU; ++rep) gemm_phase(lds, g, S, E, wid); }
        { Gemm g{pb + (size_t)l * T * 256, (const bf16_t*)(ws + WS_WPP) + (size_t)l * 1024 * 256, 256, 256, 256, 0, 0};
          Order S; S.init(T / 256, 4, 1, G, c);
          EpiPP E{pp};
          for (int rep = 0; rep < REP_PP; ++rep) gemm_phase(lds, g, S, E, wid); }
        GSYNC();
        { Gemm g{cat, (const bf16_t*)(ws + WS_WOUT) + (size_t)l * 1024 * 1024, 1024, 1024, 1024, 0, 0};
          Order S; S.init(T / 256, 4, 1, G, c);
          EpiOut E{hbA, hbB, ssMid};
          gemm_phase(lds, g, S, E, wid); }
        GSYNC();
        { Gemm g{hbB, (const bf16_t*)(ws + WS_WPG) + (size_t)l * 1024 * 1024, 1024, 1024, 1024, 0, 0};
          Order S; S.init(T / 256, 4, 1, G, c);
          EpiPle E{ssMid, hbB, P.out, pp, hbA, ssNext, l == 1 ? 1 : 0};
          gemm_phase(lds, g, S, E, wid); }
        if (l == 0) GSYNC();
    };
    layer(0); layer(1);
}

extern "C" void kernel_launch(void* const* d_in, const int* in_sizes, int n_in, void* d_out, int out_size, void* d_ws, size_t ws_size, hipStream_t stream) {
    static int grid = 0;
    if (grid == 0) {
        if (n_in != 20 || ws_size < WS_END) { fprintf(stderr, "kernel_launch: unexpected inputs (n_in %d, ws %zu < %zu)\n", n_in, ws_size, (size_t)WS_END); grid = -1; return; }
        int dev = 0, cus = 0, per_cu = 0;
        hipGetDevice(&dev); hipDeviceGetAttribute(&cus, hipDeviceAttributeMultiprocessorCount, dev);
        if (hipFuncSetAttribute((const void*)mega, hipFuncAttributeMaxDynamicSharedMemorySize, LDS_BYTES) != hipSuccess) { fprintf(stderr, "hipFuncSetAttribute failed\n"); grid = -1; return; }
        if (hipOccupancyMaxActiveBlocksPerMultiprocessor(&per_cu, (const void*)mega, 512, LDS_BYTES) != hipSuccess || per_cu < 1) { fprintf(stderr, "occupancy query: %d\n", per_cu); per_cu = 1; }
        (void)hipGetLastError();
        if (cus < 256) { fprintf(stderr, "kernel_launch: built for a 256-CU device (static work partition over 256 workgroups), found %d CUs; nothing launched\n", cus); grid = -1; return; }
        grid = 256;
    }
    if (grid < 0) return;
    if (hipMemsetAsync((char*)d_ws + WS_MISC + 786432, 0, XCD_BAR_WORDS * 4, stream) != hipSuccess) { fprintf(stderr, "kernel_launch: hipMemsetAsync failed\n"); return; }
    Params P{};
    const float** pp = (const float**)&P;
    for (int i = 0; i < 20; ++i) pp[i] = (const float*)d_in[i];
    P.out = (float*)d_out; P.ws = (unsigned char*)d_ws;
    void* args[] = {&P};
    hipError_t e = hipLaunchCooperativeKernel((const void*)mega, dim3(grid), dim3(512), args, LDS_BYTES, stream);
    if (e != hipSuccess) fprintf(stderr, "cooperative launch failed: %s (grid %d)\n", hipGetErrorString(e), grid);
}
```

```cpp
#ifndef REP_P0
#define REP_P0 1
#define REP_INPROJ 1
#define REP_ATTN 1
#define REP_SCAN 1
#define REP_SYNC 1
#define REP_GEMMS 1
#define REP_PP 1
#define REP_Y 1
#define REP_GLU 1
#endif
#include <hip/hip_runtime.h>
#include <hip/hip_cooperative_groups.h>
#include <cstdio>
namespace cg = cooperative_groups;

#define LAS __attribute__((address_space(3)))
#define DI __device__ __forceinline__
typedef unsigned short bf16_t;
typedef short bf16x8 __attribute__((ext_vector_type(8)));
typedef float f32x4 __attribute__((ext_vector_type(4)));
typedef float f32x16 __attribute__((ext_vector_type(16)));
typedef unsigned u32x4 __attribute__((ext_vector_type(4)));
typedef unsigned u32x2 __attribute__((ext_vector_type(2)));

constexpr int T = 32768, SEQ = 4096;
constexpr int BM = 256, BK = 64, HALF = 128, HTB = HALF * BK * 2, STAGE_BYTES = 8 * HTB, NXCD = 8, WGM = 2;
constexpr int LDS_DUMMY = STAGE_BYTES + 16;
constexpr int LDS_BYTES = STAGE_BYTES + 16 + 2048;

constexpr size_t MBy = 1u << 20;
constexpr size_t WS_WIN = 0;
constexpr size_t WS_WGLU = WS_WIN + 12 * MBy;
constexpr size_t WS_WOUT = WS_WGLU + 2 * MBy;
constexpr size_t WS_WPG = WS_WOUT + 4 * MBy;
constexpr size_t WS_WPP = WS_WPG + 4 * MBy;
constexpr size_t WS_W1 = WS_WPP + 1 * MBy;
constexpr size_t WS_TOEP = WS_W1 + 16 * MBy;
constexpr size_t WS_MISC = WS_TOEP + 40 * MBy;
constexpr size_t WS_HBA = WS_MISC + 1 * MBy;
constexpr size_t WS_UCAT = WS_HBA + 64 * MBy;
constexpr size_t WS_SGGA = WS_UCAT + 40 * MBy;
constexpr size_t WS_QK = WS_SGGA + 64 * MBy;
constexpr size_t WS_VT = WS_QK + 64 * MBy;
constexpr size_t WS_CAT = WS_VT + 32 * MBy;
constexpr size_t WS_SBUF = WS_CAT + 64 * MBy;
constexpr size_t WS_PB = WS_SBUF + 16 * MBy;
constexpr size_t WS_ZB = WS_PB + 32 * MBy;
constexpr size_t WS_END = WS_ZB + 32 * MBy;

struct Params {
    const float *x, *p, *mix_g, *w_in, *a_re, *a_im, *log_dt, *b_re, *b_im, *c_re, *c_im, *dsk, *w_glu, *b_glu, *q_g, *k_g, *w_out, *ple_g, *w_pg, *w_pp;
    float* out; unsigned char* ws;
};

DI int lane_fresh() { int l; asm volatile("v_mbcnt_lo_u32_b32 %0, -1, 0\n\tv_mbcnt_hi_u32_b32 %0, -1, %0" : "=v"(l)); return l; }
DI unsigned cvt_pk_bf16(float lo, float hi) { unsigned r; asm volatile("v_cvt_pk_bf16_f32 %0, %1, %2" : "=v"(r) : "v"(lo), "v"(hi)); return r; }
DI float bf_lo(unsigned w) { return __uint_as_float(w << 16); }
DI float bf_hi(unsigned w) { return __uint_as_float(w & 0xffff0000u); }
DI float fsigmoid(float x) { return __builtin_amdgcn_rcpf(1.0f + __expf(-x)); }
DI float fsilu(float x) { return x * fsigmoid(x); }
DI float fgelu_tanh(float y) { const float u2 = 1.5957691216057308f * (y + 0.044715f * y * y * y); return y * fsigmoid(u2); }

DI int lds_byte(int r, int c) { const int st = (r >> 4) * 2 + (c >> 5), rr = r & 15, cc = c & 31, ob = rr * 64 + cc * 2; return st * 1024 + (ob ^ (((ob >> 9) & 1) << 5)); }
DI void stage_rc(int b, int& R, int& C) { const int st = b / 1024, sb = b % 1024, swz = sb ^ (((sb >> 9) & 1) << 5); R = (st >> 1) * 16 + swz / 64; C = (st & 1) * 32 + (swz % 64) / 2; }

struct Unit { int pm, pn, g; };
struct Gemm { const bf16_t* A; const bf16_t* Bt; int lda, ldb, K; size_t gsA, gsB; };
struct Order {
    int nM, nN, nwg, total, G, c, lim;
    DI void init(int nM_, int nN_, int nG, int G_, int c_) { nM = nM_; nN = nN_; nwg = nM * nN; total = nwg * nG; lim = total; G = G_; c = c_; asm volatile("" : "+s"(c)); }
    DI bool next(int i, Unit& u) const {
        if (nwg < 0) { if (i >= lim) return false; u.g = nM; u.pm = nN; u.pn = i; return true; }
        int L = i * G + c; if (L >= lim) return false;
        if (total > nwg) {
            const int gpx = (total / nwg) >> 3, q = (c >> 3) + (G >> 3) * i; if (q >= gpx * nwg) return false;
            L = ((c & 7) * gpx + q / nwg) * nwg + q % nwg; }
        u.g = L / nwg; int wgid = L - u.g * nwg;
        { const int q = nwg / NXCD, r = nwg % NXCD, xcd = wgid % NXCD, off = wgid / NXCD; wgid = (xcd < r ? xcd * (q + 1) : r * (q + 1) + (xcd - r) * q) + off; }
        const int nig = WGM * nN, gid = wgid / nig, fm = gid * WGM, gsz = (nM - fm) < WGM ? (nM - fm) : WGM;
        u.pm = fm + ((wgid % nig) % gsz); u.pn = (wgid % nig) / gsz; return true;
    }
};

template <class Epi>
DI void gemm_phase(LAS unsigned char* lds, const Gemm g, const Order& S, const Epi& E, const int wid) {
    const int lane = lane_fresh(), tid = wid * 64 + lane, wr = wid >> 2, wc = wid & 3, fr = lane & 15, fq = lane >> 4;
    const int K = g.K, nt = K / BK;
    unsigned voffA[2], voffB[2];
#pragma unroll
    for (int i = 0; i < 2; ++i) { int R, C; stage_rc(tid * 16 + i * 8192, R, C); voffA[i] = (unsigned)(R * g.lda + C) * 2u; voffB[i] = (unsigned)(R * g.ldb + C) * 2u; }
    const size_t kstep = (size_t)(BK * 2);
    const size_t hstepA = (size_t)HALF * g.lda * 2, hstepB = (size_t)HALF * g.ldb * 2;
    const size_t tstepA = 2 * hstepA, tstepB = 2 * hstepB;
    const unsigned ldsw = (unsigned)wid * 1024u;
    const int aoff = lds_byte(wr * 64 + fr, fq * 8), boff = lds_byte(wc * 32 + fr, fq * 8);
#define PG8_SA(b, h) (((b) * 2 + (h)) * HTB)
#define PG8_SB(b, h) ((4 + (b) * 2 + (h)) * HTB)
#define PG8_STAGE(bufoff, gbase, voff) do { _Pragma("unroll") for (int _i = 0; _i < 2; ++_i) \
        __builtin_amdgcn_global_load_lds((const unsigned*)((const char*)(gbase) + (voff)[_i]), (LAS unsigned*)(lds + (bufoff) + ldsw + _i * 8192), 16, 0, 0); } while (0)
#define PG8_LDA(dst, b, h) do { _Pragma("unroll") for (int m = 0; m < 4; ++m) _Pragma("unroll") for (int k = 0; k < 2; ++k) dst[m][k] = *(const LAS bf16x8*)(lds + PG8_SA(b, h) + aoff + m * 2048 + k * 1024); } while (0)
#define PG8_LDB(dst, b, h) do { _Pragma("unroll") for (int n = 0; n < 2; ++n) _Pragma("unroll") for (int k = 0; k < 2; ++k) dst[n][k] = *(const LAS bf16x8*)(lds + PG8_SB(b, h) + boff + n * 2048 + k * 1024); } while (0)
#define PG8_MMA(ai, bj, At, Bt) do { __builtin_amdgcn_s_setprio(1); _Pragma("unroll") for (int m = 0; m < 4; ++m) _Pragma("unroll") for (int n = 0; n < 2; ++n) _Pragma("unroll") for (int k = 0; k < 2; ++k) \
        acc[ai][bj][m][n] = __builtin_amdgcn_mfma_f32_16x16x32_bf16(Bt[n][k], At[m][k], acc[ai][bj][m][n], 0, 0, 0); __builtin_amdgcn_s_setprio(0); } while (0)
#define PG8_WAIT_V(n) asm volatile("s_waitcnt vmcnt(" #n ")" ::: "memory")
#define PG8_WAIT_L(n) asm volatile("s_waitcnt lgkmcnt(" #n ")" ::: "memory")
#define PG8_BAR __builtin_amdgcn_s_barrier()
#define PG8_SCHED __builtin_amdgcn_sched_barrier(0)
    Unit cur, nxt; int ui = 0;
    if (!S.next(0, cur)) return;
    f32x4 acc[2][2][4][2];
#pragma unroll
    for (int a = 0; a < 2; ++a)
#pragma unroll
        for (int b = 0; b < 2; ++b)
#pragma unroll
            for (int m = 0; m < 4; ++m)
#pragma unroll
                for (int n = 0; n < 2; ++n) acc[a][b][m][n] = (f32x4){0.f, 0.f, 0.f, 0.f};
    bf16x8 At[4][2], B0[2][2], B1[2][2];
    const char* cA = (const char*)(g.A + (size_t)cur.g * g.gsA) + (size_t)cur.pm * tstepA;
    const char* cB = (const char*)(g.Bt + (size_t)cur.g * g.gsB) + (size_t)cur.pn * tstepB;
    PG8_STAGE(PG8_SB(0, 0), cB, voffB); PG8_STAGE(PG8_SB(0, 1), cB + hstepB, voffB); PG8_STAGE(PG8_SA(0, 0), cA, voffA); PG8_STAGE(PG8_SA(0, 1), cA + hstepA, voffA);
    if (wr == 1) PG8_BAR;
    PG8_WAIT_V(2); PG8_BAR;
    PG8_STAGE(PG8_SB(1, 0), cB + kstep, voffB); PG8_STAGE(PG8_SA(1, 0), cA + kstep, voffA); PG8_STAGE(PG8_SB(1, 1), cB + hstepB + kstep, voffB);
    PG8_WAIT_V(6); PG8_BAR;
    for (;;) {
        const bool has_next = S.next(ui + 1, nxt);
        const char* nA = has_next ? (const char*)(g.A + (size_t)nxt.g * g.gsA) + (size_t)nxt.pm * tstepA : cA;
        const char* nB = has_next ? (const char*)(g.Bt + (size_t)nxt.g * g.gsB) + (size_t)nxt.pn * tstepB : cB;
        for (int t = 0; t < nt; t += 2) {
            const bool last = (t == nt - 2);
            const char* a1 = cA + (size_t)(t + 1) * kstep;
            const char* a2 = last ? nA : cA + (size_t)(t + 2) * kstep; const char* b2 = last ? nB : cB + (size_t)(t + 2) * kstep;
            const char* a3 = a2 + kstep; const char* b3 = b2 + kstep;
            if (t == nt - 2) E.prefetch(cur, lds, wid);
            PG8_LDB(B0, 0, 0); PG8_LDB(B1, 0, 1); PG8_SCHED; PG8_LDA(At, 0, 0); PG8_STAGE(PG8_SA(1, 1), a1 + hstepA, voffA);
            PG8_WAIT_V(8); PG8_WAIT_L(0); PG8_BAR; PG8_MMA(0, 0, At, B0); PG8_MMA(0, 1, At, B1); PG8_BAR; PG8_SCHED;
            PG8_LDA(At, 0, 1); PG8_STAGE(PG8_SB(0, 0), b2, voffB); PG8_STAGE(PG8_SB(0, 1), b2 + hstepB, voffB); PG8_STAGE(PG8_SA(0, 0), a2, voffA);
            PG8_WAIT_V(8); PG8_WAIT_L(0); PG8_BAR; PG8_MMA(1, 0, At, B0); PG8_MMA(1, 1, At, B1); PG8_BAR; PG8_SCHED;
            PG8_LDB(B0, 1, 0); PG8_LDB(B1, 1, 1); PG8_SCHED; PG8_LDA(At, 1, 0); PG8_STAGE(PG8_SA(0, 1), a2 + hstepA, voffA);
            PG8_WAIT_V(8); PG8_WAIT_L(0); PG8_BAR; PG8_MMA(0, 0, At, B0); PG8_MMA(0, 1, At, B1); PG8_BAR; PG8_SCHED;
            PG8_LDA(At, 1, 1); PG8_STAGE(PG8_SB(1, 0), b3, voffB); PG8_STAGE(PG8_SB(1, 1), b3 + hstepB, voffB); PG8_STAGE(PG8_SA(1, 0), a3, voffA);
            PG8_WAIT_V(8); PG8_WAIT_L(0); PG8_BAR; PG8_MMA(1, 0, At, B0); PG8_MMA(1, 1, At, B1); PG8_BAR; PG8_SCHED;
        }
        if (wr == 0) PG8_BAR;
        { const int le = lane_fresh(); E(acc, cur, wr, wc, le & 15, le >> 4); }
        if (!has_next) break;
#pragma unroll
        for (int a = 0; a < 2; ++a)
#pragma unroll
            for (int b = 0; b < 2; ++b)
#pragma unroll
                for (int m = 0; m < 4; ++m)
#pragma unroll
                    for (int n = 0; n < 2; ++n) acc[a][b][m][n] = (f32x4){0.f, 0.f, 0.f, 0.f};
        cur = nxt; cA = nA; cB = nB; ++ui;
        if (wr == 1) PG8_BAR;
    }
    PG8_WAIT_V(0);
    PG8_BAR;
#undef PG8_SA
#undef PG8_SB
#undef PG8_STAGE
#undef PG8_LDA
#undef PG8_LDB
#undef PG8_MMA
#undef PG8_WAIT_V
#undef PG8_WAIT_L
#undef PG8_BAR
#undef PG8_SCHED
}

#define EPI_ROWS _Pragma("unroll") for (int ai = 0; ai < 2; ++ai) _Pragma("unroll") for (int m = 0; m < 4; ++m) if ((__extension__({ if ((m & 1) == 0) asm volatile("" ::: "memory"); 1; })))
#define EPI_ROWS_NF _Pragma("unroll") for (int ai = 0; ai < 2; ++ai) _Pragma("unroll") for (int m = 0; m < 4; ++m)
#define EPI_COLS _Pragma("unroll") for (int bj = 0; bj < 2; ++bj) _Pragma("unroll") for (int n = 0; n < 2; ++n)

struct EpiIn {
    DI void prefetch(const Unit& u, LAS unsigned char* lds, int wid) const {
        if (wid < 4) __builtin_amdgcn_global_load_lds((const unsigned*)(ss + u.pm * BM + wid * 64 + lane_fresh()), (LAS unsigned*)(lds + LDS_DUMMY + wid * 256), 4, 0, 0);
    }
    const float* ss; bf16_t *Ucat, *SG, *GA, *Q, *Kb, *VT; const float *qg, *kg;
    DI void operator()(const f32x4 (&acc)[2][2][4][2], const Unit& u, int wr, int wc, int fr, int fq) const {
        const int type = u.pn >> 1, hf = u.pn & 1;
        float rsv[2][4];
        EPI_ROWS_NF rsv[ai][m] = ss[u.pm * BM + ai * HALF + wr * 64 + m * 16 + fr];
        EPI_ROWS_NF rsv[ai][m] = rsqrtf(rsv[ai][m] * (1.f / 1024.f) + 1e-6f);
#define EPI_BJ _Pragma("unroll") for (int bj = 0; bj < 2; ++bj)
#define PACK8(w, a0, a1) do { w.x = cvt_pk_bf16(a0[0], a0[1]); w.y = cvt_pk_bf16(a0[2], a0[3]); w.z = cvt_pk_bf16(a1[0], a1[1]); w.w = cvt_pk_bf16(a1[2], a1[3]); } while (0)
        if (type == 0) {
            EPI_ROWS_NF { const int row = u.pm * BM + ai * HALF + wr * 64 + m * 16 + fr; const float rs = rsv[ai][m];
                EPI_BJ { const f32x4 v0 = acc[ai][bj][m][0] * rs, v1 = acc[ai][bj][m][1] * rs; const int g = 16 * hf + 4 * wc + 2 * bj + (fq >> 1);
                    u32x4 w; PACK8(w, v0, v1);
                    *(u32x4*)(Ucat + ((size_t)(g * 1024 + (row >> 5)) * 640 + (row & 31) * 16 + 8 * (fq & 1))) = w; } }
        } else if (type == 1 || type == 5) {
            bf16_t* dst = type == 1 ? SG : GA;
            EPI_ROWS_NF { const int row = u.pm * BM + ai * HALF + wr * 64 + m * 16 + fr; const float rs = rsv[ai][m];
                EPI_BJ { f32x4 v0 = acc[ai][bj][m][0] * rs, v1 = acc[ai][bj][m][1] * rs; const int cs = 256 * hf + 64 * wc + 32 * bj + 8 * fq;
#pragma unroll
                    for (int j = 0; j < 4; ++j) { v0[j] = fsilu(v0[j]); v1[j] = fsilu(v1[j]); }
                    u32x4 w; PACK8(w, v0, v1);
                    *(u32x4*)(dst + (size_t)row * 512 + cs) = w; } }
        } else if (type == 2 || type == 3) {
            bf16_t* dst = type == 2 ? Q : Kb; const float* gam = type == 2 ? qg : kg; const float sc = type == 2 ? 0.125f : 1.0f;
            f32x4 gv[2][2];
            EPI_COLS gv[bj][n] = *(const f32x4*)(gam + 32 * bj + 8 * fq + 4 * n) * sc;
            EPI_ROWS_NF { const int row = u.pm * BM + ai * HALF + wr * 64 + m * 16 + fr; const float rs = rsv[ai][m];
                f32x4 v[2][2]; float s = 0.f;
                EPI_COLS { v[bj][n] = acc[ai][bj][m][n] * rs; s += (v[bj][n][0] * v[bj][n][0] + v[bj][n][1] * v[bj][n][1]) + (v[bj][n][2] * v[bj][n][2] + v[bj][n][3] * v[bj][n][3]); }
                s += __shfl_xor(s, 16); s += __shfl_xor(s, 32);
                const float ri = rsqrtf(s * (1.f / 64.f) + 1e-6f);
                EPI_BJ { const f32x4 o0 = v[bj][0] * ri * gv[bj][0], o1 = v[bj][1] * ri * gv[bj][1]; const int cs = 256 * hf + 64 * wc + 32 * bj + 8 * fq;
                    u32x4 w; PACK8(w, o0, o1);
                    if (type == 2) *(u32x4*)(dst + (size_t)row * 512 + cs) = w;
                    else {
                        const int key = row & 4095;
                        *(u32x4*)(dst + (((size_t)((row >> 12) * 8 + 4 * hf + wc)) << 18) + (key >> 5) * 2048 + (2 * bj + (fq >> 1)) * 512 + (key & 31) * 16 + 8 * (fq & 1)) = w; } } }
        } else {
            EPI_ROWS_NF { const int row = u.pm * BM + ai * HALF + wr * 64 + m * 16 + fr; const float rs = rsv[ai][m];
                const int b = row >> 12, s = row & 4095, head = 4 * hf + wc;
                EPI_COLS { const f32x4 v = acc[ai][bj][m][n] * rs;
                    const unsigned w0 = cvt_pk_bf16(v[0], v[1]), w1 = cvt_pk_bf16(v[2], v[3]);
                    bf16_t* o = VT + (((size_t)(b * 8 + head)) << 18) + (s >> 5) * 2048 + bj * 1024 + ((s >> 4) & 1) * 512 + (8 * fq + 4 * n) * 16 + (s & 15);
                    o[0] = (bf16_t)(w0 & 0xffffu); o[16] = (bf16_t)(w0 >> 16); o[32] = (bf16_t)(w1 & 0xffffu); o[48] = (bf16_t)(w1 >> 16); } }
        }
#undef EPI_BJ
#undef PACK8
    }
};
struct EpiS {
    DI void prefetch(const Unit&, LAS unsigned char*, int) const {}
    float* Sbuf;
    DI void operator()(const f32x4 (&acc)[2][2][4][2], const Unit& u, int wr, int wc, int fr, int fq) const {
        EPI_ROWS { const int R = u.pm * BM + ai * HALF + wr * 64 + m * 16 + fr;
#pragma unroll
            for (int n = 0; n < 2; ++n) *(f32x4*)(Sbuf + ((size_t)(u.g * 1024 + R) * 128 + 32 * wc + 16 * n + 4 * fq)) = acc[ai][0][m][n]; }
    }
};
struct EpiY {
    DI void prefetch(const Unit&, LAS unsigned char*, int) const {}
    const bf16_t* Ucat; const float* dsk; bf16_t* zb;
    DI void operator()(const f32x4 (&acc)[2][2][4][2], const Unit& u, int wr, int wc, int fr, int fq) const {
        const int h0 = 8 * (fq & 1);
        const f32x4 dv0 = *(const f32x4*)(dsk + u.g * 16 + h0), dv1 = *(const f32x4*)(dsk + u.g * 16 + h0 + 4);
        EPI_ROWS { const int R = u.pm * BM + ai * HALF + wr * 64 + m * 16 + fr;
#pragma unroll
            for (int bj = 0; bj < 2; ++bj) { const int ncol = u.pn * BM + bj * HALF + 32 * wc + 8 * fq;
                const u32x4 ub = *(const u32x4*)(Ucat + ((size_t)(u.g * 1024 + R) * 640 + ncol));
                f32x4 y0 = acc[ai][bj][m][0], y1 = acc[ai][bj][m][1];
                y0[0] += dv0[0] * bf_lo(ub.x); y0[1] += dv0[1] * bf_hi(ub.x); y0[2] += dv0[2] * bf_lo(ub.y); y0[3] += dv0[3] * bf_hi(ub.y);
                y1[0] += dv1[0] * bf_lo(ub.z); y1[1] += dv1[1] * bf_hi(ub.z); y1[2] += dv1[2] * bf_lo(ub.w); y1[3] += dv1[3] * bf_hi(ub.w);
                u32x4 w; w.x = cvt_pk_bf16(fgelu_tanh(y0[0]), fgelu_tanh(y0[1])); w.y = cvt_pk_bf16(fgelu_tanh(y0[2]), fgelu_tanh(y0[3]));
                w.z = cvt_pk_bf16(fgelu_tanh(y1[0]), fgelu_tanh(y1[1])); w.w = cvt_pk_bf16(fgelu_tanh(y1[2]), fgelu_tanh(y1[3]));
                const int token = R * 32 + (ncol >> 4);
                *(u32x4*)(zb + (size_t)token * 512 + u.g * 16 + h0) = w; } }
    }
};
struct EpiGlu {
    DI void prefetch(const Unit& u, LAS unsigned char* lds, int wid) const {
        const int id = wid * 64 + lane_fresh(), row = id >> 1, seg = id & 1;
        __builtin_amdgcn_global_load_lds((const unsigned*)(SG + (size_t)(u.pm * BM + row) * 512 + u.pn * 128 + seg * 64), (LAS unsigned*)(lds + LDS_DUMMY + wid * 256), 4, 0, 0);
    }
    const float* bglu; const bf16_t* SG; bf16_t* cat;
    DI void operator()(const f32x4 (&acc)[2][2][4][2], const Unit& u, int wr, int wc, int fr, int fq) const {
        const int ch = u.pn * 128 + 32 * wc + 8 * fq;
        f32x4 bv[2], bg[2];
#pragma unroll
        for (int n = 0; n < 2; ++n) { bv[n] = *(const f32x4*)(bglu + ch + 4 * n); bg[n] = *(const f32x4*)(bglu + 512 + ch + 4 * n); }
        EPI_ROWS { const int row = u.pm * BM + ai * HALF + wr * 64 + m * 16 + fr;
            const f32x4 v0 = acc[ai][0][m][0] + bv[0], g0 = acc[ai][1][m][0] + bg[0], v1 = acc[ai][0][m][1] + bv[1], g1 = acc[ai][1][m][1] + bg[1];
            const u32x4 sg = *(const u32x4*)(SG + (size_t)row * 512 + ch);
            u32x4 w;
            w.x = cvt_pk_bf16(v0[0] * fsigmoid(g0[0]) * bf_lo(sg.x), v0[1] * fsigmoid(g0[1]) * bf_hi(sg.x)); w.y = cvt_pk_bf16(v0[2] * fsigmoid(g0[2]) * bf_lo(sg.y), v0[3] * fsigmoid(g0[3]) * bf_hi(sg.y));
            w.z = cvt_pk_bf16(v1[0] * fsigmoid(g1[0]) * bf_lo(sg.z), v1[1] * fsigmoid(g1[1]) * bf_hi(sg.z)); w.w = cvt_pk_bf16(v1[2] * fsigmoid(g1[2]) * bf_lo(sg.w), v1[3] * fsigmoid(g1[3]) * bf_hi(sg.w));
            *(u32x4*)(cat + (size_t)row * 1024 + ch) = w; }
    }
};
struct EpiOut {
    DI void prefetch(const Unit& u, LAS unsigned char* lds, int wid) const {
        const int tid = wid * 64 + lane_fresh();
#pragma unroll
        for (int i = 0; i < 2; ++i) { const int id = tid + 512 * i, row = id >> 2, seg = id & 3;
            __builtin_amdgcn_global_load_lds((const unsigned*)(hin + (size_t)(u.pm * BM + row) * 1024 + u.pn * BM + seg * 64), (LAS unsigned*)(lds + LDS_DUMMY + wid * 256), 4, 0, 0); }
    }
    const bf16_t* hin; bf16_t* hb; float* ss;
    DI void operator()(const f32x4 (&acc)[2][2][4][2], const Unit& u, int wr, int wc, int fr, int fq) const {
        EPI_ROWS { const int row = u.pm * BM + ai * HALF + wr * 64 + m * 16 + fr; float s = 0.f;
#pragma unroll
            for (int bj = 0; bj < 2; ++bj) { const size_t off = (size_t)row * 1024 + u.pn * BM + bj * HALF + 32 * wc + 8 * fq;
                const u32x4 rw = *(const u32x4*)(hin + off); f32x4 h0 = acc[ai][bj][m][0], h1_ = acc[ai][bj][m][1];
                h0[0] += bf_lo(rw.x); h0[1] += bf_hi(rw.x); h0[2] += bf_lo(rw.y); h0[3] += bf_hi(rw.y); h1_[0] += bf_lo(rw.z); h1_[1] += bf_hi(rw.z); h1_[2] += bf_lo(rw.w); h1_[3] += bf_hi(rw.w);
                u32x4 w; w.x = cvt_pk_bf16(h0[0], h0[1]); w.y = cvt_pk_bf16(h0[2], h0[3]); w.z = cvt_pk_bf16(h1_[0], h1_[1]); w.w = cvt_pk_bf16(h1_[2], h1_[3]); *(u32x4*)(hb + off) = w;
                s += ((h0[0] * h0[0] + h0[1] * h0[1]) + (h0[2] * h0[2] + h0[3] * h0[3])) + ((h1_[0] * h1_[0] + h1_[1] * h1_[1]) + (h1_[2] * h1_[2] + h1_[3] * h1_[3])); }
            s += __shfl_xor(s, 16); s += __shfl_xor(s, 32);
            if (fq == 0) atomicAdd(ss + row, s); }
    }
};
struct EpiPle {
    DI void prefetch(const Unit& u, LAS unsigned char* lds, int wid) const {
        const int tid = wid * 64 + lane_fresh();
#pragma unroll
        for (int i = 0; i < 2; ++i) { const int id = tid + 512 * i, row = id >> 2, seg = id & 3; const size_t off = (size_t)(u.pm * BM + row) * 1024 + u.pn * BM + seg * 64;
            __builtin_amdgcn_global_load_lds((const unsigned*)(h1 + off), (LAS unsigned*)(lds + LDS_DUMMY + wid * 256), 4, 0, 0);
            __builtin_amdgcn_global_load_lds((const unsigned*)(pp + off), (LAS unsigned*)(lds + LDS_DUMMY + wid * 256), 4, 0, 0); }
        if (wid < 4) __builtin_amdgcn_global_load_lds((const unsigned*)(ss1 + u.pm * BM + tid), (LAS unsigned*)(lds + LDS_DUMMY + wid * 256), 4, 0, 0);
    }
    const float* ss1; const bf16_t* h1; float* h; const bf16_t* pp; bf16_t* hb; float* ss2; int last;
    DI void operator()(const f32x4 (&acc)[2][2][4][2], const Unit& u, int wr, int wc, int fr, int fq) const {
        float rsv[2][4];
        EPI_ROWS_NF rsv[ai][m] = ss1[u.pm * BM + ai * HALF + wr * 64 + m * 16 + fr];
        EPI_ROWS_NF rsv[ai][m] = rsqrtf(rsv[ai][m] * (1.f / 1024.f) + 1e-6f);
        EPI_ROWS { const int row = u.pm * BM + ai * HALF + wr * 64 + m * 16 + fr; float s = 0.f;
            const float rs = rsv[ai][m];
#pragma unroll
            for (int bj = 0; bj < 2; ++bj) { const size_t off = (size_t)row * 1024 + u.pn * BM + bj * HALF + 32 * wc + 8 * fq;
                const f32x4 a0 = acc[ai][bj][m][0] * rs, a1 = acc[ai][bj][m][1] * rs; const u32x4 pw = *(const u32x4*)(pp + off); const u32x4 hw = *(const u32x4*)(h1 + off);
                f32x4 h0, h1_;
                h0[0] = bf_lo(hw.x) + fsigmoid(a0[0]) * bf_lo(pw.x); h0[1] = bf_hi(hw.x) + fsigmoid(a0[1]) * bf_hi(pw.x); h0[2] = bf_lo(hw.y) + fsigmoid(a0[2]) * bf_lo(pw.y); h0[3] = bf_hi(hw.y) + fsigmoid(a0[3]) * bf_hi(pw.y);
                h1_[0] = bf_lo(hw.z) + fsigmoid(a1[0]) * bf_lo(pw.z); h1_[1] = bf_hi(hw.z) + fsigmoid(a1[1]) * bf_hi(pw.z); h1_[2] = bf_lo(hw.w) + fsigmoid(a1[2]) * bf_lo(pw.w); h1_[3] = bf_hi(hw.w) + fsigmoid(a1[3]) * bf_hi(pw.w);
                if (last) { *(f32x4*)(h + off) = h0; *(f32x4*)(h + off + 4) = h1_; }
                if (!last) { u32x4 w; w.x = cvt_pk_bf16(h0[0], h0[1]); w.y = cvt_pk_bf16(h0[2], h0[3]); w.z = cvt_pk_bf16(h1_[0], h1_[1]); w.w = cvt_pk_bf16(h1_[2], h1_[3]); *(u32x4*)(hb + off) = w;
                    s += ((h0[0] * h0[0] + h0[1] * h0[1]) + (h0[2] * h0[2] + h0[3] * h0[3])) + ((h1_[0] * h1_[0] + h1_[1] * h1_[1]) + (h1_[2] * h1_[2] + h1_[3] * h1_[3])); } }
            if (!last) { s += __shfl_xor(s, 16); s += __shfl_xor(s, 32); if (fq == 0) atomicAdd(ss2 + row, s); } }
    }
};
struct EpiPP {
    DI void prefetch(const Unit&, LAS unsigned char*, int) const {}
    bf16_t* pp;
    DI void operator()(const f32x4 (&acc)[2][2][4][2], const Unit& u, int wr, int wc, int fr, int fq) const {
        EPI_ROWS { const int row = u.pm * BM + ai * HALF + wr * 64 + m * 16 + fr;
#pragma unroll
            for (int bj = 0; bj < 2; ++bj) { const size_t off = (size_t)row * 1024 + u.pn * BM + bj * HALF + 32 * wc + 8 * fq; const f32x4 a0 = acc[ai][bj][m][0] * 1.0f, a1 = acc[ai][bj][m][1] * 1.0f;
                u32x4 w; w.x = cvt_pk_bf16(a0[0], a0[1]); w.y = cvt_pk_bf16(a0[2], a0[3]); w.z = cvt_pk_bf16(a1[0], a1[1]); w.w = cvt_pk_bf16(a1[2], a1[3]); *(u32x4*)(pp + off) = w; } }
    }
};

DI void attn_item(int item, const bf16_t* Q, const bf16_t* Kb, const bf16_t* VT, const bf16_t* GA, bf16_t* cat, int lane) {
    const int qb = item & 127, h = (item >> 7) & 7, b = item >> 10;
    const int q0 = qb * 32, hf = lane >> 5, ql = lane & 31;
    const bf16_t* qp = Q + (size_t)(b * SEQ + q0 + ql) * 512 + h * 64 + 8 * hf;
    bf16x8 qf[4];
#pragma unroll
    for (int s = 0; s < 4; ++s) qf[s] = *(const bf16x8*)(qp + 16 * s);
    const int kperm = (ql & 16) | ((ql & 4) << 1) | ((ql & 8) >> 1) | (ql & 3);
    const bf16_t* kbase = Kb + (((size_t)(b * 8 + h)) << 18) + kperm * 16 + 8 * hf;
    const bf16_t* vbase = VT + (((size_t)(b * 8 + h)) << 18) + ql * 16 + 8 * hf;
    f32x16 o0, o1;
#pragma unroll
    for (int i = 0; i < 16; ++i) { o0[i] = 0.f; o1[i] = 0.f; }
    float cprod = 1.f;
    bf16x8 kf[4], vf[2][2];
    { const bf16_t* kp = kbase + (size_t)(q0 >> 5) * 2048; const bf16_t* vp = vbase + (size_t)(q0 >> 5) * 2048;
#pragma unroll
      for (int s = 0; s < 4; ++s) kf[s] = *(const bf16x8*)(kp + 512 * s);
#pragma unroll
      for (int s = 0; s < 2; ++s) { vf[s][0] = *(const bf16x8*)(vp + 512 * s); vf[s][1] = *(const bf16x8*)(vp + 1024 + 512 * s); } }
#define ATT_TILE(DIAG) { \
        f32x16 st; _Pragma("unroll") for (int i = 0; i < 16; ++i) st[i] = 0.f; \
        _Pragma("unroll") for (int s = 0; s < 4; ++s) st = __builtin_amdgcn_mfma_f32_32x32x16_bf16(kf[s], qf[s], st, 0, 0, 0); \
        const int kn = kb >= 32 ? kb - 32 : 0; const bf16_t* kp = kbase + (size_t)(kn >> 5) * 2048; const bf16_t* vp = vbase + (size_t)(kn >> 5) * 2048; \
        bf16x8 kf2[4], vf2[2][2]; \
        _Pragma("unroll") for (int s = 0; s < 4; ++s) kf2[s] = *(const bf16x8*)(kp + 512 * s); \
        _Pragma("unroll") for (int s = 0; s < 2; ++s) { vf2[s][0] = *(const bf16x8*)(vp + 512 * s); vf2[s][1] = *(const bf16x8*)(vp + 1024 + 512 * s); } \
        float sg[16], ns[16]; float PA = 1.f, PB = 1.f; \
        _Pragma("unroll") for (int r = 0; r < 16; ++r) { \
            const float t = st[r] * -1.4426950408889634f; \
            const float e = __builtin_amdgcn_exp2f(fminf(t, 115.0f));        \
            float sgm = __builtin_amdgcn_rcpf(1.0f + e);                     \
            float nsv = e * sgm;                                             \
            if (DIAG) { const int koff = 16 * (r >> 3) + 8 * hf + (r & 7); if (koff >= ql) { sgm = 0.f; nsv = 1.f; } } \
            sg[r] = sgm; ns[r] = nsv; if (r < 8) PA *= nsv; else PB *= nsv; } \
        const float PAo = __shfl_xor(PA, 32), PBo = __shfl_xor(PB, 32); \
        float runA = cprod * (PB * PBo) * (hf == 0 ? PAo : 1.f); float runB = cprod * (hf == 0 ? PBo : 1.f); \
        float w[16]; \
        _Pragma("unroll") for (int r = 7; r >= 0; --r) { w[r] = sg[r] * runA; runA *= ns[r]; } \
        _Pragma("unroll") for (int r = 15; r >= 8; --r) { w[r] = sg[r] * runB; runB *= ns[r]; } \
        cprod *= (PA * PAo) * (PB * PBo); \
        _Pragma("unroll") for (int s = 0; s < 2; ++s) { \
            u32x4 pw; pw.x = cvt_pk_bf16(w[8 * s], w[8 * s + 1]); pw.y = cvt_pk_bf16(w[8 * s + 2], w[8 * s + 3]); pw.z = cvt_pk_bf16(w[8 * s + 4], w[8 * s + 5]); pw.w = cvt_pk_bf16(w[8 * s + 6], w[8 * s + 7]); \
            const bf16x8 wf = __builtin_bit_cast(bf16x8, pw); \
            o0 = __builtin_amdgcn_mfma_f32_32x32x16_bf16(wf, vf[s][0], o0, 0, 0, 0); \
            o1 = __builtin_amdgcn_mfma_f32_32x32x16_bf16(wf, vf[s][1], o1, 0, 0, 0); } \
        _Pragma("unroll") for (int s = 0; s < 4; ++s) kf[s] = kf2[s]; \
        _Pragma("unroll") for (int s = 0; s < 2; ++s) { vf[s][0] = vf2[s][0]; vf[s][1] = vf2[s][1]; } \
        kb -= 32; }
    { int kb = q0;
      ATT_TILE(true)
      if (kb >= 0 && !__all(cprod < 1.17549435e-38f)) {
          _Pragma("nounroll") for (;;) { ATT_TILE(false) if (kb < 0 || __all(cprod < 1.17549435e-38f)) break; } } }
#undef ATT_TILE
#pragma unroll
    for (int r = 0; r < 16; ++r) {
        const size_t tok = (size_t)(b * SEQ + q0 + 8 * (r >> 2) + 4 * hf + (r & 3));
        const float g0 = __uint_as_float((unsigned)GA[tok * 512 + h * 64 + ql] << 16), g1 = __uint_as_float((unsigned)GA[tok * 512 + h * 64 + 32 + ql] << 16);
        const unsigned w = cvt_pk_bf16(o0[r] * g0, o1[r] * g1);
        cat[tok * 1024 + 512 + h * 64 + ql] = (bf16_t)(w & 0xffffu);
        cat[tok * 1024 + 512 + h * 64 + 32 + ql] = (bf16_t)(w >> 16);
    }
}

DI void sincos_d(double ang, double& s, double& c) {
    const double k = rint(ang * 0.63661977236758134308);
    double y = fma(-k, 1.5707963267948966192, ang); y = fma(-k, 6.123233995736766e-17, y);
    const double y2 = y * y;
    const double sp = y * (1.0 - y2 * (1.0 / 6.0) * (1.0 - y2 * (1.0 / 20.0) * (1.0 - y2 * (1.0 / 42.0) * (1.0 - y2 * (1.0 / 72.0) * (1.0 - y2 * (1.0 / 110.0) * (1.0 - y2 * (1.0 / 156.0) * (1.0 - y2 * (1.0 / 210.0) * (1.0 - y2 * (1.0 / 272.0)))))))));
    const double cp = 1.0 - y2 * (1.0 / 2.0) * (1.0 - y2 * (1.0 / 12.0) * (1.0 - y2 * (1.0 / 30.0) * (1.0 - y2 * (1.0 / 56.0) * (1.0 - y2 * (1.0 / 90.0) * (1.0 - y2 * (1.0 / 132.0) * (1.0 - y2 * (1.0 / 182.0) * (1.0 - y2 * (1.0 / 240.0))))))));
    const int q = (int)((long long)k & 3);
    s = (q == 0) ? sp : (q == 1) ? cp : (q == 2) ? -sp : -cp;
    c = (q == 0) ? cp : (q == 1) ? -sp : (q == 2) ? -cp : sp;
}
DI double exp_d(double x) {
    const double k = rint(x * 1.4426950408889634074); const double r = fma(-k, 0.69314718055994530942, x);
    double t = 1.0;
#pragma unroll
    for (int i = 14; i >= 1; --i) t = 1.0 + t * r * (1.0 / (double)i);
    return ldexp(t, (int)k);
}

template <int MODE>
DI int colmap(int n) {
    if (MODE == 1) { const int pn = n >> 8, r = n & 255, bj = r >> 7, wc = (r >> 5) & 3, c = r & 31; return 256 * pn + 64 * wc + 32 * bj + c; }
    if (MODE == 2) { const int pn = n >> 8, r = n & 255; return r < 128 ? 128 * pn + r : 512 + 128 * pn + (r - 128); }
    if (MODE == 5) { const int rho = n & 31, nn = rho >> 4, i = rho & 15; const int m2 = (n & ~31) + 8 * (i >> 2) + 4 * nn + (i & 3); const int pn = m2 >> 8, r = m2 & 255, bj = r >> 7, wc = (r >> 5) & 3, c = r & 31; return 256 * pn + 64 * wc + 32 * bj + c; }
    if (MODE == 4) { const int rho = n & 31, nn = rho >> 4, i = rho & 15; const int m2 = (n & ~31) + 8 * (i >> 2) + 4 * nn + (i & 3); const int pn = m2 >> 8, r = m2 & 255; return r < 128 ? 128 * pn + r : 512 + 128 * pn + (r - 128); }
    if (MODE == 3) { const int rho = n & 31, nn = rho >> 4, i = rho & 15; return (n & ~31) + 8 * (i >> 2) + 4 * nn + (i & 3); }
    return n;
}
template <int MODE>
DI void transpose_w(const float* W, int K, int N, bf16_t* WT, const float* kscale, LAS float* scr, int gw, int nw, int lane) {
    const int nblk = N >> 5, items = (K >> 6) * nblk;
    for (int item = gw; item < items; item += nw) {
        const int kb = item / nblk, nb = item - kb * nblk, k0 = 64 * kb, n0 = 32 * nb, colL = colmap<MODE>(n0 + (lane & 31));
        float tv[32];
#pragma unroll
        for (int i = 0; i < 32; ++i) { const int kk = 2 * i + (lane >> 5); tv[i] = W[(size_t)(k0 + kk) * N + colL]; }
        if (kscale) {
#pragma unroll
            for (int i = 0; i < 32; ++i) tv[i] *= kscale[k0 + 2 * i + (lane >> 5)]; }
#pragma unroll
        for (int i = 0; i < 32; ++i) { const int kk = 2 * i + (lane >> 5); scr[kk * 33 + (lane & 31)] = tv[i]; }
        asm volatile("s_waitcnt lgkmcnt(0)" ::: "memory");
        const int cc = lane & 7;
#pragma unroll
        for (int j = 0; j < 4; ++j) { const int n = (lane >> 3) + 8 * j; const LAS float* sp = scr + (8 * cc) * 33 + n;
            u32x4 o; o.x = cvt_pk_bf16(sp[0 * 33], sp[1 * 33]); o.y = cvt_pk_bf16(sp[2 * 33], sp[3 * 33]); o.z = cvt_pk_bf16(sp[4 * 33], sp[5 * 33]); o.w = cvt_pk_bf16(sp[6 * 33], sp[7 * 33]);
            *(u32x4*)(WT + (size_t)(n0 + n) * K + k0 + 8 * cc) = o; }
        asm volatile("s_waitcnt lgkmcnt(0)" ::: "memory");
    }
}

DI void ssm_prep(const Params& P, int lg, int qd, LAS unsigned char* lds, int tid) {
    LAS float* apr = (LAS float*)lds;
    LAS float* api = apr + 33 * 64;
    LAS float* bbr = api + 33 * 64;
    LAS float* bbi = bbr + 1024;
    LAS float* cr = bbi + 1024;
    LAS float* ci = cr + 1024;
    LAS float* ktab = ci + 1024;
    LAS float* part = ktab + 8192;
    LAS double* fz = (LAS double*)(part + 8192);
    const double dt = exp_d((double)P.log_dt[lg]);
    for (int idx = tid; idx < 33 * 64; idx += 512) {
        const int tau = idx >> 6, p = idx & 63;
        const double lr = (double)P.a_re[lg * 64 + p], li = (double)P.a_im[lg * 64 + p];
        const double mag = exp_d(lr * dt * (double)tau); double s, c; sincos_d(li * dt * (double)tau, s, c);
        apr[idx] = (float)(mag * c); api[idx] = (float)(mag * s);
        if (tau == 32 && qd == 0) { float* a32 = (float*)(P.ws + WS_MISC) + (size_t)(lg * 64 + p) * 2; a32[0] = (float)(mag * c); a32[1] = (float)(mag * s); }
        if (tau == 1) {
            const double nr = mag * c - 1.0, ni = mag * s, den = lr * lr + li * li;
            fz[2 * p] = (nr * lr + ni * li) / den; fz[2 * p + 1] = (ni * lr - nr * li) / den; }
    }
    for (int idx = tid; idx < 1024; idx += 512) { cr[idx] = P.c_re[(size_t)lg * 1024 + idx]; ci[idx] = P.c_im[(size_t)lg * 1024 + idx]; }
    __syncthreads();
    for (int idx = tid; idx < 1024; idx += 512) { const int p = idx >> 4; const double fr_ = fz[2 * p], fi_ = fz[2 * p + 1];
        const double br = (double)P.b_re[(size_t)lg * 1024 + idx], bi = (double)P.b_im[(size_t)lg * 1024 + idx];
        bbr[idx] = (float)(fr_ * br - fi_ * bi); bbi[idx] = (float)(fr_ * bi + fi_ * br); }
    __syncthreads();
    {
        const int hh = tid & 255, hp = hh >> 4, h = hh & 15, ph = tid >> 8;
        float cbr[32], cbi[32];
#pragma unroll
        for (int i = 0; i < 32; ++i) { const int p = 32 * ph + i; const float c_r = cr[h * 64 + p], c_i = ci[h * 64 + p], x_r = bbr[p * 16 + hp], x_i = bbi[p * 16 + hp];
            cbr[i] = c_r * x_r - c_i * x_i; cbi[i] = c_r * x_i + c_i * x_r; }
        for (int tau = 0; tau < 32; ++tau) { float acc = 0.f;
#pragma unroll
            for (int i = 0; i < 32; ++i) acc += apr[tau * 64 + 32 * ph + i] * cbr[i] - api[tau * 64 + 32 * ph + i] * cbi[i];
            if (ph) part[tau * 256 + hh] = acc; else ktab[tau * 256 + hh] = acc; }
    }
    __syncthreads();
    for (int o = tid; o < 8192; o += 512) ktab[o] += part[o];
    __syncthreads();
    bf16_t* W1 = (bf16_t*)(P.ws + WS_W1) + (size_t)lg * 256 * 512;
    for (int it = tid; it < 128 * 64; it += 512) {
        const int n = 128 * qd + (it >> 6), k8 = it & 63, s = k8 >> 1, hp0 = (k8 & 1) * 8; float v[8];
#pragma unroll
        for (int i = 0; i < 8; ++i) {
            if (n < 128) { const int p = n & 63; const float ar = apr[(31 - s) * 64 + p], ai = api[(31 - s) * 64 + p], xr = bbr[p * 16 + hp0 + i], xi = bbi[p * 16 + hp0 + i];
                v[i] = n < 64 ? ar * xr - ai * xi : ar * xi + ai * xr; }
            else v[i] = 0.f;
        }
        u32x4 o; o.x = cvt_pk_bf16(v[0], v[1]); o.y = cvt_pk_bf16(v[2], v[3]); o.z = cvt_pk_bf16(v[4], v[5]); o.w = cvt_pk_bf16(v[6], v[7]);
        *(u32x4*)(W1 + (size_t)n * 512 + k8 * 8) = o;
    }
    bf16_t* TP = (bf16_t*)(P.ws + WS_TOEP) + (size_t)lg * 512 * 640;
    for (int it = tid; it < 256 * 80; it += 512) {
        const int n = 256 * qd + it / 80, k8 = it % 80, nl = colmap<3>(n), t = nl >> 4, h = nl & 15; float v[8];
        if (k8 < 64) { const int s = k8 >> 1, hp0 = (k8 & 1) * 8;
#pragma unroll
            for (int i = 0; i < 8; ++i) v[i] = (s <= t) ? ktab[(t - s) * 256 + (hp0 + i) * 16 + h] : 0.f;
        } else if (k8 < 72) {
#pragma unroll
            for (int i = 0; i < 8; ++i) { const int p = (k8 - 64) * 8 + i; v[i] = cr[h * 64 + p] * apr[(t + 1) * 64 + p] - ci[h * 64 + p] * api[(t + 1) * 64 + p]; }
        } else {
#pragma unroll
            for (int i = 0; i < 8; ++i) { const int p = (k8 - 72) * 8 + i; v[i] = -(cr[h * 64 + p] * api[(t + 1) * 64 + p] + ci[h * 64 + p] * apr[(t + 1) * 64 + p]); }
        }
        u32x4 o; o.x = cvt_pk_bf16(v[0], v[1]); o.y = cvt_pk_bf16(v[2], v[3]); o.z = cvt_pk_bf16(v[4], v[5]); o.w = cvt_pk_bf16(v[6], v[7]);
        *(u32x4*)(TP + (size_t)n * 640 + k8 * 8) = o;
    }
    __syncthreads();
}

#define XB_TMO      128
#define XB_XCNT(j)  (256  + 64 * (j))
#define XB_XSUB(j)  (1280 + 64 * (j))
#define XB_XGEN(j)  (2304 + 64 * (j))
#define XB_TOP      3328
#define XB_TOPGEN   3392
#define XCD_BAR_WORDS 3456
#define XB_SPIN_CAP (1u << 18)
DI unsigned xb_ld(unsigned* p) { return __hip_atomic_load(p, __ATOMIC_RELAXED, __HIP_MEMORY_SCOPE_AGENT); }
DI unsigned xb_add(unsigned* p, unsigned v) { return __hip_atomic_fetch_add(p, v, __ATOMIC_RELAXED, __HIP_MEMORY_SCOPE_AGENT); }
DI unsigned xb_xcc_id() { return (unsigned)__builtin_amdgcn_s_getreg((3 << 11) | 20) & 0xFu; }
#define XB_SPIN(cond, bar) do { unsigned _sp = 0; while (cond) { __builtin_amdgcn_s_sleep(1); \
    if ((++_sp & 255u) == 0u) { if (xb_ld(&(bar)[XB_TMO])) break; if (_sp > XB_SPIN_CAP) { atomicAdd(&(bar)[XB_TMO], 1u); break; } } } } while (0)
DI void xcd_barrier_complete(unsigned* bar, unsigned x, unsigned G, unsigned& nloc, unsigned& nx) {
    unsigned sum, cnt, mine, sp = 0u;
    for (;;) {
        sum = 0u; cnt = 0u; mine = 0u;
#pragma unroll 1
        for (unsigned j = 0; j < 16; ++j) { const unsigned cj = xb_ld(&bar[XB_XCNT(j)]); sum += cj; cnt += (cj > 0u) ? 1u : 0u; mine = (j == x) ? cj : mine; }
        if (sum == G) break;
        __builtin_amdgcn_s_sleep(1);
        if ((++sp & 255u) == 0u) { if (xb_ld(&bar[XB_TMO])) break; if (sp > XB_SPIN_CAP) { atomicAdd(&bar[XB_TMO], 1u); break; } }
    }
    nloc = mine > 0u ? mine : 1u; nx = cnt > 0u ? cnt : 1u;
}
DI void xcd_barrier(unsigned* bar, volatile LAS unsigned* st, const int wid) {
    asm volatile("" : "+s"(bar));
    asm volatile("s_waitcnt vmcnt(0)" ::: "memory");
    __syncthreads();
    if (wid == 0 && lane_fresh() == 0) {
        const unsigned x = xb_xcc_id();
        __builtin_amdgcn_s_waitcnt(0);
        const unsigned nloc = st[0], nx = st[1];
        const unsigned old = xb_add(&bar[XB_XSUB(x)], 1u);
        const unsigned gen = old / nloc;
        if (old + 1u == (gen + 1u) * nloc) {
            __builtin_amdgcn_fence(__ATOMIC_RELEASE, "agent");
            asm volatile("s_waitcnt vmcnt(0)" ::: "memory");
            const unsigned og = xb_add(&bar[XB_TOP], 1u);
            const unsigned tg = og / nx;
            if (og + 1u == (tg + 1u) * nx) xb_add(&bar[XB_TOPGEN], 1u);
            else XB_SPIN(xb_ld(&bar[XB_TOPGEN]) == tg, bar);
            __builtin_amdgcn_fence(__ATOMIC_ACQUIRE, "agent");
            xb_add(&bar[XB_XGEN(x)], 1u);
            asm volatile("s_waitcnt vmcnt(0)" ::: "memory");
        } else {
            XB_SPIN(xb_ld(&bar[XB_XGEN(x)]) == gen, bar);
            __builtin_amdgcn_fence(__ATOMIC_ACQUIRE, "agent");
            asm volatile("s_waitcnt vmcnt(0)" ::: "memory");
        }
    }
    __syncthreads();
}

__global__ void __launch_bounds__(512) mega(Params P) {
    extern __shared__ __attribute__((aligned(16))) unsigned char shm[];
    LAS unsigned char* lds = (LAS unsigned char*)shm;
    cg::grid_group grid = cg::this_grid();
    const int wid = __builtin_amdgcn_readfirstlane(threadIdx.x >> 6);
    const int G = gridDim.x, c = blockIdx.x;
    const int gthreads = G * 512;
#define LANE lane_fresh()
#define TID (wid * 64 + lane_fresh())
#define GTID (c * 512 + wid * 64 + lane_fresh())
    unsigned char* ws = P.ws;
    float* ssb = (float*)(ws + WS_MISC + 65536);
    bf16_t* hbA = (bf16_t*)(ws + WS_HBA);
    bf16_t* Ucat = (bf16_t*)(ws + WS_UCAT);
    bf16_t* SG = (bf16_t*)(ws + WS_SGGA); bf16_t* GA = SG + (size_t)T * 512; bf16_t* hbB = SG;
    bf16_t* Qb = (bf16_t*)(ws + WS_QK); bf16_t* Kb = Qb + (size_t)T * 512; bf16_t* pp = Qb;
    bf16_t* VT = (bf16_t*)(ws + WS_VT); bf16_t* zb = (bf16_t*)(ws + WS_ZB);
    bf16_t* cat = (bf16_t*)(ws + WS_CAT);
    float* Sbuf = (float*)(ws + WS_SBUF);
    bf16_t* pb = (bf16_t*)(ws + WS_PB);

    unsigned* bar = (unsigned*)(ws + WS_MISC + 786432);
    volatile LAS unsigned* xst = (volatile LAS unsigned*)(lds + STAGE_BYTES);
#define GSYNC() xcd_barrier(bar, xst, wid)
    if (wid == 0 && LANE == 0) { xst[0] = 0u; xst[1] = 0u; (void)xb_add(&bar[XB_XCNT(xb_xcc_id())], 1u); }
    if (P.ws == nullptr) grid.sync();
    for (int rep = 0; rep < REP_P0; ++rep) {
    const int role = (c >> 3) & 1, sc = ((c >> 4) << 3) | (c & 7), SG_ = G >> 1;
    const int sthreads = SG_ * 512;
    if (role == 0) ssm_prep(P, sc >> 1, sc & 1, lds, TID);
    { const int lane = LANE; LAS float* scr = (LAS float*)lds + wid * (64 * 33); const int l = role == 0 ? 1 : 0;
    for (int i = sc * 512 + TID; i < 3 * T; i += SG_ * 512) if (role == 1) ssb[T + i] = 0.f;
    {
        transpose_w<5>(P.w_in + (size_t)l * 1024 * 3072, 1024, 3072, (bf16_t*)(ws + WS_WIN) + (size_t)l * 3072 * 1024, P.mix_g + l * 1024, scr, sc * 8 + wid, SG_ * 8, lane);
        transpose_w<4>(P.w_glu + (size_t)l * 512 * 1024, 512, 1024, (bf16_t*)(ws + WS_WGLU) + (size_t)l * 1024 * 512, nullptr, scr, sc * 8 + wid, SG_ * 8, lane);
        transpose_w<3>(P.w_out + (size_t)l * 1024 * 1024, 1024, 1024, (bf16_t*)(ws + WS_WOUT) + (size_t)l * 1024 * 1024, nullptr, scr, sc * 8 + wid, SG_ * 8, lane);
        transpose_w<3>(P.w_pg + (size_t)l * 1024 * 1024, 1024, 1024, (bf16_t*)(ws + WS_WPG) + (size_t)l * 1024 * 1024, P.ple_g + l * 1024, scr, sc * 8 + wid, SG_ * 8, lane);
        transpose_w<3>(P.w_pp + (size_t)l * 256 * 1024, 256, 1024, (bf16_t*)(ws + WS_WPP) + (size_t)l * 1024 * 256, nullptr, scr, sc * 8 + wid, SG_ * 8, lane);
    } }
    if (role == 1)
    for (int row = (sc * 8 + wid) * 2; row < T; row += SG_ * 16) {
        const int lane = LANE;
        const f32x4* xr = (const f32x4*)(P.x + (size_t)row * 1024); f32x4 v[2][4];
#pragma unroll
        for (int r2 = 0; r2 < 2; ++r2)
#pragma unroll
            for (int j = 0; j < 4; ++j) v[r2][j] = xr[r2 * 256 + lane + 64 * j];
#pragma unroll
        for (int r2 = 0; r2 < 2; ++r2) { float s = 0.f;
#pragma unroll
            for (int j = 0; j < 4; ++j) { const f32x4 q = v[r2][j]; s += (q[0] * q[0] + q[1] * q[1]) + (q[2] * q[2] + q[3] * q[3]);
                u32x2 w; w.x = cvt_pk_bf16(q[0], q[1]); w.y = cvt_pk_bf16(q[2], q[3]); *(u32x2*)(hbA + (size_t)(row + r2) * 1024 + (lane + 64 * j) * 4) = w; }
#pragma unroll
            for (int o = 1; o < 64; o <<= 1) s += __shfl_xor(s, o);
            if (lane == 0) ssb[row + r2] = s; }
    }
    { const size_t pbase = (size_t)(role == 0 ? 1 : 0) * T * 256 / 8, pend = pbase + (size_t)T * 256 / 8;
    for (size_t i = pbase + sc * 512 + TID; i < pend; i += (size_t)4 * sthreads) {
        f32x4 a[4], b[4];
#pragma unroll
        for (int q = 0; q < 4; ++q) { const size_t ii = i + (size_t)q * sthreads; if (ii < pend) { a[q] = ((const f32x4*)P.p)[2 * ii]; b[q] = ((const f32x4*)P.p)[2 * ii + 1]; } }
#pragma unroll
        for (int q = 0; q < 4; ++q) { const size_t ii = i + (size_t)q * sthreads; if (ii < pend) {
            u32x4 o; o.x = cvt_pk_bf16(a[q][0], a[q][1]); o.y = cvt_pk_bf16(a[q][2], a[q][3]); o.z = cvt_pk_bf16(b[q][0], b[q][1]); o.w = cvt_pk_bf16(b[q][2], b[q][3]);
            ((u32x4*)pb)[ii] = o; } }
    }
    }
    }
    if (wid == 0 && LANE == 0) { unsigned nloc, nx; xcd_barrier_complete(bar, xb_xcc_id(), G, nloc, nx); xst[0] = nloc; xst[1] = nx; }
    GSYNC();

    auto layer = [&](const int l) __attribute__((always_inline)) {
        float* ssIn = ssb + (size_t)(2 * l) * T; float* ssMid = ssb + (size_t)(2 * l + 1) * T; float* ssNext = ssb + (size_t)(2 * l + 2 > 3 ? 3 : 2 * l + 2) * T;
        { Gemm g{hbA, (const bf16_t*)(ws + WS_WIN) + (size_t)l * 3072 * 1024, 1024, 1024, 1024, 0, 0};
          Order S; S.init(T / 256, 12, 1, G, c);
          EpiIn E{ssIn, Ucat, SG, GA, Qb, Kb, VT, P.q_g + l * 64, P.k_g + l * 64};
          for (int rep = 0; rep < REP_INPROJ; ++rep) gemm_phase(lds, g, S, E, wid); }
        GSYNC();
        { Gemm g{Ucat, (const bf16_t*)(ws + WS_W1) + (size_t)l * 32 * 256 * 512, 640, 512, 512, (size_t)1024 * 640, (size_t)256 * 512};
          Order S; S.init(4, 1, 32, G, c);
          EpiS E{Sbuf};
          for (int rep = 0; rep < REP_GEMMS; ++rep) gemm_phase(lds, g, S, E, wid); }
        if (c < 128) {
            asm volatile("s_waitcnt vmcnt(0)" ::: "memory"); __syncthreads();
            const int lane = LANE, seg = lane >> 4, pl = lane & 15;
            const int q_ = c >> 3, L_ = ((c & 7) * 4 + (q_ >> 2)) * 4 + (q_ & 3);
            const int pq = wid & 3, g = L_ >> 2, b = 2 * (L_ & 3) + (wid >> 2), p = pq * 16 + pl;
            const float* a32 = (const float*)(ws + WS_MISC) + (size_t)((l * 32 + g) * 64 + p) * 2; const float ar = a32[0], ai = a32[1];
            const size_t row0 = (size_t)g * 1024 + b * 128 + seg * 32;
            const float* __restrict__ Sp = Sbuf + row0 * 128 + p;
            float sr[32], si[32];
#pragma unroll
            for (int j = 0; j < 32; ++j) { sr[j] = Sp[(size_t)j * 128]; si[j] = Sp[(size_t)j * 128 + 64]; }
            float hr = 0.f, hi = 0.f, wr_ = 1.f, wi_ = 0.f;
#pragma unroll
            for (int j = 0; j < 32; ++j) { const float nr = ar * hr - ai * hi + sr[j], ni = ar * hi + ai * hr + si[j]; hr = nr; hi = ni;
                const float xr = ar * wr_ - ai * wi_, xi = ar * wi_ + ai * wr_; wr_ = xr; wi_ = xi; }
            const float e0r = __shfl(hr, pl), e0i = __shfl(hi, pl), e1r = __shfl(hr, pl + 16), e1i = __shfl(hi, pl + 16), e2r = __shfl(hr, pl + 32), e2i = __shfl(hi, pl + 32);
            const float h1r = e0r, h1i = e0i;
            const float h2r = wr_ * h1r - wi_ * h1i + e1r, h2i = wr_ * h1i + wi_ * h1r + e1i;
            const float h3r = wr_ * h2r - wi_ * h2i + e2r, h3i = wr_ * h2i + wi_ * h2r + e2i;
            const float cinr = seg == 0 ? 0.f : seg == 1 ? h1r : seg == 2 ? h2r : h3r, cini = seg == 0 ? 0.f : seg == 1 ? h1i : seg == 2 ? h2i : h3i;
            bf16_t* __restrict__ Up = Ucat + row0 * 640 + 512 + p;
            hr = 0.f; hi = 0.f; float cr_ = cinr, ci_ = cini;
#pragma unroll
            for (int j = 0; j < 32; ++j) {
                const unsigned pk = cvt_pk_bf16(hr + cr_, hi + ci_);
                Up[(size_t)j * 640] = (bf16_t)(pk & 0xffffu); Up[(size_t)j * 640 + 64] = (bf16_t)(pk >> 16);
                const float nr = ar * hr - ai * hi + sr[j], ni = ar * hi + ai * hr + si[j]; hr = nr; hi = ni;
                const float xr = ar * cr_ - ai * ci_, xi = ar * ci_ + ai * cr_; cr_ = xr; ci_ = xi; }
            asm volatile("s_waitcnt vmcnt(0)" ::: "memory"); __syncthreads();
            { Gemm gy{Ucat, (const bf16_t*)(ws + WS_TOEP) + (size_t)l * 32 * 512 * 640, 640, 640, 640, (size_t)1024 * 640, (size_t)512 * 640};
              Order SY; SY.nwg = -1; SY.nM = g; SY.nN = L_ & 3; SY.lim = 2; SY.total = 0; SY.G = 0; SY.c = 0;
              EpiY EY{Ucat, P.dsk + l * 512, zb};
              for (int rep = 0; rep < REP_Y; ++rep) gemm_phase(lds, gy, SY, EY, wid); }
        }
        for (int rep = 0; rep < REP_ATTN; ++rep)
        {
            const int nit = c < 128 ? 1 : 7, base = c < 128 ? (c * 8 + wid) : 1024 + (c - 128) * 56 + wid;
            for (int j = 0; j < nit; ++j) attn_item(base + 8 * j, Qb, Kb, VT, GA, cat, LANE); }
        GSYNC();
        { Gemm g{zb, (const bf16_t*)(ws + WS_WGLU) + (size_t)l * 1024 * 512, 512, 512, 512, 0, 0};
          Order S; S.init(T / 256, 4, 1, G, c);
          EpiGlu E{P.b_glu + l * 1024, SG, cat};
          for (int rep = 0; rep < REP_GLU; ++rep) gemm_phase(lds, g, S, E, wid); }
        { Gemm g{pb + (size_t)l * T * 256, (const bf16_t*)(ws + WS_WPP) + (size_t)l * 1024 * 256, 256, 256, 256, 0, 0};
          Order S; S.init(T / 256, 4, 1, G, c);
          EpiPP E{pp};
          for (int rep = 0; rep < REP_PP; ++rep) gemm_phase(lds, g, S, E, wid); }
        GSYNC();
        { Gemm g{cat, (const bf16_t*)(ws + WS_WOUT) + (size_t)l * 1024 * 1024, 1024, 1024, 1024, 0, 0};
          Order S; S.init(T / 256, 4, 1, G, c);
          EpiOut E{hbA, hbB, ssMid};
          gemm_phase(lds, g, S, E, wid); }
        GSYNC();
        { Gemm g{hbB, (const bf16_t*)(ws + WS_WPG) + (size_t)l * 1024 * 1024, 1024, 1024, 1024, 0, 0};
          Order S; S.init(T / 256, 4, 1, G, c);
          EpiPle E{ssMid, hbB, P.out, pp, hbA, ssNext, l == 1 ? 1 : 0};
          gemm_phase(lds, g, S, E, wid); }
        if (l == 0) GSYNC();
    };
    layer(0); layer(1);
}

extern "C" void kernel_launch(void* const* d_in, const int* in_sizes, int n_in, void* d_out, int out_size, void* d_ws, size_t ws_size, hipStream_t stream) {
    static int grid = 0;
    if (grid == 0) {
        if (n_in != 20 || ws_size < WS_END) { fprintf(stderr, "kernel_launch: unexpected inputs (n_in %d, ws %zu < %zu)\n", n_in, ws_size, (size_t)WS_END); grid = -1; return; }
        int dev = 0, cus = 0, per_cu = 0;
        hipGetDevice(&dev); hipDeviceGetAttribute(&cus, hipDeviceAttributeMultiprocessorCount, dev);
        if (hipFuncSetAttribute((const void*)mega, hipFuncAttributeMaxDynamicSharedMemorySize, LDS_BYTES) != hipSuccess) { fprintf(stderr, "hipFuncSetAttribute failed\n"); grid = -1; return; }
        if (hipOccupancyMaxActiveBlocksPerMultiprocessor(&per_cu, (const void*)mega, 512, LDS_BYTES) != hipSuccess || per_cu < 1) { fprintf(stderr, "occupancy query: %d\n", per_cu); per_cu = 1; }
        (void)hipGetLastError();
        if (cus < 256) { fprintf(stderr, "kernel_launch: built for a 256-CU device (static work partition over 256 workgroups), found %d CUs; nothing launched\n", cus); grid = -1; return; }
        grid = 256;
    }
    if (grid < 0) return;
    if (hipMemsetAsync((char*)d_ws + WS_MISC + 786432, 0, XCD_BAR_WORDS * 4, stream) != hipSuccess) { fprintf(stderr, "kernel_launch: hipMemsetAsync failed\n"); return; }
    Params P{};
    const float** pp = (const float**)&P;
    for (int i = 0; i < 20; ++i) pp[i] = (const float*)d_in[i];
    P.out = (float*)d_out; P.ws = (unsigned char*)d_ws;
    void* args[] = {&P};
    hipError_t e = hipLaunchCooperativeKernel((const void*)mega, dim3(grid), dim3(512), args, LDS_BYTES, stream);
    if (e != hipSuccess) fprintf(stderr, "cooperative launch failed: %s (grid %d)\n", hipGetErrorString(e), grid);
}
```

```cpp
#ifndef REP_P0
#define REP_P0 1
#define REP_INPROJ 1
#define REP_ATTN 1
#define REP_SCAN 1
#define REP_SYNC 1
#define REP_GEMMS 1
#define REP_PP 1
#define REP_Y 1
#define REP_GLU 1
#endif
#include <hip/hip_runtime.h>
#include <hip/hip_cooperative_groups.h>
#include <cstdio>
namespace cg = cooperative_groups;

#define LAS __attribute__((address_space(3)))
#define DI __device__ __forceinline__
typedef unsigned short bf16_t;
typedef short bf16x8 __attribute__((ext_vector_type(8)));
typedef float f32x4 __attribute__((ext_vector_type(4)));
typedef float f32x16 __attribute__((ext_vector_type(16)));
typedef unsigned u32x4 __attribute__((ext_vector_type(4)));
typedef unsigned u32x2 __attribute__((ext_vector_type(2)));

constexpr int T = 32768, SEQ = 4096;
constexpr int BM = 256, BK = 64, HALF = 128, HTB = HALF * BK * 2, STAGE_BYTES = 8 * HTB, NXCD = 8, WGM = 2;
constexpr int LDS_DUMMY = STAGE_BYTES + 16;
constexpr int LDS_BYTES = STAGE_BYTES + 16 + 2048;

constexpr size_t MBy = 1u << 20;
constexpr size_t WS_WIN = 0;
constexpr size_t WS_WGLU = WS_WIN + 12 * MBy;
constexpr size_t WS_WOUT = WS_WGLU + 2 * MBy;
constexpr size_t WS_WPG = WS_WOUT + 4 * MBy;
constexpr size_t WS_WPP = WS_WPG + 4 * MBy;
constexpr size_t WS_W1 = WS_WPP + 1 * MBy;
constexpr size_t WS_TOEP = WS_W1 + 16 * MBy;
constexpr size_t WS_MISC = WS_TOEP + 40 * MBy;
constexpr size_t WS_HBA = WS_MISC + 1 * MBy;
constexpr size_t WS_UCAT = WS_HBA + 64 * MBy;
constexpr size_t WS_SGGA = WS_UCAT + 40 * MBy;
constexpr size_t WS_QK = WS_SGGA + 64 * MBy;
constexpr size_t WS_VT = WS_QK + 64 * MBy;
constexpr size_t WS_CAT = WS_VT + 32 * MBy;
constexpr size_t WS_SBUF = WS_CAT + 64 * MBy;
constexpr size_t WS_PB = WS_SBUF + 16 * MBy;
constexpr size_t WS_ZB = WS_PB + 32 * MBy;
constexpr size_t WS_END = WS_ZB + 32 * MBy;

struct Params {
    const float *x, *p, *mix_g, *w_in, *a_re, *a_im, *log_dt, *b_re, *b_im, *c_re, *c_im, *dsk, *w_glu, *b_glu, *q_g, *k_g, *w_out, *ple_g, *w_pg, *w_pp;
    float* out; unsigned char* ws;
};

DI int lane_fresh() { int l; asm volatile("v_mbcnt_lo_u32_b32 %0, -1, 0\n\tv_mbcnt_hi_u32_b32 %0, -1, %0" : "=v"(l)); return l; }
DI unsigned cvt_pk_bf16(float lo, float hi) { unsigned r; asm volatile("v_cvt_pk_bf16_f32 %0, %1, %2" : "=v"(r) : "v"(lo), "v"(hi)); return r; }
DI float bf_lo(unsigned w) { return __uint_as_float(w << 16); }
DI float bf_hi(unsigned w) { return __uint_as_float(w & 0xffff0000u); }
DI float fsigmoid(float x) { return __builtin_amdgcn_rcpf(1.0f + __expf(-x)); }
DI float fsilu(float x) { return x * fsigmoid(x); }
DI float fgelu_tanh(float y) { const float u2 = 1.5957691216057308f * (y + 0.044715f * y * y * y); return y * fsigmoid(u2); }

DI int lds_byte(int r, int c) { const int st = (r >> 4) * 2 + (c >> 5), rr = r & 15, cc = c & 31, ob = rr * 64 + cc * 2; return st * 1024 + (ob ^ (((ob >> 9) & 1) << 5)); }
DI void stage_rc(int b, int& R, int& C) { const int st = b / 1024, sb = b % 1024, swz = sb ^ (((sb >> 9) & 1) << 5); R = (st >> 1) * 16 + swz / 64; C = (st & 1) * 32 + (swz % 64) / 2; }

struct Unit { int pm, pn, g; };
struct Gemm { const bf16_t* A; const bf16_t* Bt; int lda, ldb, K; size_t gsA, gsB; };
struct Order {
    int nM, nN, nwg, total, G, c, lim;
    DI void init(int nM_, int nN_, int nG, int G_, int c_) { nM = nM_; nN = nN_; nwg = nM * nN; total = nwg * nG; lim = total; G = G_; c = c_; asm volatile("" : "+s"(c)); }
    DI bool next(int i, Unit& u) const {
        if (nwg < 0) { if (i >= lim) return false; u.g = nM; u.pm = nN; u.pn = i; return true; }
        int L = i * G + c; if (L >= lim) return false;
        if (total > nwg) {
            const int gpx = (total / nwg) >> 3, q = (c >> 3) + (G >> 3) * i; if (q >= gpx * nwg) return false;
            L = ((c & 7) * gpx + q / nwg) * nwg + q % nwg; }
        u.g = L / nwg; int wgid = L - u.g * nwg;
        { const int q = nwg / NXCD, r = nwg % NXCD, xcd = wgid % NXCD, off = wgid / NXCD; wgid = (xcd < r ? xcd * (q + 1) : r * (q + 1) + (xcd - r) * q) + off; }
        const int nig = WGM * nN, gid = wgid / nig, fm = gid * WGM, gsz = (nM - fm) < WGM ? (nM - fm) : WGM;
        u.pm = fm + ((wgid % nig) % gsz); u.pn = (wgid % nig) / gsz; return true;
    }
};

template <class Epi>
DI void gemm_phase(LAS unsigned char* lds, const Gemm g, const Order& S, const Epi& E, const int wid) {
    const int lane = lane_fresh(), tid = wid * 64 + lane, wr = wid >> 2, wc = wid & 3, fr = lane & 15, fq = lane >> 4;
    const int K = g.K, nt = K / BK;
    unsigned voffA[2], voffB[2];
#pragma unroll
    for (int i = 0; i < 2; ++i) { int R, C; stage_rc(tid * 16 + i * 8192, R, C); voffA[i] = (unsigned)(R * g.lda + C) * 2u; voffB[i] = (unsigned)(R * g.ldb + C) * 2u; }
    const size_t kstep = (size_t)(BK * 2);
    const size_t hstepA = (size_t)HALF * g.lda * 2, hstepB = (size_t)HALF * g.ldb * 2;
    const size_t tstepA = 2 * hstepA, tstepB = 2 * hstepB;
    const unsigned ldsw = (unsigned)wid * 1024u;
    const int aoff = lds_byte(wr * 64 + fr, fq * 8), boff = lds_byte(wc * 32 + fr, fq * 8);
#define PG8_SA(b, h) (((b) * 2 + (h)) * HTB)
#define PG8_SB(b, h) ((4 + (b) * 2 + (h)) * HTB)
#define PG8_STAGE(bufoff, gbase, voff) do { _Pragma("unroll") for (int _i = 0; _i < 2; ++_i) \
        __builtin_amdgcn_global_load_lds((const unsigned*)((const char*)(gbase) + (voff)[_i]), (LAS unsigned*)(lds + (bufoff) + ldsw + _i * 8192), 16, 0, 0); } while (0)
#define PG8_LDA(dst, b, h) do { _Pragma("unroll") for (int m = 0; m < 4; ++m) _Pragma("unroll") for (int k = 0; k < 2; ++k) dst[m][k] = *(const LAS bf16x8*)(lds + PG8_SA(b, h) + aoff + m * 2048 + k * 1024); } while (0)
#define PG8_LDB(dst, b, h) do { _Pragma("unroll") for (int n = 0; n < 2; ++n) _Pragma("unroll") for (int k = 0; k < 2; ++k) dst[n][k] = *(const LAS bf16x8*)(lds + PG8_SB(b, h) + boff + n * 2048 + k * 1024); } while (0)
#define PG8_MMA(ai, bj, At, Bt) do { __builtin_amdgcn_s_setprio(1); _Pragma("unroll") for (int m = 0; m < 4; ++m) _Pragma("unroll") for (int n = 0; n < 2; ++n) _Pragma("unroll") for (int k = 0; k < 2; ++k) \
        acc[ai][bj][m][n] = __builtin_amdgcn_mfma_f32_16x16x32_bf16(Bt[n][k], At[m][k], acc[ai][bj][m][n], 0, 0, 0); __builtin_amdgcn_s_setprio(0); } while (0)
#define PG8_WAIT_V(n) asm volatile("s_waitcnt vmcnt(" #n ")" ::: "memory")
#define PG8_WAIT_L(n) asm volatile("s_waitcnt lgkmcnt(" #n ")" ::: "memory")
#define PG8_BAR __builtin_amdgcn_s_barrier()
#define PG8_SCHED __builtin_amdgcn_sched_barrier(0)
    Unit cur, nxt; int ui = 0;
    if (!S.next(0, cur)) return;
    f32x4 acc[2][2][4][2];
#pragma unroll
    for (int a = 0; a < 2; ++a)
#pragma unroll
        for (int b = 0; b < 2; ++b)
#pragma unroll
            for (int m = 0; m < 4; ++m)
#pragma unroll
                for (int n = 0; n < 2; ++n) acc[a][b][m][n] = (f32x4){0.f, 0.f, 0.f, 0.f};
    bf16x8 At[4][2], B0[2][2], B1[2][2];
    const char* cA = (const char*)(g.A + (size_t)cur.g * g.gsA) + (size_t)cur.pm * tstepA;
    const char* cB = (const char*)(g.Bt + (size_t)cur.g * g.gsB) + (size_t)cur.pn * tstepB;
    PG8_STAGE(PG8_SB(0, 0), cB, voffB); PG8_STAGE(PG8_SB(0, 1), cB + hstepB, voffB); PG8_STAGE(PG8_SA(0, 0), cA, voffA); PG8_STAGE(PG8_SA(0, 1), cA + hstepA, voffA);
    if (wr == 1) PG8_BAR;
    PG8_WAIT_V(2); PG8_BAR;
    PG8_STAGE(PG8_SB(1, 0), cB + kstep, voffB); PG8_STAGE(PG8_SA(1, 0), cA + kstep, voffA); PG8_STAGE(PG8_SB(1, 1), cB + hstepB + kstep, voffB);
    PG8_WAIT_V(6); PG8_BAR;
    for (;;) {
        const bool has_next = S.next(ui + 1, nxt);
        const char* nA = has_next ? (const char*)(g.A + (size_t)nxt.g * g.gsA) + (size_t)nxt.pm * tstepA : cA;
        const char* nB = has_next ? (const char*)(g.Bt + (size_t)nxt.g * g.gsB) + (size_t)nxt.pn * tstepB : cB;
        for (int t = 0; t < nt; t += 2) {
            const bool last = (t == nt - 2);
            const char* a1 = cA + (size_t)(t + 1) * kstep;
            const char* a2 = last ? nA : cA + (size_t)(t + 2) * kstep; const char* b2 = last ? nB : cB + (size_t)(t + 2) * kstep;
            const char* a3 = a2 + kstep; const char* b3 = b2 + kstep;
            if (t == nt - 2) E.prefetch(cur, lds, wid);
            PG8_LDB(B0, 0, 0); PG8_LDB(B1, 0, 1); PG8_SCHED; PG8_LDA(At, 0, 0); PG8_STAGE(PG8_SA(1, 1), a1 + hstepA, voffA);
            PG8_WAIT_V(8); PG8_WAIT_L(0); PG8_BAR; PG8_MMA(0, 0, At, B0); PG8_MMA(0, 1, At, B1); PG8_BAR; PG8_SCHED;
            PG8_LDA(At, 0, 1); PG8_STAGE(PG8_SB(0, 0), b2, voffB); PG8_STAGE(PG8_SB(0, 1), b2 + hstepB, voffB); PG8_STAGE(PG8_SA(0, 0), a2, voffA);
            PG8_WAIT_V(8); PG8_WAIT_L(0); PG8_BAR; PG8_MMA(1, 0, At, B0); PG8_MMA(1, 1, At, B1); PG8_BAR; PG8_SCHED;
            PG8_LDB(B0, 1, 0); PG8_LDB(B1, 1, 1); PG8_SCHED; PG8_LDA(At, 1, 0); PG8_STAGE(PG8_SA(0, 1), a2 + hstepA, voffA);
            PG8_WAIT_V(8); PG8_WAIT_L(0); PG8_BAR; PG8_MMA(0, 0, At, B0); PG8_MMA(0, 1, At, B1); PG8_BAR; PG8_SCHED;
            PG8_LDA(At, 1, 1); PG8_STAGE(PG8_SB(1, 0), b3, voffB); PG8_STAGE(PG8_SB(1, 1), b3 + hstepB, voffB); PG8_STAGE(PG8_SA(1, 0), a3, voffA);
            PG8_WAIT_V(8); PG8_WAIT_L(0); PG8_BAR; PG8_MMA(1, 0, At, B0); PG8_MMA(1, 1, At, B1); PG8_BAR; PG8_SCHED;
        }
        if (wr == 0) PG8_BAR;
        { const int le = lane_fresh(); E(acc, cur, wr, wc, le & 15, le >> 4); }
        if (!has_next) break;
#pragma unroll
        for (int a = 0; a < 2; ++a)
#pragma unroll
            for (int b = 0; b < 2; ++b)
#pragma unroll
                for (int m = 0; m < 4; ++m)
#pragma unroll
                    for (int n = 0; n < 2; ++n) acc[a][b][m][n] = (f32x4){0.f, 0.f, 0.f, 0.f};
        cur = nxt; cA = nA; cB = nB; ++ui;
        if (wr == 1) PG8_BAR;
    }
    PG8_WAIT_V(0);
    PG8_BAR;
#undef PG8_SA
#undef PG8_SB
#undef PG8_STAGE
#undef PG8_LDA
#undef PG8_LDB
#undef PG8_MMA
#undef PG8_WAIT_V
#undef PG8_WAIT_L
#undef PG8_BAR
#undef PG8_SCHED
}

#define EPI_ROWS _Pragma("unroll") for (int ai = 0; ai < 2; ++ai) _Pragma("unroll") for (int m = 0; m < 4; ++m) if ((__extension__({ if (m == 0) asm volatile("" ::: "memory"); 1; })))
#define EPI_ROWS_NF _Pragma("unroll") for (int ai = 0; ai < 2; ++ai) _Pragma("unroll") for (int m = 0; m < 4; ++m)
#define EPI_COLS _Pragma("unroll") for (int bj = 0; bj < 2; ++bj) _Pragma("unroll") for (int n = 0; n < 2; ++n)

struct EpiIn {
    DI void prefetch(const Unit& u, LAS unsigned char* lds, int wid) const {
        if (wid < 4) __builtin_amdgcn_global_load_lds((const unsigned*)(ss + u.pm * BM + wid * 64 + lane_fresh()), (LAS unsigned*)(lds + LDS_DUMMY + wid * 256), 4, 0, 0);
    }
    const float* ss; bf16_t *Ucat, *SG, *GA, *Q, *Kb, *VT; const float *qg, *kg;
    DI void operator()(const f32x4 (&acc)[2][2][4][2], const Unit& u, int wr, int wc, int fr, int fq) const {
        const int type = u.pn >> 1, hf = u.pn & 1;
        float rsv[2][4];
        EPI_ROWS_NF rsv[ai][m] = ss[u.pm * BM + ai * HALF + wr * 64 + m * 16 + fr];
        EPI_ROWS_NF rsv[ai][m] = rsqrtf(rsv[ai][m] * (1.f / 1024.f) + 1e-6f);
#define EPI_BJ _Pragma("unroll") for (int bj = 0; bj < 2; ++bj)
#define PACK8(w, a0, a1) do { w.x = cvt_pk_bf16(a0[0], a0[1]); w.y = cvt_pk_bf16(a0[2], a0[3]); w.z = cvt_pk_bf16(a1[0], a1[1]); w.w = cvt_pk_bf16(a1[2], a1[3]); } while (0)
        if (type == 0) {
            EPI_ROWS_NF { const int row = u.pm * BM + ai * HALF + wr * 64 + m * 16 + fr; const float rs = rsv[ai][m];
                EPI_BJ { const f32x4 v0 = acc[ai][bj][m][0] * rs, v1 = acc[ai][bj][m][1] * rs; const int g = 16 * hf + 4 * wc + 2 * bj + (fq >> 1);
                    u32x4 w; PACK8(w, v0, v1);
                    *(u32x4*)(Ucat + ((size_t)(g * 1024 + (row >> 5)) * 640 + (row & 31) * 16 + 8 * (fq & 1))) = w; } }
        } else if (type == 1 || type == 5) {
            bf16_t* dst = type == 1 ? SG : GA;
            EPI_ROWS_NF { const int row = u.pm * BM + ai * HALF + wr * 64 + m * 16 + fr; const float rs = rsv[ai][m];
                EPI_BJ { f32x4 v0 = acc[ai][bj][m][0] * rs, v1 = acc[ai][bj][m][1] * rs; const int cs = 256 * hf + 64 * wc + 32 * bj + 8 * fq;
#pragma unroll
                    for (int j = 0; j < 4; ++j) { v0[j] = fsilu(v0[j]); v1[j] = fsilu(v1[j]); }
                    u32x4 w; PACK8(w, v0, v1);
                    *(u32x4*)(dst + (size_t)row * 512 + cs) = w; } }
        } else if (type == 2 || type == 3) {
            bf16_t* dst = type == 2 ? Q : Kb; const float* gam = type == 2 ? qg : kg; const float sc = type == 2 ? 0.125f : 1.0f;
            f32x4 gv[2][2];
            EPI_COLS gv[bj][n] = *(const f32x4*)(gam + 32 * bj + 8 * fq + 4 * n) * sc;
            EPI_ROWS_NF { const int row = u.pm * BM + ai * HALF + wr * 64 + m * 16 + fr; const float rs = rsv[ai][m];
                f32x4 v[2][2]; float s = 0.f;
                EPI_COLS { v[bj][n] = acc[ai][bj][m][n] * rs; s += (v[bj][n][0] * v[bj][n][0] + v[bj][n][1] * v[bj][n][1]) + (v[bj][n][2] * v[bj][n][2] + v[bj][n][3] * v[bj][n][3]); }
                s += __shfl_xor(s, 16); s += __shfl_xor(s, 32);
                const float ri = rsqrtf(s * (1.f / 64.f) + 1e-6f);
                EPI_BJ { const f32x4 o0 = v[bj][0] * ri * gv[bj][0], o1 = v[bj][1] * ri * gv[bj][1]; const int cs = 256 * hf + 64 * wc + 32 * bj + 8 * fq;
                    u32x4 w; PACK8(w, o0, o1);
                    if (type == 2) *(u32x4*)(dst + (size_t)row * 512 + cs) = w;
                    else {
                        const int key = row & 4095;
                        *(u32x4*)(dst + (((size_t)((row >> 12) * 8 + 4 * hf + wc)) << 18) + (key >> 5) * 2048 + (2 * bj + (fq >> 1)) * 512 + (key & 31) * 16 + 8 * (fq & 1)) = w; } } }
        } else {
            EPI_ROWS_NF { const int row = u.pm * BM + ai * HALF + wr * 64 + m * 16 + fr; const float rs = rsv[ai][m];
                const int b = row >> 12, s = row & 4095, head = 4 * hf + wc;
                EPI_COLS { const f32x4 v = acc[ai][bj][m][n] * rs;
                    const unsigned w0 = cvt_pk_bf16(v[0], v[1]), w1 = cvt_pk_bf16(v[2], v[3]);
                    bf16_t* o = VT + (((size_t)(b * 8 + head)) << 18) + (s >> 5) * 2048 + bj * 1024 + ((s >> 4) & 1) * 512 + (8 * fq + 4 * n) * 16 + (s & 15);
                    o[0] = (bf16_t)(w0 & 0xffffu); o[16] = (bf16_t)(w0 >> 16); o[32] = (bf16_t)(w1 & 0xffffu); o[48] = (bf16_t)(w1 >> 16); } }
        }
#undef EPI_BJ
#undef PACK8
    }
};
struct EpiS {
    DI void prefetch(const Unit&, LAS unsigned char*, int) const {}
    float* Sbuf;
    DI void operator()(const f32x4 (&acc)[2][2][4][2], const Unit& u, int wr, int wc, int fr, int fq) const {
        EPI_ROWS { const int R = u.pm * BM + ai * HALF + wr * 64 + m * 16 + fr;
#pragma unroll
            for (int n = 0; n < 2; ++n) *(f32x4*)(Sbuf + ((size_t)(u.g * 1024 + R) * 128 + 32 * wc + 16 * n + 4 * fq)) = acc[ai][0][m][n]; }
    }
};
struct EpiY {
    DI void prefetch(const Unit&, LAS unsigned char*, int) const {}
    const bf16_t* Ucat; const float* dsk; bf16_t* zb;
    DI void operator()(const f32x4 (&acc)[2][2][4][2], const Unit& u, int wr, int wc, int fr, int fq) const {
        const int h0 = 8 * (fq & 1);
        const f32x4 dv0 = *(const f32x4*)(dsk + u.g * 16 + h0), dv1 = *(const f32x4*)(dsk + u.g * 16 + h0 + 4);
        EPI_ROWS { const int R = u.pm * BM + ai * HALF + wr * 64 + m * 16 + fr;
#pragma unroll
            for (int bj = 0; bj < 2; ++bj) { const int ncol = u.pn * BM + bj * HALF + 32 * wc + 8 * fq;
                const u32x4 ub = *(const u32x4*)(Ucat + ((size_t)(u.g * 1024 + R) * 640 + ncol));
                f32x4 y0 = acc[ai][bj][m][0], y1 = acc[ai][bj][m][1];
                y0[0] += dv0[0] * bf_lo(ub.x); y0[1] += dv0[1] * bf_hi(ub.x); y0[2] += dv0[2] * bf_lo(ub.y); y0[3] += dv0[3] * bf_hi(ub.y);
                y1[0] += dv1[0] * bf_lo(ub.z); y1[1] += dv1[1] * bf_hi(ub.z); y1[2] += dv1[2] * bf_lo(ub.w); y1[3] += dv1[3] * bf_hi(ub.w);
                u32x4 w; w.x = cvt_pk_bf16(fgelu_tanh(y0[0]), fgelu_tanh(y0[1])); w.y = cvt_pk_bf16(fgelu_tanh(y0[2]), fgelu_tanh(y0[3]));
                w.z = cvt_pk_bf16(fgelu_tanh(y1[0]), fgelu_tanh(y1[1])); w.w = cvt_pk_bf16(fgelu_tanh(y1[2]), fgelu_tanh(y1[3]));
                const int token = R * 32 + (ncol >> 4);
                *(u32x4*)(zb + (size_t)token * 512 + u.g * 16 + h0) = w; } }
    }
};
struct EpiGlu {
    DI void prefetch(const Unit& u, LAS unsigned char* lds, int wid) const {
        const int id = wid * 64 + lane_fresh(), row = id >> 1, seg = id & 1;
        __builtin_amdgcn_global_load_lds((const unsigned*)(SG + (size_t)(u.pm * BM + row) * 512 + u.pn * 128 + seg * 64), (LAS unsigned*)(lds + LDS_DUMMY + wid * 256), 4, 0, 0);
    }
    const float* bglu; const bf16_t* SG; bf16_t* cat;
    DI void operator()(const f32x4 (&acc)[2][2][4][2], const Unit& u, int wr, int wc, int fr, int fq) const {
        const int ch = u.pn * 128 + 32 * wc + 8 * fq;
        f32x4 bv[2], bg[2];
#pragma unroll
        for (int n = 0; n < 2; ++n) { bv[n] = *(const f32x4*)(bglu + ch + 4 * n); bg[n] = *(const f32x4*)(bglu + 512 + ch + 4 * n); }
        EPI_ROWS { const int row = u.pm * BM + ai * HALF + wr * 64 + m * 16 + fr;
            const f32x4 v0 = acc[ai][0][m][0] + bv[0], g0 = acc[ai][1][m][0] + bg[0], v1 = acc[ai][0][m][1] + bv[1], g1 = acc[ai][1][m][1] + bg[1];
            const u32x4 sg = *(const u32x4*)(SG + (size_t)row * 512 + ch);
            u32x4 w;
            w.x = cvt_pk_bf16(v0[0] * fsigmoid(g0[0]) * bf_lo(sg.x), v0[1] * fsigmoid(g0[1]) * bf_hi(sg.x)); w.y = cvt_pk_bf16(v0[2] * fsigmoid(g0[2]) * bf_lo(sg.y), v0[3] * fsigmoid(g0[3]) * bf_hi(sg.y));
            w.z = cvt_pk_bf16(v1[0] * fsigmoid(g1[0]) * bf_lo(sg.z), v1[1] * fsigmoid(g1[1]) * bf_hi(sg.z)); w.w = cvt_pk_bf16(v1[2] * fsigmoid(g1[2]) * bf_lo(sg.w), v1[3] * fsigmoid(g1[3]) * bf_hi(sg.w));
            *(u32x4*)(cat + (size_t)row * 1024 + ch) = w; }
    }
};
struct EpiOut {
    DI void prefetch(const Unit& u, LAS unsigned char* lds, int wid) const {
        const int tid = wid * 64 + lane_fresh();
#pragma unroll
        for (int i = 0; i < 2; ++i) { const int id = tid + 512 * i, row = id >> 2, seg = id & 3;
            __builtin_amdgcn_global_load_lds((const unsigned*)(hin + (size_t)(u.pm * BM + row) * 1024 + u.pn * BM + seg * 64), (LAS unsigned*)(lds + LDS_DUMMY + wid * 256), 4, 0, 0); }
    }
    const bf16_t* hin; bf16_t* hb; float* ss;
    DI void operator()(const f32x4 (&acc)[2][2][4][2], const Unit& u, int wr, int wc, int fr, int fq) const {
        EPI_ROWS { const int row = u.pm * BM + ai * HALF + wr * 64 + m * 16 + fr; float s = 0.f;
#pragma unroll
            for (int bj = 0; bj < 2; ++bj) { const size_t off = (size_t)row * 1024 + u.pn * BM + bj * HALF + 32 * wc + 8 * fq;
                const u32x4 rw = *(const u32x4*)(hin + off); f32x4 h0 = acc[ai][bj][m][0], h1_ = acc[ai][bj][m][1];
                h0[0] += bf_lo(rw.x); h0[1] += bf_hi(rw.x); h0[2] += bf_lo(rw.y); h0[3] += bf_hi(rw.y); h1_[0] += bf_lo(rw.z); h1_[1] += bf_hi(rw.z); h1_[2] += bf_lo(rw.w); h1_[3] += bf_hi(rw.w);
                u32x4 w; w.x = cvt_pk_bf16(h0[0], h0[1]); w.y = cvt_pk_bf16(h0[2], h0[3]); w.z = cvt_pk_bf16(h1_[0], h1_[1]); w.w = cvt_pk_bf16(h1_[2], h1_[3]); *(u32x4*)(hb + off) = w;
                s += ((h0[0] * h0[0] + h0[1] * h0[1]) + (h0[2] * h0[2] + h0[3] * h0[3])) + ((h1_[0] * h1_[0] + h1_[1] * h1_[1]) + (h1_[2] * h1_[2] + h1_[3] * h1_[3])); }
            s += __shfl_xor(s, 16); s += __shfl_xor(s, 32);
            if (fq == 0) atomicAdd(ss + row, s); }
    }
};
struct EpiPle {
    DI void prefetch(const Unit& u, LAS unsigned char* lds, int wid) const {
        const int tid = wid * 64 + lane_fresh();
#pragma unroll
        for (int i = 0; i < 2; ++i) { const int id = tid + 512 * i, row = id >> 2, seg = id & 3; const size_t off = (size_t)(u.pm * BM + row) * 1024 + u.pn * BM + seg * 64;
            __builtin_amdgcn_global_load_lds((const unsigned*)(h1 + off), (LAS unsigned*)(lds + LDS_DUMMY + wid * 256), 4, 0, 0);
            __builtin_amdgcn_global_load_lds((const unsigned*)(pp + off), (LAS unsigned*)(lds + LDS_DUMMY + wid * 256), 4, 0, 0); }
        if (wid < 4) __builtin_amdgcn_global_load_lds((const unsigned*)(ss1 + u.pm * BM + tid), (LAS unsigned*)(lds + LDS_DUMMY + wid * 256), 4, 0, 0);
    }
    const float* ss1; const bf16_t* h1; float* h; const bf16_t* pp; bf16_t* hb; float* ss2; int last;
    DI void operator()(const f32x4 (&acc)[2][2][4][2], const Unit& u, int wr, int wc, int fr, int fq) const {
        float rsv[2][4];
        EPI_ROWS_NF rsv[ai][m] = ss1[u.pm * BM + ai * HALF + wr * 64 + m * 16 + fr];
        EPI_ROWS_NF rsv[ai][m] = rsqrtf(rsv[ai][m] * (1.f / 1024.f) + 1e-6f);
        EPI_ROWS { const int row = u.pm * BM + ai * HALF + wr * 64 + m * 16 + fr; float s = 0.f;
            const float rs = rsv[ai][m];
#pragma unroll
            for (int bj = 0; bj < 2; ++bj) { const size_t off = (size_t)row * 1024 + u.pn * BM + bj * HALF + 32 * wc + 8 * fq;
                const f32x4 a0 = acc[ai][bj][m][0] * rs, a1 = acc[ai][bj][m][1] * rs; const u32x4 pw = *(const u32x4*)(pp + off); const u32x4 hw = *(const u32x4*)(h1 + off);
                f32x4 h0, h1_;
                h0[0] = bf_lo(hw.x) + fsigmoid(a0[0]) * bf_lo(pw.x); h0[1] = bf_hi(hw.x) + fsigmoid(a0[1]) * bf_hi(pw.x); h0[2] = bf_lo(hw.y) + fsigmoid(a0[2]) * bf_lo(pw.y); h0[3] = bf_hi(hw.y) + fsigmoid(a0[3]) * bf_hi(pw.y);
                h1_[0] = bf_lo(hw.z) + fsigmoid(a1[0]) * bf_lo(pw.z); h1_[1] = bf_hi(hw.z) + fsigmoid(a1[1]) * bf_hi(pw.z); h1_[2] = bf_lo(hw.w) + fsigmoid(a1[2]) * bf_lo(pw.w); h1_[3] = bf_hi(hw.w) + fsigmoid(a1[3]) * bf_hi(pw.w);
                if (last) { *(f32x4*)(h + off) = h0; *(f32x4*)(h + off + 4) = h1_; }
                if (!last) { u32x4 w; w.x = cvt_pk_bf16(h0[0], h0[1]); w.y = cvt_pk_bf16(h0[2], h0[3]); w.z = cvt_pk_bf16(h1_[0], h1_[1]); w.w = cvt_pk_bf16(h1_[2], h1_[3]); *(u32x4*)(hb + off) = w;
                    s += ((h0[0] * h0[0] + h0[1] * h0[1]) + (h0[2] * h0[2] + h0[3] * h0[3])) + ((h1_[0] * h1_[0] + h1_[1] * h1_[1]) + (h1_[2] * h1_[2] + h1_[3] * h1_[3])); } }
            if (!last) { s += __shfl_xor(s, 16); s += __shfl_xor(s, 32); if (fq == 0) atomicAdd(ss2 + row, s); } }
    }
};
struct EpiPP {
    DI void prefetch(const Unit&, LAS unsigned char*, int) const {}
    bf16_t* pp;
    DI void operator()(const f32x4 (&acc)[2][2][4][2], const Unit& u, int wr, int wc, int fr, int fq) const {
        EPI_ROWS { const int row = u.pm * BM + ai * HALF + wr * 64 + m * 16 + fr;
#pragma unroll
            for (int bj = 0; bj < 2; ++bj) { const size_t off = (size_t)row * 1024 + u.pn * BM + bj * HALF + 32 * wc + 8 * fq; const f32x4 a0 = acc[ai][bj][m][0] * 1.0f, a1 = acc[ai][bj][m][1] * 1.0f;
                u32x4 w; w.x = cvt_pk_bf16(a0[0], a0[1]); w.y = cvt_pk_bf16(a0[2], a0[3]); w.z = cvt_pk_bf16(a1[0], a1[1]); w.w = cvt_pk_bf16(a1[2], a1[3]); *(u32x4*)(pp + off) = w; } }
    }
};

DI void attn_item(int item, const bf16_t* Q, const bf16_t* Kb, const bf16_t* VT, const bf16_t* GA, bf16_t* cat, int lane) {
    const int qb = item & 127, h = (item >> 7) & 7, b = item >> 10;
    const int q0 = qb * 32, hf = lane >> 5, ql = lane & 31;
    const bf16_t* qp = Q + (size_t)(b * SEQ + q0 + ql) * 512 + h * 64 + 8 * hf;
    bf16x8 qf[4];
#pragma unroll
    for (int s = 0; s < 4; ++s) qf[s] = *(const bf16x8*)(qp + 16 * s);
    const int kperm = (ql & 16) | ((ql & 4) << 1) | ((ql & 8) >> 1) | (ql & 3);
    const bf16_t* kbase = Kb + (((size_t)(b * 8 + h)) << 18) + kperm * 16 + 8 * hf;
    const bf16_t* vbase = VT + (((size_t)(b * 8 + h)) << 18) + ql * 16 + 8 * hf;
    f32x16 o0, o1;
#pragma unroll
    for (int i = 0; i < 16; ++i) { o0[i] = 0.f; o1[i] = 0.f; }
    float cprod = 1.f;
    bf16x8 kf[4], vf[2][2];
    { const bf16_t* kp = kbase + (size_t)(q0 >> 5) * 2048; const bf16_t* vp = vbase + (size_t)(q0 >> 5) * 2048;
#pragma unroll
      for (int s = 0; s < 4; ++s) kf[s] = *(const bf16x8*)(kp + 512 * s);
#pragma unroll
      for (int s = 0; s < 2; ++s) { vf[s][0] = *(const bf16x8*)(vp + 512 * s); vf[s][1] = *(const bf16x8*)(vp + 1024 + 512 * s); } }
#define ATT_TILE(DIAG) { \
        f32x16 st; _Pragma("unroll") for (int i = 0; i < 16; ++i) st[i] = 0.f; \
        _Pragma("unroll") for (int s = 0; s < 4; ++s) st = __builtin_amdgcn_mfma_f32_32x32x16_bf16(kf[s], qf[s], st, 0, 0, 0); \
        const int kn = kb >= 32 ? kb - 32 : 0; const bf16_t* kp = kbase + (size_t)(kn >> 5) * 2048; const bf16_t* vp = vbase + (size_t)(kn >> 5) * 2048; \
        bf16x8 kf2[4], vf2[2][2]; \
        _Pragma("unroll") for (int s = 0; s < 4; ++s) kf2[s] = *(const bf16x8*)(kp + 512 * s); \
        _Pragma("unroll") for (int s = 0; s < 2; ++s) { vf2[s][0] = *(const bf16x8*)(vp + 512 * s); vf2[s][1] = *(const bf16x8*)(vp + 1024 + 512 * s); } \
        float sg[16], ns[16]; float PA = 1.f, PB = 1.f; \
        _Pragma("unroll") for (int r = 0; r < 16; ++r) { \
            const float t = st[r] * -1.4426950408889634f; \
            const float e = __builtin_amdgcn_exp2f(fminf(t, 115.0f));        \
            float sgm = __builtin_amdgcn_rcpf(1.0f + e);                     \
            float nsv = e * sgm;                                             \
            if (DIAG) { const int koff = 16 * (r >> 3) + 8 * hf + (r & 7); if (koff >= ql) { sgm = 0.f; nsv = 1.f; } } \
            sg[r] = sgm; ns[r] = nsv; if (r < 8) PA *= nsv; else PB *= nsv; } \
        const float PAo = __shfl_xor(PA, 32), PBo = __shfl_xor(PB, 32); \
        float runA = cprod * (PB * PBo) * (hf == 0 ? PAo : 1.f); float runB = cprod * (hf == 0 ? PBo : 1.f); \
        float w[16]; \
        _Pragma("unroll") for (int r = 7; r >= 0; --r) { w[r] = sg[r] * runA; runA *= ns[r]; } \
        _Pragma("unroll") for (int r = 15; r >= 8; --r) { w[r] = sg[r] * runB; runB *= ns[r]; } \
        cprod *= (PA * PAo) * (PB * PBo); \
        _Pragma("unroll") for (int s = 0; s < 2; ++s) { \
            u32x4 pw; pw.x = cvt_pk_bf16(w[8 * s], w[8 * s + 1]); pw.y = cvt_pk_bf16(w[8 * s + 2], w[8 * s + 3]); pw.z = cvt_pk_bf16(w[8 * s + 4], w[8 * s + 5]); pw.w = cvt_pk_bf16(w[8 * s + 6], w[8 * s + 7]); \
            const bf16x8 wf = __builtin_bit_cast(bf16x8, pw); \
            o0 = __builtin_amdgcn_mfma_f32_32x32x16_bf16(wf, vf[s][0], o0, 0, 0, 0); \
            o1 = __builtin_amdgcn_mfma_f32_32x32x16_bf16(wf, vf[s][1], o1, 0, 0, 0); } \
        _Pragma("unroll") for (int s = 0; s < 4; ++s) kf[s] = kf2[s]; \
        _Pragma("unroll") for (int s = 0; s < 2; ++s) { vf[s][0] = vf2[s][0]; vf[s][1] = vf2[s][1]; } \
        kb -= 32; }
    { int kb = q0;
      ATT_TILE(true)
      if (kb >= 0 && !__all(cprod < 1.17549435e-38f)) {
          _Pragma("nounroll") for (;;) { ATT_TILE(false) if (kb < 0 || __all(cprod < 1.17549435e-38f)) break; } } }
#undef ATT_TILE
#pragma unroll
    for (int r = 0; r < 16; ++r) {
        const size_t tok = (size_t)(b * SEQ + q0 + 8 * (r >> 2) + 4 * hf + (r & 3));
        const float g0 = __uint_as_float((unsigned)GA[tok * 512 + h * 64 + ql] << 16), g1 = __uint_as_float((unsigned)GA[tok * 512 + h * 64 + 32 + ql] << 16);
        const unsigned w = cvt_pk_bf16(o0[r] * g0, o1[r] * g1);
        cat[tok * 1024 + 512 + h * 64 + ql] = (bf16_t)(w & 0xffffu);
        cat[tok * 1024 + 512 + h * 64 + 32 + ql] = (bf16_t)(w >> 16);
    }
}

DI void sincos_d(double ang, double& s, double& c) {
    const double k = rint(ang * 0.63661977236758134308);
    double y = fma(-k, 1.5707963267948966192, ang); y = fma(-k, 6.123233995736766e-17, y);
    const double y2 = y * y;
    const double sp = y * (1.0 - y2 * (1.0 / 6.0) * (1.0 - y2 * (1.0 / 20.0) * (1.0 - y2 * (1.0 / 42.0) * (1.0 - y2 * (1.0 / 72.0) * (1.0 - y2 * (1.0 / 110.0) * (1.0 - y2 * (1.0 / 156.0) * (1.0 - y2 * (1.0 / 210.0) * (1.0 - y2 * (1.0 / 272.0)))))))));
    const double cp = 1.0 - y2 * (1.0 / 2.0) * (1.0 - y2 * (1.0 / 12.0) * (1.0 - y2 * (1.0 / 30.0) * (1.0 - y2 * (1.0 / 56.0) * (1.0 - y2 * (1.0 / 90.0) * (1.0 - y2 * (1.0 / 132.0) * (1.0 - y2 * (1.0 / 182.0) * (1.0 - y2 * (1.0 / 240.0))))))));
    const int q = (int)((long long)k & 3);
    s = (q == 0) ? sp : (q == 1) ? cp : (q == 2) ? -sp : -cp;
    c = (q == 0) ? cp : (q == 1) ? -sp : (q == 2) ? -cp : sp;
}
DI double exp_d(double x) {
    const double k = rint(x * 1.4426950408889634074); const double r = fma(-k, 0.69314718055994530942, x);
    double t = 1.0;
#pragma unroll
    for (int i = 14; i >= 1; --i) t = 1.0 + t * r * (1.0 / (double)i);
    return ldexp(t, (int)k);
}

template <int MODE>
DI int colmap(int n) {
    if (MODE == 1) { const int pn = n >> 8, r = n & 255, bj = r >> 7, wc = (r >> 5) & 3, c = r & 31; return 256 * pn + 64 * wc + 32 * bj + c; }
    if (MODE == 2) { const int pn = n >> 8, r = n & 255; return r < 128 ? 128 * pn + r : 512 + 128 * pn + (r - 128); }
    if (MODE == 5) { const int rho = n & 31, nn = rho >> 4, i = rho & 15; const int m2 = (n & ~31) + 8 * (i >> 2) + 4 * nn + (i & 3); const int pn = m2 >> 8, r = m2 & 255, bj = r >> 7, wc = (r >> 5) & 3, c = r & 31; return 256 * pn + 64 * wc + 32 * bj + c; }
    if (MODE == 4) { const int rho = n & 31, nn = rho >> 4, i = rho & 15; const int m2 = (n & ~31) + 8 * (i >> 2) + 4 * nn + (i & 3); const int pn = m2 >> 8, r = m2 & 255; return r < 128 ? 128 * pn + r : 512 + 128 * pn + (r - 128); }
    if (MODE == 3) { const int rho = n & 31, nn = rho >> 4, i = rho & 15; return (n & ~31) + 8 * (i >> 2) + 4 * nn + (i & 3); }
    return n;
}
template <int MODE>
DI void transpose_w(const float* W, int K, int N, bf16_t* WT, const float* kscale, LAS float* scr, int gw, int nw, int lane) {
    const int nblk = N >> 5, items = (K >> 6) * nblk;
    for (int item = gw; item < items; item += nw) {
        const int kb = item / nblk, nb = item - kb * nblk, k0 = 64 * kb, n0 = 32 * nb, colL = colmap<MODE>(n0 + (lane & 31));
        float tv[32];
#pragma unroll
        for (int i = 0; i < 32; ++i) { const int kk = 2 * i + (lane >> 5); tv[i] = W[(size_t)(k0 + kk) * N + colL]; }
        if (kscale) {
#pragma unroll
            for (int i = 0; i < 32; ++i) tv[i] *= kscale[k0 + 2 * i + (lane >> 5)]; }
#pragma unroll
        for (int i = 0; i < 32; ++i) { const int kk = 2 * i + (lane >> 5); scr[kk * 33 + (lane & 31)] = tv[i]; }
        asm volatile("s_waitcnt lgkmcnt(0)" ::: "memory");
        const int cc = lane & 7;
#pragma unroll
        for (int j = 0; j < 4; ++j) { const int n = (lane >> 3) + 8 * j; const LAS float* sp = scr + (8 * cc) * 33 + n;
            u32x4 o; o.x = cvt_pk_bf16(sp[0 * 33], sp[1 * 33]); o.y = cvt_pk_bf16(sp[2 * 33], sp[3 * 33]); o.z = cvt_pk_bf16(sp[4 * 33], sp[5 * 33]); o.w = cvt_pk_bf16(sp[6 * 33], sp[7 * 33]);
            *(u32x4*)(WT + (size_t)(n0 + n) * K + k0 + 8 * cc) = o; }
        asm volatile("s_waitcnt lgkmcnt(0)" ::: "memory");
    }
}

DI void ssm_prep(const Params& P, int lg, int qd, LAS unsigned char* lds, int tid) {
    LAS float* apr = (LAS float*)lds;
    LAS float* api = apr + 33 * 64;
    LAS float* bbr = api + 33 * 64;
    LAS float* bbi = bbr + 1024;
    LAS float* cr = bbi + 1024;
    LAS float* ci = cr + 1024;
    LAS float* ktab = ci + 1024;
    LAS float* part = ktab + 8192;
    LAS double* fz = (LAS double*)(part + 8192);
    const double dt = exp_d((double)P.log_dt[lg]);
    for (int idx = tid; idx < 33 * 64; idx += 512) {
        const int tau = idx >> 6, p = idx & 63;
        const double lr = (double)P.a_re[lg * 64 + p], li = (double)P.a_im[lg * 64 + p];
        const double mag = exp_d(lr * dt * (double)tau); double s, c; sincos_d(li * dt * (double)tau, s, c);
        apr[idx] = (float)(mag * c); api[idx] = (float)(mag * s);
        if (tau == 32 && qd == 0) { float* a32 = (float*)(P.ws + WS_MISC) + (size_t)(lg * 64 + p) * 2; a32[0] = (float)(mag * c); a32[1] = (float)(mag * s); }
        if (tau == 1) {
            const double nr = mag * c - 1.0, ni = mag * s, den = lr * lr + li * li;
            fz[2 * p] = (nr * lr + ni * li) / den; fz[2 * p + 1] = (ni * lr - nr * li) / den; }
    }
    for (int idx = tid; idx < 1024; idx += 512) { cr[idx] = P.c_re[(size_t)lg * 1024 + idx]; ci[idx] = P.c_im[(size_t)lg * 1024 + idx]; }
    __syncthreads();
    for (int idx = tid; idx < 1024; idx += 512) { const int p = idx >> 4; const double fr_ = fz[2 * p], fi_ = fz[2 * p + 1];
        const double br = (double)P.b_re[(size_t)lg * 1024 + idx], bi = (double)P.b_im[(size_t)lg * 1024 + idx];
        bbr[idx] = (float)(fr_ * br - fi_ * bi); bbi[idx] = (float)(fr_ * bi + fi_ * br); }
    __syncthreads();
    {
        const int hh = tid & 255, hp = hh >> 4, h = hh & 15, ph = tid >> 8;
        float cbr[32], cbi[32];
#pragma unroll
        for (int i = 0; i < 32; ++i) { const int p = 32 * ph + i; const float c_r = cr[h * 64 + p], c_i = ci[h * 64 + p], x_r = bbr[p * 16 + hp], x_i = bbi[p * 16 + hp];
            cbr[i] = c_r * x_r - c_i * x_i; cbi[i] = c_r * x_i + c_i * x_r; }
        for (int tau = 0; tau < 32; ++tau) { float acc = 0.f;
#pragma unroll
            for (int i = 0; i < 32; ++i) acc += apr[tau * 64 + 32 * ph + i] * cbr[i] - api[tau * 64 + 32 * ph + i] * cbi[i];
            if (ph) part[tau * 256 + hh] = acc; else ktab[tau * 256 + hh] = acc; }
    }
    __syncthreads();
    for (int o = tid; o < 8192; o += 512) ktab[o] += part[o];
    __syncthreads();
    bf16_t* W1 = (bf16_t*)(P.ws + WS_W1) + (size_t)lg * 256 * 512;
    for (int it = tid; it < 128 * 64; it += 512) {
        const int n = 128 * qd + (it >> 6), k8 = it & 63, s = k8 >> 1, hp0 = (k8 & 1) * 8; float v[8];
#pragma unroll
        for (int i = 0; i < 8; ++i) {
            if (n < 128) { const int p = n & 63; const float ar = apr[(31 - s) * 64 + p], ai = api[(31 - s) * 64 + p], xr = bbr[p * 16 + hp0 + i], xi = bbi[p * 16 + hp0 + i];
                v[i] = n < 64 ? ar * xr - ai * xi : ar * xi + ai * xr; }
            else v[i] = 0.f;
        }
        u32x4 o; o.x = cvt_pk_bf16(v[0], v[1]); o.y = cvt_pk_bf16(v[2], v[3]); o.z = cvt_pk_bf16(v[4], v[5]); o.w = cvt_pk_bf16(v[6], v[7]);
        *(u32x4*)(W1 + (size_t)n * 512 + k8 * 8) = o;
    }
    bf16_t* TP = (bf16_t*)(P.ws + WS_TOEP) + (size_t)lg * 512 * 640;
    for (int it = tid; it < 256 * 80; it += 512) {
        const int n = 256 * qd + it / 80, k8 = it % 80, nl = colmap<3>(n), t = nl >> 4, h = nl & 15; float v[8];
        if (k8 < 64) { const int s = k8 >> 1, hp0 = (k8 & 1) * 8;
#pragma unroll
            for (int i = 0; i < 8; ++i) v[i] = (s <= t) ? ktab[(t - s) * 256 + (hp0 + i) * 16 + h] : 0.f;
        } else if (k8 < 72) {
#pragma unroll
            for (int i = 0; i < 8; ++i) { const int p = (k8 - 64) * 8 + i; v[i] = cr[h * 64 + p] * apr[(t + 1) * 64 + p] - ci[h * 64 + p] * api[(t + 1) * 64 + p]; }
        } else {
#pragma unroll
            for (int i = 0; i < 8; ++i) { const int p = (k8 - 72) * 8 + i; v[i] = -(cr[h * 64 + p] * api[(t + 1) * 64 + p] + ci[h * 64 + p] * apr[(t + 1) * 64 + p]); }
        }
        u32x4 o; o.x = cvt_pk_bf16(v[0], v[1]); o.y = cvt_pk_bf16(v[2], v[3]); o.z = cvt_pk_bf16(v[4], v[5]); o.w = cvt_pk_bf16(v[6], v[7]);
        *(u32x4*)(TP + (size_t)n * 640 + k8 * 8) = o;
    }
    __syncthreads();
}

#define XB_TMO      128
#define XB_XCNT(j)  (256  + 64 * (j))
#define XB_XSUB(j)  (1280 + 64 * (j))
#define XB_XGEN(j)  (2304 + 64 * (j))
#define XB_TOP      3328
#define XB_TOPGEN   3392
#define XCD_BAR_WORDS 3456
#define XB_SPIN_CAP (1u << 18)
DI unsigned xb_ld(unsigned* p) { return __hip_atomic_load(p, __ATOMIC_RELAXED, __HIP_MEMORY_SCOPE_AGENT); }
DI unsigned xb_add(unsigned* p, unsigned v) { return __hip_atomic_fetch_add(p, v, __ATOMIC_RELAXED, __HIP_MEMORY_SCOPE_AGENT); }
DI unsigned xb_xcc_id() { return (unsigned)__builtin_amdgcn_s_getreg((3 << 11) | 20) & 0xFu; }
#define XB_SPIN(cond, bar) do { unsigned _sp = 0; while (cond) { __builtin_amdgcn_s_sleep(1); \
    if ((++_sp & 255u) == 0u) { if (xb_ld(&(bar)[XB_TMO])) break; if (_sp > XB_SPIN_CAP) { atomicAdd(&(bar)[XB_TMO], 1u); break; } } } } while (0)
DI void xcd_barrier_complete(unsigned* bar, unsigned x, unsigned G, unsigned& nloc, unsigned& nx) {
    unsigned sum, cnt, mine, sp = 0u;
    for (;;) {
        sum = 0u; cnt = 0u; mine = 0u;
#pragma unroll 1
        for (unsigned j = 0; j < 16; ++j) { const unsigned cj = xb_ld(&bar[XB_XCNT(j)]); sum += cj; cnt += (cj > 0u) ? 1u : 0u; mine = (j == x) ? cj : mine; }
        if (sum == G) break;
        __builtin_amdgcn_s_sleep(1);
        if ((++sp & 255u) == 0u) { if (xb_ld(&bar[XB_TMO])) break; if (sp > XB_SPIN_CAP) { atomicAdd(&bar[XB_TMO], 1u); break; } }
    }
    nloc = mine > 0u ? mine : 1u; nx = cnt > 0u ? cnt : 1u;
}
DI void xcd_barrier(unsigned* bar, volatile LAS unsigned* st, const int wid) {
    asm volatile("" : "+s"(bar));
    asm volatile("s_waitcnt vmcnt(0)" ::: "memory");
    __syncthreads();
    if (wid == 0 && lane_fresh() == 0) {
        const unsigned x = xb_xcc_id();
        __builtin_amdgcn_s_waitcnt(0);
        const unsigned nloc = st[0], nx = st[1];
        const unsigned old = xb_add(&bar[XB_XSUB(x)], 1u);
        const unsigned gen = old / nloc;
        if (old + 1u == (gen + 1u) * nloc) {
            __builtin_amdgcn_fence(__ATOMIC_RELEASE, "agent");
            asm volatile("s_waitcnt vmcnt(0)" ::: "memory");
            const unsigned og = xb_add(&bar[XB_TOP], 1u);
            const unsigned tg = og / nx;
            if (og + 1u == (tg + 1u) * nx) xb_add(&bar[XB_TOPGEN], 1u);
            else XB_SPIN(xb_ld(&bar[XB_TOPGEN]) == tg, bar);
            __builtin_amdgcn_fence(__ATOMIC_ACQUIRE, "agent");
            xb_add(&bar[XB_XGEN(x)], 1u);
            asm volatile("s_waitcnt vmcnt(0)" ::: "memory");
        } else {
            XB_SPIN(xb_ld(&bar[XB_XGEN(x)]) == gen, bar);
            __builtin_amdgcn_fence(__ATOMIC_ACQUIRE, "agent");
            asm volatile("s_waitcnt vmcnt(0)" ::: "memory");
        }
    }
    __syncthreads();
}

__global__ void __launch_bounds__(512) mega(Params P) {
    extern __shared__ __attribute__((aligned(16))) unsigned char shm[];
    LAS unsigned char* lds = (LAS unsigned char*)shm;
    cg::grid_group grid = cg::this_grid();
    const int wid = __builtin_amdgcn_readfirstlane(threadIdx.x >> 6);
    const int G = gridDim.x, c = blockIdx.x;
    const int gthreads = G * 512;
#define LANE lane_fresh()
#define TID (wid * 64 + lane_fresh())
#define GTID (c * 512 + wid * 64 + lane_fresh())
    unsigned char* ws = P.ws;
    float* ssb = (float*)(ws + WS_MISC + 65536);
    bf16_t* hbA = (bf16_t*)(ws + WS_HBA);
    bf16_t* Ucat = (bf16_t*)(ws + WS_UCAT);
    bf16_t* SG = (bf16_t*)(ws + WS_SGGA); bf16_t* GA = SG + (size_t)T * 512; bf16_t* hbB = SG;
    bf16_t* Qb = (bf16_t*)(ws + WS_QK); bf16_t* Kb = Qb + (size_t)T * 512; bf16_t* pp = Qb;
    bf16_t* VT = (bf16_t*)(ws + WS_VT); bf16_t* zb = (bf16_t*)(ws + WS_ZB);
    bf16_t* cat = (bf16_t*)(ws + WS_CAT);
    float* Sbuf = (float*)(ws + WS_SBUF);
    bf16_t* pb = (bf16_t*)(ws + WS_PB);

    unsigned* bar = (unsigned*)(ws + WS_MISC + 786432);
    volatile LAS unsigned* xst = (volatile LAS unsigned*)(lds + STAGE_BYTES);
#define GSYNC() xcd_barrier(bar, xst, wid)
    if (wid == 0 && LANE == 0) { xst[0] = 0u; xst[1] = 0u; (void)xb_add(&bar[XB_XCNT(xb_xcc_id())], 1u); }
    if (P.ws == nullptr) grid.sync();
    for (int rep = 0; rep < REP_P0; ++rep) {
    const int role = (c >> 3) & 1, sc = ((c >> 4) << 3) | (c & 7), SG_ = G >> 1;
    const int sthreads = SG_ * 512;
    if (role == 0) ssm_prep(P, sc >> 1, sc & 1, lds, TID);
    { const int lane = LANE; LAS float* scr = (LAS float*)lds + wid * (64 * 33); const int l = role == 0 ? 1 : 0;
    for (int i = sc * 512 + TID; i < 3 * T; i += SG_ * 512) if (role == 1) ssb[T + i] = 0.f;
    {
        transpose_w<5>(P.w_in + (size_t)l * 1024 * 3072, 1024, 3072, (bf16_t*)(ws + WS_WIN) + (size_t)l * 3072 * 1024, P.mix_g + l * 1024, scr, sc * 8 + wid, SG_ * 8, lane);
        transpose_w<4>(P.w_glu + (size_t)l * 512 * 1024, 512, 1024, (bf16_t*)(ws + WS_WGLU) + (size_t)l * 1024 * 512, nullptr, scr, sc * 8 + wid, SG_ * 8, lane);
        transpose_w<3>(P.w_out + (size_t)l * 1024 * 1024, 1024, 1024, (bf16_t*)(ws + WS_WOUT) + (size_t)l * 1024 * 1024, nullptr, scr, sc * 8 + wid, SG_ * 8, lane);
        transpose_w<3>(P.w_pg + (size_t)l * 1024 * 1024, 1024, 1024, (bf16_t*)(ws + WS_WPG) + (size_t)l * 1024 * 1024, P.ple_g + l * 1024, scr, sc * 8 + wid, SG_ * 8, lane);
        transpose_w<3>(P.w_pp + (size_t)l * 256 * 1024, 256, 1024, (bf16_t*)(ws + WS_WPP) + (size_t)l * 1024 * 256, nullptr, scr, sc * 8 + wid, SG_ * 8, lane);
    } }
    if (role == 1)
    for (int row = (sc * 8 + wid) * 2; row < T; row += SG_ * 16) {
        const int lane = LANE;
        const f32x4* xr = (const f32x4*)(P.x + (size_t)row * 1024); f32x4 v[2][4];
#pragma unroll
        for (int r2 = 0; r2 < 2; ++r2)
#pragma unroll
            for (int j = 0; j < 4; ++j) v[r2][j] = xr[r2 * 256 + lane + 64 * j];
#pragma unroll
        for (int r2 = 0; r2 < 2; ++r2) { float s = 0.f;
#pragma unroll
            for (int j = 0; j < 4; ++j) { const f32x4 q = v[r2][j]; s += (q[0] * q[0] + q[1] * q[1]) + (q[2] * q[2] + q[3] * q[3]);
                u32x2 w; w.x = cvt_pk_bf16(q[0], q[1]); w.y = cvt_pk_bf16(q[2], q[3]); *(u32x2*)(hbA + (size_t)(row + r2) * 1024 + (lane + 64 * j) * 4) = w; }
#pragma unroll
            for (int o = 1; o < 64; o <<= 1) s += __shfl_xor(s, o);
            if (lane == 0) ssb[row + r2] = s; }
    }
    { const size_t pbase = (size_t)(role == 0 ? 1 : 0) * T * 256 / 8, pend = pbase + (size_t)T * 256 / 8;
    for (size_t i = pbase + sc * 512 + TID; i < pend; i += (size_t)4 * sthreads) {
        f32x4 a[4], b[4];
#pragma unroll
        for (int q = 0; q < 4; ++q) { const size_t ii = i + (size_t)q * sthreads; if (ii < pend) { a[q] = ((const f32x4*)P.p)[2 * ii]; b[q] = ((const f32x4*)P.p)[2 * ii + 1]; } }
#pragma unroll
        for (int q = 0; q < 4; ++q) { const size_t ii = i + (size_t)q * sthreads; if (ii < pend) {
            u32x4 o; o.x = cvt_pk_bf16(a[q][0], a[q][1]); o.y = cvt_pk_bf16(a[q][2], a[q][3]); o.z = cvt_pk_bf16(b[q][0], b[q][1]); o.w = cvt_pk_bf16(b[q][2], b[q][3]);
            ((u32x4*)pb)[ii] = o; } }
    }
    }
    }
    if (wid == 0 && LANE == 0) { unsigned nloc, nx; xcd_barrier_complete(bar, xb_xcc_id(), G, nloc, nx); xst[0] = nloc; xst[1] = nx; }
    GSYNC();

    auto layer = [&](const int l) __attribute__((always_inline)) {
        float* ssIn = ssb + (size_t)(2 * l) * T; float* ssMid = ssb + (size_t)(2 * l + 1) * T; float* ssNext = ssb + (size_t)(2 * l + 2 > 3 ? 3 : 2 * l + 2) * T;
        { Gemm g{hbA, (const bf16_t*)(ws + WS_WIN) + (size_t)l * 3072 * 1024, 1024, 1024, 1024, 0, 0};
          Order S; S.init(T / 256, 12, 1, G, c);
          EpiIn E{ssIn, Ucat, SG, GA, Qb, Kb, VT, P.q_g + l * 64, P.k_g + l * 64};
          for (int rep = 0; rep < REP_INPROJ; ++rep) gemm_phase(lds, g, S, E, wid); }
        GSYNC();
        { Gemm g{Ucat, (const bf16_t*)(ws + WS_W1) + (size_t)l * 32 * 256 * 512, 640, 512, 512, (size_t)1024 * 640, (size_t)256 * 512};
          Order S; S.init(4, 1, 32, G, c);
          EpiS E{Sbuf};
          for (int rep = 0; rep < REP_GEMMS; ++rep) gemm_phase(lds, g, S, E, wid); }
        if (c < 128) {
            asm volatile("s_waitcnt vmcnt(0)" ::: "memory"); __syncthreads();
            const int lane = LANE, seg = lane >> 4, pl = lane & 15;
            const int q_ = c >> 3, L_ = ((c & 7) * 4 + (q_ >> 2)) * 4 + (q_ & 3);
            const int pq = wid & 3, g = L_ >> 2, b = 2 * (L_ & 3) + (wid >> 2), p = pq * 16 + pl;
            const float* a32 = (const float*)(ws + WS_MISC) + (size_t)((l * 32 + g) * 64 + p) * 2; const float ar = a32[0], ai = a32[1];
            const size_t row0 = (size_t)g * 1024 + b * 128 + seg * 32;
            const float* __restrict__ Sp = Sbuf + row0 * 128 + p;
            float sr[32], si[32];
#pragma unroll
            for (int j = 0; j < 32; ++j) { sr[j] = Sp[(size_t)j * 128]; si[j] = Sp[(size_t)j * 128 + 64]; }
            float hr = 0.f, hi = 0.f, wr_ = 1.f, wi_ = 0.f;
#pragma unroll
            for (int j = 0; j < 32; ++j) { const float nr = ar * hr - ai * hi + sr[j], ni = ar * hi + ai * hr + si[j]; hr = nr; hi = ni;
                const float xr = ar * wr_ - ai * wi_, xi = ar * wi_ + ai * wr_; wr_ = xr; wi_ = xi; }
            const float e0r = __shfl(hr, pl), e0i = __shfl(hi, pl), e1r = __shfl(hr, pl + 16), e1i = __shfl(hi, pl + 16), e2r = __shfl(hr, pl + 32), e2i = __shfl(hi, pl + 32);
            const float h1r = e0r, h1i = e0i;
            const float h2r = wr_ * h1r - wi_ * h1i + e1r, h2i = wr_ * h1i + wi_ * h1r + e1i;
            const float h3r = wr_ * h2r - wi_ * h2i + e2r, h3i = wr_ * h2i + wi_ * h2r + e2i;
            const float cinr = seg == 0 ? 0.f : seg == 1 ? h1r : seg == 2 ? h2r : h3r, cini = seg == 0 ? 0.f : seg == 1 ? h1i : seg == 2 ? h2i : h3i;
            bf16_t* __restrict__ Up = Ucat + row0 * 640 + 512 + p;
            hr = 0.f; hi = 0.f; float cr_ = cinr, ci_ = cini;
#pragma unroll
            for (int j = 0; j < 32; ++j) {
                const unsigned pk = cvt_pk_bf16(hr + cr_, hi + ci_);
                Up[(size_t)j * 640] = (bf16_t)(pk & 0xffffu); Up[(size_t)j * 640 + 64] = (bf16_t)(pk >> 16);
                const float nr = ar * hr - ai * hi + sr[j], ni = ar * hi + ai * hr + si[j]; hr = nr; hi = ni;
                const float xr = ar * cr_ - ai * ci_, xi = ar * ci_ + ai * cr_; cr_ = xr; ci_ = xi; }
            asm volatile("s_waitcnt vmcnt(0)" ::: "memory"); __syncthreads();
            { Gemm gy{Ucat, (const bf16_t*)(ws + WS_TOEP) + (size_t)l * 32 * 512 * 640, 640, 640, 640, (size_t)1024 * 640, (size_t)512 * 640};
              Order SY; SY.nwg = -1; SY.nM = g; SY.nN = L_ & 3; SY.lim = 2; SY.total = 0; SY.G = 0; SY.c = 0;
              EpiY EY{Ucat, P.dsk + l * 512, zb};
              for (int rep = 0; rep < REP_Y; ++rep) gemm_phase(lds, gy, SY, EY, wid); }
        }
        for (int rep = 0; rep < REP_ATTN; ++rep)
        {
            const int nit = c < 128 ? 1 : 7, base = c < 128 ? (c * 8 + wid) : 1024 + (c - 128) * 56 + wid;
            for (int j = 0; j < nit; ++j) attn_item(base + 8 * j, Qb, Kb, VT, GA, cat, LANE); }
        GSYNC();
        { Gemm g{zb, (const bf16_t*)(ws + WS_WGLU) + (size_t)l * 1024 * 512, 512, 512, 512, 0, 0};
          Order S; S.init(T / 256, 4, 1, G, c);
          EpiGlu E{P.b_glu + l * 1024, SG, cat};
          for (int rep = 0; rep < REP_GLU; ++rep) gemm_phase(lds, g, S, E, wid); }
        { Gemm g{pb + (size_t)l * T * 256, (const bf16_t*)(ws + WS_WPP) + (size_t)l * 1024 * 256, 256, 256, 256, 0, 0};
          Order S; S.init(T / 256, 4, 1, G, c);
          EpiPP E{pp};
          for (int rep = 0; rep < REP_PP; ++rep) gemm_phase(lds, g, S, E, wid); }
        GSYNC();
        { Gemm g{cat, (const bf16_t*)(ws + WS_WOUT) + (size_t)l * 1024 * 1024, 1024, 1024, 1024, 0, 0};
          Order S; S.init(T / 256, 4, 1, G, c);
          EpiOut E{hbA, hbB, ssMid};
          gemm_phase(lds, g, S, E, wid); }
        GSYNC();
        { Gemm g{hbB, (const bf16_t*)(ws + WS_WPG) + (size_t)l * 1024 * 1024, 1024, 1024, 1024, 0, 0};
          Order S; S.init(T / 256, 4, 1, G, c);
          EpiPle E{ssMid, hbB, P.out, pp, hbA, ssNext, l == 1 ? 1 : 0};
          gemm_phase(lds, g, S, E, wid); }
        if (l == 0) GSYNC();
    };
    layer(0); layer(1);
}

extern "C" void kernel_launch(void* const* d_in, const int* in_sizes, int n_in, void* d_out, int out_size, void* d_ws, size_t ws_size, hipStream_t stream) {
    static int grid = 0;
    if (grid == 0) {
        if (n_in != 20 || ws_size < WS_END) { fprintf(stderr, "kernel_launch: unexpected inputs (n_in %d, ws %zu < %zu)\n", n_in, ws_size, (size_t)WS_END); grid = -1; return; }
        int dev = 0, cus = 0, per_cu = 0;
        hipGetDevice(&dev); hipDeviceGetAttribute(&cus, hipDeviceAttributeMultiprocessorCount, dev);
        if (hipFuncSetAttribute((const void*)mega, hipFuncAttributeMaxDynamicSharedMemorySize, LDS_BYTES) != hipSuccess) { fprintf(stderr, "hipFuncSetAttribute failed\n"); grid = -1; return; }
        if (hipOccupancyMaxActiveBlocksPerMultiprocessor(&per_cu, (const void*)mega, 512, LDS_BYTES) != hipSuccess || per_cu < 1) { fprintf(stderr, "occupancy query: %d\n", per_cu); per_cu = 1; }
        (void)hipGetLastError();
        if (cus < 256) { fprintf(stderr, "kernel_launch: built for a 256-CU device (static work partition over 256 workgroups), found %d CUs; nothing launched\n", cus); grid = -1; return; }
        grid = 256;
    }
    if (grid < 0) return;
    if (hipMemsetAsync((char*)d_ws + WS_MISC + 786432, 0, XCD_BAR_WORDS * 4, stream) != hipSuccess) { fprintf(stderr, "kernel_launch: hipMemsetAsync failed\n"); return; }
    Params P{};
    const float** pp = (const float**)&P;
    for (int i = 0; i < 20; ++i) pp[i] = (const float*)d_in[i];
    P.out = (float*)d_out; P.ws = (unsigned char*)d_ws;
    void* args[] = {&P};
    hipError_t e = hipLaunchCooperativeKernel((const void*)mega, dim3(grid), dim3(512), args, LDS_BYTES, stream);
    if (e != hipSuccess) fprintf(stderr, "cooperative launch failed: %s (grid %d)\n", hipGetErrorString(e), grid);
}
```

```cpp
#ifndef REP_P0
#define REP_P0 1
#define REP_INPROJ 1
#define REP_ATTN 1
#define REP_SCAN 1
#define REP_SYNC 1
#define REP_GEMMS 1
#define REP_PP 1
#define REP_Y 1
#define REP_GLU 1
#endif
#include <hip/hip_runtime.h>
#include <hip/hip_cooperative_groups.h>
#include <cstdio>
namespace cg = cooperative_groups;

#define LAS __attribute__((address_space(3)))
#define DI __device__ __forceinline__
typedef unsigned short bf16_t;
typedef short bf16x8 __attribute__((ext_vector_type(8)));
typedef float f32x4 __attribute__((ext_vector_type(4)));
typedef float f32x16 __attribute__((ext_vector_type(16)));
typedef unsigned u32x4 __attribute__((ext_vector_type(4)));
typedef unsigned u32x2 __attribute__((ext_vector_type(2)));

constexpr int T = 32768, SEQ = 4096;
constexpr int BM = 256, BK = 64, HALF = 128, HTB = HALF * BK * 2, STAGE_BYTES = 8 * HTB, NXCD = 8, WGM = 2;
constexpr int LDS_DUMMY = STAGE_BYTES + 16;
constexpr int LDS_BYTES = STAGE_BYTES + 16 + 2048;

constexpr size_t MBy = 1u << 20;
constexpr size_t WS_WIN = 0;
constexpr size_t WS_WGLU = WS_WIN + 12 * MBy;
constexpr size_t WS_WOUT = WS_WGLU + 2 * MBy;
constexpr size_t WS_WPG = WS_WOUT + 4 * MBy;
constexpr size_t WS_WPP = WS_WPG + 4 * MBy;
constexpr size_t WS_W1 = WS_WPP + 1 * MBy;
constexpr size_t WS_TOEP = WS_W1 + 16 * MBy;
constexpr size_t WS_MISC = WS_TOEP + 40 * MBy;
constexpr size_t WS_HBA = WS_MISC + 1 * MBy;
constexpr size_t WS_UCAT = WS_HBA + 64 * MBy;
constexpr size_t WS_SGGA = WS_UCAT + 40 * MBy;
constexpr size_t WS_QK = WS_SGGA + 64 * MBy;
constexpr size_t WS_VT = WS_QK + 64 * MBy;
constexpr size_t WS_CAT = WS_VT + 32 * MBy;
constexpr size_t WS_SBUF = WS_CAT + 64 * MBy;
constexpr size_t WS_PB = WS_SBUF + 16 * MBy;
constexpr size_t WS_ZB = WS_PB + 32 * MBy;
constexpr size_t WS_END = WS_ZB + 32 * MBy;

struct Params {
    const float *x, *p, *mix_g, *w_in, *a_re, *a_im, *log_dt, *b_re, *b_im, *c_re, *c_im, *dsk, *w_glu, *b_glu, *q_g, *k_g, *w_out, *ple_g, *w_pg, *w_pp;
    float* out; unsigned char* ws;
};

DI int lane_fresh() { int l; asm volatile("v_mbcnt_lo_u32_b32 %0, -1, 0\n\tv_mbcnt_hi_u32_b32 %0, -1, %0" : "=v"(l)); return l; }
DI unsigned cvt_pk_bf16(float lo, float hi) { unsigned r; asm volatile("v_cvt_pk_bf16_f32 %0, %1, %2" : "=v"(r) : "v"(lo), "v"(hi)); return r; }
DI float bf_lo(unsigned w) { return __uint_as_float(w << 16); }
DI float bf_hi(unsigned w) { return __uint_as_float(w & 0xffff0000u); }
DI float fsigmoid(float x) { return __builtin_amdgcn_rcpf(1.0f + __expf(-x)); }
DI float fsilu(float x) { return x * fsigmoid(x); }
DI float fgelu_tanh(float y) { const float u2 = 1.5957691216057308f * (y + 0.044715f * y * y * y); return y * fsigmoid(u2); }

DI int lds_byte(int r, int c) { const int st = (r >> 4) * 2 + (c >> 5), rr = r & 15, cc = c & 31, ob = rr * 64 + cc * 2; return st * 1024 + (ob ^ (((ob >> 9) & 1) << 5)); }
DI void stage_rc(int b, int& R, int& C) { const int st = b / 1024, sb = b % 1024, swz = sb ^ (((sb >> 9) & 1) << 5); R = (st >> 1) * 16 + swz / 64; C = (st & 1) * 32 + (swz % 64) / 2; }

struct Unit { int pm, pn, g; };
struct Gemm { const bf16_t* A; const bf16_t* Bt; int lda, ldb, K; size_t gsA, gsB; };
struct Order {
    int nM, nN, nwg, total, G, c, lim;
    DI void init(int nM_, int nN_, int nG, int G_, int c_) { nM = nM_; nN = nN_; nwg = nM * nN; total = nwg * nG; lim = total; G = G_; c = c_; asm volatile("" : "+s"(c)); }
    DI bool next(int i, Unit& u) const {
        if (nwg < 0) { if (i >= lim) return false; u.g = nM; u.pm = nN; u.pn = i; return true; }
        int L = i * G + c; if (L >= lim) return false;
        if (total > nwg) {
            const int gpx = (total / nwg) >> 3, q = (c >> 3) + (G >> 3) * i; if (q >= gpx * nwg) return false;
            L = ((c & 7) * gpx + q / nwg) * nwg + q % nwg; }
        u.g = L / nwg; int wgid = L - u.g * nwg;
        { const int q = nwg / NXCD, r = nwg % NXCD, xcd = wgid % NXCD, off = wgid / NXCD; wgid = (xcd < r ? xcd * (q + 1) : r * (q + 1) + (xcd - r) * q) + off; }
        const int nig = WGM * nN, gid = wgid / nig, fm = gid * WGM, gsz = (nM - fm) < WGM ? (nM - fm) : WGM;
        u.pm = fm + ((wgid % nig) % gsz); u.pn = (wgid % nig) / gsz; return true;
    }
};

template <class Epi>
DI void gemm_phase(LAS unsigned char* lds, const Gemm g, const Order& S, const Epi& E, const int wid) {
    const int lane = lane_fresh(), tid = wid * 64 + lane, wr = wid >> 2, wc = wid & 3, fr = lane & 15, fq = lane >> 4;
    const int K = g.K, nt = K / BK;
    unsigned voffA[2], voffB[2];
#pragma unroll
    for (int i = 0; i < 2; ++i) { int R, C; stage_rc(tid * 16 + i * 8192, R, C); voffA[i] = (unsigned)(R * g.lda + C) * 2u; voffB[i] = (unsigned)(R * g.ldb + C) * 2u; }
    const size_t kstep = (size_t)(BK * 2);
    const size_t hstepA = (size_t)HALF * g.lda * 2, hstepB = (size_t)HALF * g.ldb * 2;
    const size_t tstepA = 2 * hstepA, tstepB = 2 * hstepB;
    const unsigned ldsw = (unsigned)wid * 1024u;
    const int aoff = lds_byte(wr * 64 + fr, fq * 8), boff = lds_byte(wc * 32 + fr, fq * 8);
#define PG8_SA(b, h) (((b) * 2 + (h)) * HTB)
#define PG8_SB(b, h) ((4 + (b) * 2 + (h)) * HTB)
#define PG8_STAGE(bufoff, gbase, voff) do { _Pragma("unroll") for (int _i = 0; _i < 2; ++_i) \
        __builtin_amdgcn_global_load_lds((const unsigned*)((const char*)(gbase) + (voff)[_i]), (LAS unsigned*)(lds + (bufoff) + ldsw + _i * 8192), 16, 0, 0); } while (0)
#define PG8_LDA(dst, b, h) do { _Pragma("unroll") for (int m = 0; m < 4; ++m) _Pragma("unroll") for (int k = 0; k < 2; ++k) dst[m][k] = *(const LAS bf16x8*)(lds + PG8_SA(b, h) + aoff + m * 2048 + k * 1024); } while (0)
#define PG8_LDB(dst, b, h) do { _Pragma("unroll") for (int n = 0; n < 2; ++n) _Pragma("unroll") for (int k = 0; k < 2; ++k) dst[n][k] = *(const LAS bf16x8*)(lds + PG8_SB(b, h) + boff + n * 2048 + k * 1024); } while (0)
#define PG8_MMA(ai, bj, At, Bt) do { __builtin_amdgcn_s_setprio(1); _Pragma("unroll") for (int m = 0; m < 4; ++m) _Pragma("unroll") for (int n = 0; n < 2; ++n) _Pragma("unroll") for (int k = 0; k < 2; ++k) \
        acc[ai][bj][m][n] = __builtin_amdgcn_mfma_f32_16x16x32_bf16(Bt[n][k], At[m][k], acc[ai][bj][m][n], 0, 0, 0); __builtin_amdgcn_s_setprio(0); } while (0)
#define PG8_WAIT_V(n) asm volatile("s_waitcnt vmcnt(" #n ")" ::: "memory")
#define PG8_WAIT_L(n) asm volatile("s_waitcnt lgkmcnt(" #n ")" ::: "memory")
#define PG8_BAR __builtin_amdgcn_s_barrier()
#define PG8_SCHED __builtin_amdgcn_sched_barrier(0)
    Unit cur, nxt; int ui = 0;
    if (!S.next(0, cur)) return;
    f32x4 acc[2][2][4][2];
#pragma unroll
    for (int a = 0; a < 2; ++a)
#pragma unroll
        for (int b = 0; b < 2; ++b)
#pragma unroll
            for (int m = 0; m < 4; ++m)
#pragma unroll
                for (int n = 0; n < 2; ++n) acc[a][b][m][n] = (f32x4){0.f, 0.f, 0.f, 0.f};
    bf16x8 At[4][2], B0[2][2], B1[2][2];
    const char* cA = (const char*)(g.A + (size_t)cur.g * g.gsA) + (size_t)cur.pm * tstepA;
    const char* cB = (const char*)(g.Bt + (size_t)cur.g * g.gsB) + (size_t)cur.pn * tstepB;
    PG8_STAGE(PG8_SB(0, 0), cB, voffB); PG8_STAGE(PG8_SB(0, 1), cB + hstepB, voffB); PG8_STAGE(PG8_SA(0, 0), cA, voffA); PG8_STAGE(PG8_SA(0, 1), cA + hstepA, voffA);
    if (wr == 1) PG8_BAR;
    PG8_WAIT_V(2); PG8_BAR;
    PG8_STAGE(PG8_SB(1, 0), cB + kstep, voffB); PG8_STAGE(PG8_SA(1, 0), cA + kstep, voffA); PG8_STAGE(PG8_SB(1, 1), cB + hstepB + kstep, voffB);
    PG8_WAIT_V(6); PG8_BAR;
    for (;;) {
        const bool has_next = S.next(ui + 1, nxt);
        const char* nA = has_next ? (const char*)(g.A + (size_t)nxt.g * g.gsA) + (size_t)nxt.pm * tstepA : cA;
        const char* nB = has_next ? (const char*)(g.Bt + (size_t)nxt.g * g.gsB) + (size_t)nxt.pn * tstepB : cB;
        for (int t = 0; t < nt; t += 2) {
            const bool last = (t == nt - 2);
            const char* a1 = cA + (size_t)(t + 1) * kstep;
            const char* a2 = last ? nA : cA + (size_t)(t + 2) * kstep; const char* b2 = last ? nB : cB + (size_t)(t + 2) * kstep;
            const char* a3 = a2 + kstep; const char* b3 = b2 + kstep;
            if (t == nt - 2) E.prefetch(cur, lds, wid);
            PG8_LDB(B0, 0, 0); PG8_LDB(B1, 0, 1); PG8_SCHED; PG8_LDA(At, 0, 0); PG8_STAGE(PG8_SA(1, 1), a1 + hstepA, voffA);
            PG8_WAIT_V(8); PG8_WAIT_L(0); PG8_BAR; PG8_MMA(0, 0, At, B0); PG8_MMA(0, 1, At, B1); PG8_BAR; PG8_SCHED;
            PG8_LDA(At, 0, 1); PG8_STAGE(PG8_SB(0, 0), b2, voffB); PG8_STAGE(PG8_SB(0, 1), b2 + hstepB, voffB); PG8_STAGE(PG8_SA(0, 0), a2, voffA);
            PG8_WAIT_V(8); PG8_WAIT_L(0); PG8_BAR; PG8_MMA(1, 0, At, B0); PG8_MMA(1, 1, At, B1); PG8_BAR; PG8_SCHED;
            PG8_LDB(B0, 1, 0); PG8_LDB(B1, 1, 1); PG8_SCHED; PG8_LDA(At, 1, 0); PG8_STAGE(PG8_SA(0, 1), a2 + hstepA, voffA);
            PG8_WAIT_V(8); PG8_WAIT_L(0); PG8_BAR; PG8_MMA(0, 0, At, B0); PG8_MMA(0, 1, At, B1); PG8_BAR; PG8_SCHED;
            PG8_LDA(At, 1, 1); PG8_STAGE(PG8_SB(1, 0), b3, voffB); PG8_STAGE(PG8_SB(1, 1), b3 + hstepB, voffB); PG8_STAGE(PG8_SA(1, 0), a3, voffA);
            PG8_WAIT_V(8); PG8_WAIT_L(0); PG8_BAR; PG8_MMA(1, 0, At, B0); PG8_MMA(1, 1, At, B1); PG8_BAR; PG8_SCHED;
        }
        if (wr == 0) PG8_BAR;
        { const int le = lane_fresh(); E(acc, cur, wr, wc, le & 15, le >> 4); }
        if (!has_next) break;
#pragma unroll
        for (int a = 0; a < 2; ++a)
#pragma unroll
            for (int b = 0; b < 2; ++b)
#pragma unroll
                for (int m = 0; m < 4; ++m)
#pragma unroll
                    for (int n = 0; n < 2; ++n) acc[a][b][m][n] = (f32x4){0.f, 0.f, 0.f, 0.f};
        cur = nxt; cA = nA; cB = nB; ++ui;
        if (wr == 1) PG8_BAR;
    }
    PG8_WAIT_V(0);
    PG8_BAR;
#undef PG8_SA
#undef PG8_SB
#undef PG8_STAGE
#undef PG8_LDA
#undef PG8_LDB
#undef PG8_MMA
#undef PG8_WAIT_V
#undef PG8_WAIT_L
#undef PG8_BAR
#undef PG8_SCHED
}

#define EPI_ROWS _Pragma("unroll") for (int ai = 0; ai < 2; ++ai) _Pragma("unroll") for (int m = 0; m < 4; ++m) if ((__extension__({ if (m == 0) asm volatile("" ::: "memory"); 1; })))
#define EPI_ROWS_NF _Pragma("unroll") for (int ai = 0; ai < 2; ++ai) _Pragma("unroll") for (int m = 0; m < 4; ++m)
#define EPI_COLS _Pragma("unroll") for (int bj = 0; bj < 2; ++bj) _Pragma("unroll") for (int n = 0; n < 2; ++n)

struct EpiIn {
    DI void prefetch(const Unit& u, LAS unsigned char* lds, int wid) const {
        if (wid < 4) __builtin_amdgcn_global_load_lds((const unsigned*)(ss + u.pm * BM + wid * 64 + lane_fresh()), (LAS unsigned*)(lds + LDS_DUMMY + wid * 256), 4, 0, 0);
    }
    const float* ss; bf16_t *Ucat, *SG, *GA, *Q, *Kb, *VT; const float *qg, *kg;
    DI void operator()(const f32x4 (&acc)[2][2][4][2], const Unit& u, int wr, int wc, int fr, int fq) const {
        const int type = u.pn >> 1, hf = u.pn & 1;
        float rsv[2][4];
        EPI_ROWS_NF rsv[ai][m] = ss[u.pm * BM + ai * HALF + wr * 64 + m * 16 + fr];
        EPI_ROWS_NF rsv[ai][m] = rsqrtf(rsv[ai][m] * (1.f / 1024.f) + 1e-6f);
#define EPI_BJ _Pragma("unroll") for (int bj = 0; bj < 2; ++bj)
#define PACK8(w, a0, a1) do { w.x = cvt_pk_bf16(a0[0], a0[1]); w.y = cvt_pk_bf16(a0[2], a0[3]); w.z = cvt_pk_bf16(a1[0], a1[1]); w.w = cvt_pk_bf16(a1[2], a1[3]); } while (0)
        if (type == 0) {
            EPI_ROWS_NF { const int row = u.pm * BM + ai * HALF + wr * 64 + m * 16 + fr; const float rs = rsv[ai][m];
                EPI_BJ { const f32x4 v0 = acc[ai][bj][m][0] * rs, v1 = acc[ai][bj][m][1] * rs; const int g = 16 * hf + 4 * wc + 2 * bj + (fq >> 1);
                    u32x4 w; PACK8(w, v0, v1);
                    *(u32x4*)(Ucat + ((size_t)(g * 1024 + (row >> 5)) * 640 + (row & 31) * 16 + 8 * (fq & 1))) = w; } }
        } else if (type == 1 || type == 5) {
            bf16_t* dst = type == 1 ? SG : GA;
            EPI_ROWS_NF { const int row = u.pm * BM + ai * HALF + wr * 64 + m * 16 + fr; const float rs = rsv[ai][m];
                EPI_BJ { f32x4 v0 = acc[ai][bj][m][0] * rs, v1 = acc[ai][bj][m][1] * rs; const int cs = 256 * hf + 64 * wc + 32 * bj + 8 * fq;
#pragma unroll
                    for (int j = 0; j < 4; ++j) { v0[j] = fsilu(v0[j]); v1[j] = fsilu(v1[j]); }
                    u32x4 w; PACK8(w, v0, v1);
                    *(u32x4*)(dst + (size_t)row * 512 + cs) = w; } }
        } else if (type == 2 || type == 3) {
            bf16_t* dst = type == 2 ? Q : Kb; const float* gam = type == 2 ? qg : kg; const float sc = type == 2 ? 0.125f : 1.0f;
            f32x4 gv[2][2];
            EPI_COLS gv[bj][n] = *(const f32x4*)(gam + 32 * bj + 8 * fq + 4 * n) * sc;
            EPI_ROWS_NF { const int row = u.pm * BM + ai * HALF + wr * 64 + m * 16 + fr; const float rs = rsv[ai][m];
                f32x4 v[2][2]; float s = 0.f;
                EPI_COLS { v[bj][n] = acc[ai][bj][m][n] * rs; s += (v[bj][n][0] * v[bj][n][0] + v[bj][n][1] * v[bj][n][1]) + (v[bj][n][2] * v[bj][n][2] + v[bj][n][3] * v[bj][n][3]); }
                s += __shfl_xor(s, 16); s += __shfl_xor(s, 32);
                const float ri = rsqrtf(s * (1.f / 64.f) + 1e-6f);
                EPI_BJ { const f32x4 o0 = v[bj][0] * ri * gv[bj][0], o1 = v[bj][1] * ri * gv[bj][1]; const int cs = 256 * hf + 64 * wc + 32 * bj + 8 * fq;
                    u32x4 w; PACK8(w, o0, o1);
                    if (type == 2) *(u32x4*)(dst + (size_t)row * 512 + cs) = w;
                    else {
                        const int key = row & 4095;
                        *(u32x4*)(dst + (((size_t)((row >> 12) * 8 + 4 * hf + wc)) << 18) + (key >> 5) * 2048 + (2 * bj + (fq >> 1)) * 512 + (key & 31) * 16 + 8 * (fq & 1)) = w; } } }
        } else {
            EPI_ROWS_NF { const int row = u.pm * BM + ai * HALF + wr * 64 + m * 16 + fr; const float rs = rsv[ai][m];
                const int b = row >> 12, s = row & 4095, head = 4 * hf + wc;
                EPI_COLS { const f32x4 v = acc[ai][bj][m][n] * rs;
                    const unsigned w0 = cvt_pk_bf16(v[0], v[1]), w1 = cvt_pk_bf16(v[2], v[3]);
                    bf16_t* o = VT + (((size_t)(b * 8 + head)) << 18) + (s >> 5) * 2048 + bj * 1024 + ((s >> 4) & 1) * 512 + (8 * fq + 4 * n) * 16 + (s & 15);
                    o[0] = (bf16_t)(w0 & 0xffffu); o[16] = (bf16_t)(w0 >> 16); o[32] = (bf16_t)(w1 & 0xffffu); o[48] = (bf16_t)(w1 >> 16); } }
        }
#undef EPI_BJ
#undef PACK8
    }
};
struct EpiS {
    DI void prefetch(const Unit&, LAS unsigned char*, int) const {}
    float* Sbuf;
    DI void operator()(const f32x4 (&acc)[2][2][4][2], const Unit& u, int wr, int wc, int fr, int fq) const {
        EPI_ROWS { const int R = u.pm * BM + ai * HALF + wr * 64 + m * 16 + fr;
#pragma unroll
            for (int n = 0; n < 2; ++n) *(f32x4*)(Sbuf + ((size_t)(u.g * 1024 + R) * 128 + 32 * wc + 16 * n + 4 * fq)) = acc[ai][0][m][n]; }
    }
};
struct EpiY {
    DI void prefetch(const Unit&, LAS unsigned char*, int) const {}
    const bf16_t* Ucat; const float* dsk; bf16_t* zb;
    DI void operator()(const f32x4 (&acc)[2][2][4][2], const Unit& u, int wr, int wc, int fr, int fq) const {
        const int h0 = 8 * (fq & 1);
        const f32x4 dv0 = *(const f32x4*)(dsk + u.g * 16 + h0), dv1 = *(const f32x4*)(dsk + u.g * 16 + h0 + 4);
        EPI_ROWS { const int R = u.pm * BM + ai * HALF + wr * 64 + m * 16 + fr;
#pragma unroll
            for (int bj = 0; bj < 2; ++bj) { const int ncol = u.pn * BM + bj * HALF + 32 * wc + 8 * fq;
                const u32x4 ub = *(const u32x4*)(Ucat + ((size_t)(u.g * 1024 + R) * 640 + ncol));
                f32x4 y0 = acc[ai][bj][m][0], y1 = acc[ai][bj][m][1];
                y0[0] += dv0[0] * bf_lo(ub.x); y0[1] += dv0[1] * bf_hi(ub.x); y0[2] += dv0[2] * bf_lo(ub.y); y0[3] += dv0[3] * bf_hi(ub.y);
                y1[0] += dv1[0] * bf_lo(ub.z); y1[1] += dv1[1] * bf_hi(ub.z); y1[2] += dv1[2] * bf_lo(ub.w); y1[3] += dv1[3] * bf_hi(ub.w);
                u32x4 w; w.x = cvt_pk_bf16(fgelu_tanh(y0[0]), fgelu_tanh(y0[1])); w.y = cvt_pk_bf16(fgelu_tanh(y0[2]), fgelu_tanh(y0[3]));
                w.z = cvt_pk_bf16(fgelu_tanh(y1[0]), fgelu_tanh(y1[1])); w.w = cvt_pk_bf16(fgelu_tanh(y1[2]), fgelu_tanh(y1[3]));
                const int token = R * 32 + (ncol >> 4);
                *(u32x4*)(zb + (size_t)token * 512 + u.g * 16 + h0) = w; } }
    }
};
struct EpiGlu {
    DI void prefetch(const Unit& u, LAS unsigned char* lds, int wid) const {
        const int id = wid * 64 + lane_fresh(), row = id >> 1, seg = id & 1;
        __builtin_amdgcn_global_load_lds((const unsigned*)(SG + (size_t)(u.pm * BM + row) * 512 + u.pn * 128 + seg * 64), (LAS unsigned*)(lds + LDS_DUMMY + wid * 256), 4, 0, 0);
    }
    const float* bglu; const bf16_t* SG; bf16_t* cat;
    DI void operator()(const f32x4 (&acc)[2][2][4][2], const Unit& u, int wr, int wc, int fr, int fq) const {
        const int ch = u.pn * 128 + 32 * wc + 8 * fq;
        f32x4 bv[2], bg[2];
#pragma unroll
        for (int n = 0; n < 2; ++n) { bv[n] = *(const f32x4*)(bglu + ch + 4 * n); bg[n] = *(const f32x4*)(bglu + 512 + ch + 4 * n); }
        EPI_ROWS { const int row = u.pm * BM + ai * HALF + wr * 64 + m * 16 + fr;
            const f32x4 v0 = acc[ai][0][m][0] + bv[0], g0 = acc[ai][1][m][0] + bg[0], v1 = acc[ai][0][m][1] + bv[1], g1 = acc[ai][1][m][1] + bg[1];
            const u32x4 sg = *(const u32x4*)(SG + (size_t)row * 512 + ch);
            u32x4 w;
            w.x = cvt_pk_bf16(v0[0] * fsigmoid(g0[0]) * bf_lo(sg.x), v0[1] * fsigmoid(g0[1]) * bf_hi(sg.x)); w.y = cvt_pk_bf16(v0[2] * fsigmoid(g0[2]) * bf_lo(sg.y), v0[3] * fsigmoid(g0[3]) * bf_hi(sg.y));
            w.z = cvt_pk_bf16(v1[0] * fsigmoid(g1[0]) * bf_lo(sg.z), v1[1] * fsigmoid(g1[1]) * bf_hi(sg.z)); w.w = cvt_pk_bf16(v1[2] * fsigmoid(g1[2]) * bf_lo(sg.w), v1[3] * fsigmoid(g1[3]) * bf_hi(sg.w));
            *(u32x4*)(cat + (size_t)row * 1024 + ch) = w; }
    }
};
struct EpiOut {
    DI void prefetch(const Unit& u, LAS unsigned char* lds, int wid) const {
        const int tid = wid * 64 + lane_fresh();
#pragma unroll
        for (int i = 0; i < 2; ++i) { const int id = tid + 512 * i, row = id >> 2, seg = id & 3;
            __builtin_amdgcn_global_load_lds((const unsigned*)(hin + (size_t)(u.pm * BM + row) * 1024 + u.pn * BM + seg * 64), (LAS unsigned*)(lds + LDS_DUMMY + wid * 256), 4, 0, 0); }
    }
    const bf16_t* hin; bf16_t* hb; float* ss;
    DI void operator()(const f32x4 (&acc)[2][2][4][2], const Unit& u, int wr, int wc, int fr, int fq) const {
        EPI_ROWS { const int row = u.pm * BM + ai * HALF + wr * 64 + m * 16 + fr; float s = 0.f;
#pragma unroll
            for (int bj = 0; bj < 2; ++bj) { const size_t off = (size_t)row * 1024 + u.pn * BM + bj * HALF + 32 * wc + 8 * fq;
                const u32x4 rw = *(const u32x4*)(hin + off); f32x4 h0 = acc[ai][bj][m][0], h1_ = acc[ai][bj][m][1];
                h0[0] += bf_lo(rw.x); h0[1] += bf_hi(rw.x); h0[2] += bf_lo(rw.y); h0[3] += bf_hi(rw.y); h1_[0] += bf_lo(rw.z); h1_[1] += bf_hi(rw.z); h1_[2] += bf_lo(rw.w); h1_[3] += bf_hi(rw.w);
                u32x4 w; w.x = cvt_pk_bf16(h0[0], h0[1]); w.y = cvt_pk_bf16(h0[2], h0[3]); w.z = cvt_pk_bf16(h1_[0], h1_[1]); w.w = cvt_pk_bf16(h1_[2], h1_[3]); *(u32x4*)(hb + off) = w;
                s += ((h0[0] * h0[0] + h0[1] * h0[1]) + (h0[2] * h0[2] + h0[3] * h0[3])) + ((h1_[0] * h1_[0] + h1_[1] * h1_[1]) + (h1_[2] * h1_[2] + h1_[3] * h1_[3])); }
            s += __shfl_xor(s, 16); s += __shfl_xor(s, 32);
            if (fq == 0) atomicAdd(ss + row, s); }
    }
};
struct EpiPle {
    DI void prefetch(const Unit& u, LAS unsigned char* lds, int wid) const {
        const int tid = wid * 64 + lane_fresh();
#pragma unroll
        for (int i = 0; i < 2; ++i) { const int id = tid + 512 * i, row = id >> 2, seg = id & 3; const size_t off = (size_t)(u.pm * BM + row) * 1024 + u.pn * BM + seg * 64;
            __builtin_amdgcn_global_load_lds((const unsigned*)(h1 + off), (LAS unsigned*)(lds + LDS_DUMMY + wid * 256), 4, 0, 0);
            __builtin_amdgcn_global_load_lds((const unsigned*)(pp + off), (LAS unsigned*)(lds + LDS_DUMMY + wid * 256), 4, 0, 0); }
        if (wid < 4) __builtin_amdgcn_global_load_lds((const unsigned*)(ss1 + u.pm * BM + tid), (LAS unsigned*)(lds + LDS_DUMMY + wid * 256), 4, 0, 0);
    }
    const float* ss1; const bf16_t* h1; float* h; const bf16_t* pp; bf16_t* hb; float* ss2; int last;
    DI void operator()(const f32x4 (&acc)[2][2][4][2], const Unit& u, int wr, int wc, int fr, int fq) const {
        float rsv[2][4];
        EPI_ROWS_NF rsv[ai][m] = ss1[u.pm * BM + ai * HALF + wr * 64 + m * 16 + fr];
        EPI_ROWS_NF rsv[ai][m] = rsqrtf(rsv[ai][m] * (1.f / 1024.f) + 1e-6f);
        EPI_ROWS { const int row = u.pm * BM + ai * HALF + wr * 64 + m * 16 + fr; float s = 0.f;
            const float rs = rsv[ai][m];
#pragma unroll
            for (int bj = 0; bj < 2; ++bj) { const size_t off = (size_t)row * 1024 + u.pn * BM + bj * HALF + 32 * wc + 8 * fq;
                const f32x4 a0 = acc[ai][bj][m][0] * rs, a1 = acc[ai][bj][m][1] * rs; const u32x4 pw = *(const u32x4*)(pp + off); const u32x4 hw = *(const u32x4*)(h1 + off);
                f32x4 h0, h1_;
                h0[0] = bf_lo(hw.x) + fsigmoid(a0[0]) * bf_lo(pw.x); h0[1] = bf_hi(hw.x) + fsigmoid(a0[1]) * bf_hi(pw.x); h0[2] = bf_lo(hw.y) + fsigmoid(a0[2]) * bf_lo(pw.y); h0[3] = bf_hi(hw.y) + fsigmoid(a0[3]) * bf_hi(pw.y);
                h1_[0] = bf_lo(hw.z) + fsigmoid(a1[0]) * bf_lo(pw.z); h1_[1] = bf_hi(hw.z) + fsigmoid(a1[1]) * bf_hi(pw.z); h1_[2] = bf_lo(hw.w) + fsigmoid(a1[2]) * bf_lo(pw.w); h1_[3] = bf_hi(hw.w) + fsigmoid(a1[3]) * bf_hi(pw.w);
                if (last) { *(f32x4*)(h + off) = h0; *(f32x4*)(h + off + 4) = h1_; }
                if (!last) { u32x4 w; w.x = cvt_pk_bf16(h0[0], h0[1]); w.y = cvt_pk_bf16(h0[2], h0[3]); w.z = cvt_pk_bf16(h1_[0], h1_[1]); w.w = cvt_pk_bf16(h1_[2], h1_[3]); *(u32x4*)(hb + off) = w;
                    s += ((h0[0] * h0[0] + h0[1] * h0[1]) + (h0[2] * h0[2] + h0[3] * h0[3])) + ((h1_[0] * h1_[0] + h1_[1] * h1_[1]) + (h1_[2] * h1_[2] + h1_[3] * h1_[3])); } }
            if (!last) { s += __shfl_xor(s, 16); s += __shfl_xor(s, 32); if (fq == 0) atomicAdd(ss2 + row, s); } }
    }
};
struct EpiPP {
    DI void prefetch(const Unit&, LAS unsigned char*, int) const {}
    bf16_t* pp;
    DI void operator()(const f32x4 (&acc)[2][2][4][2], const Unit& u, int wr, int wc, int fr, int fq) const {
        EPI_ROWS { const int row = u.pm * BM + ai * HALF + wr * 64 + m * 16 + fr;
#pragma unroll
            for (int bj = 0; bj < 2; ++bj) { const size_t off = (size_t)row * 1024 + u.pn * BM + bj * HALF + 32 * wc + 8 * fq; const f32x4 a0 = acc[ai][bj][m][0] * 1.0f, a1 = acc[ai][bj][m][1] * 1.0f;
                u32x4 w; w.x = cvt_pk_bf16(a0[0], a0[1]); w.y = cvt_pk_bf16(a0[2], a0[3]); w.z = cvt_pk_bf16(a1[0], a1[1]); w.w = cvt_pk_bf16(a1[2], a1[3]); *(u32x4*)(pp + off) = w; } }
    }
};

DI void attn_item(int item, const bf16_t* Q, const bf16_t* Kb, const bf16_t* VT, const bf16_t* GA, bf16_t* cat, int lane, LAS float* patch) {
    const int qb = item & 127, h = (item >> 7) & 7, b = item >> 10;
    const int q0 = qb * 32, hf = lane >> 5, ql = lane & 31;
    const bf16_t* qp = Q + (size_t)(b * SEQ + q0 + ql) * 512 + h * 64 + 8 * hf;
    bf16x8 qf[4];
#pragma unroll
    for (int s = 0; s < 4; ++s) qf[s] = *(const bf16x8*)(qp + 16 * s);
    const int kperm = (ql & 16) | ((ql & 4) << 1) | ((ql & 8) >> 1) | (ql & 3);
    const bf16_t* kbase = Kb + (((size_t)(b * 8 + h)) << 18) + kperm * 16 + 8 * hf;
    const bf16_t* vbase = VT + (((size_t)(b * 8 + h)) << 18) + ql * 16 + 8 * hf;
    f32x16 o0, o1;
#pragma unroll
    for (int i = 0; i < 16; ++i) { o0[i] = 0.f; o1[i] = 0.f; }
    float cprod = 1.f;
    bf16x8 kf[4], vf[2][2];
    { const bf16_t* kp = kbase + (size_t)(q0 >> 5) * 2048; const bf16_t* vp = vbase + (size_t)(q0 >> 5) * 2048;
#pragma unroll
      for (int s = 0; s < 4; ++s) kf[s] = *(const bf16x8*)(kp + 512 * s);
#pragma unroll
      for (int s = 0; s < 2; ++s) { vf[s][0] = *(const bf16x8*)(vp + 512 * s); vf[s][1] = *(const bf16x8*)(vp + 1024 + 512 * s); } }
#define ATT_TILE(DIAG) { \
        f32x16 st; _Pragma("unroll") for (int i = 0; i < 16; ++i) st[i] = 0.f; \
        _Pragma("unroll") for (int s = 0; s < 4; ++s) st = __builtin_amdgcn_mfma_f32_32x32x16_bf16(kf[s], qf[s], st, 0, 0, 0); \
        const int kn = kb >= 32 ? kb - 32 : 0; const bf16_t* kp = kbase + (size_t)(kn >> 5) * 2048; const bf16_t* vp = vbase + (size_t)(kn >> 5) * 2048; \
        bf16x8 kf2[4], vf2[2][2]; \
        _Pragma("unroll") for (int s = 0; s < 4; ++s) kf2[s] = *(const bf16x8*)(kp + 512 * s); \
        _Pragma("unroll") for (int s = 0; s < 2; ++s) { vf2[s][0] = *(const bf16x8*)(vp + 512 * s); vf2[s][1] = *(const bf16x8*)(vp + 1024 + 512 * s); } \
        float sg[16], ns[16]; float PA = 1.f, PB = 1.f; \
        _Pragma("unroll") for (int r = 0; r < 16; ++r) { \
            const float t = st[r] * -1.4426950408889634f; \
            const float e = __builtin_amdgcn_exp2f(fminf(t, 115.0f));        \
            float sgm = __builtin_amdgcn_rcpf(1.0f + e);                     \
            float nsv = e * sgm;                                             \
            if (DIAG) { const int koff = 16 * (r >> 3) + 8 * hf + (r & 7); if (koff >= ql) { sgm = 0.f; nsv = 1.f; } } \
            sg[r] = sgm; ns[r] = nsv; if (r < 8) PA *= nsv; else PB *= nsv; } \
        const float PAo = __shfl_xor(PA, 32), PBo = __shfl_xor(PB, 32); \
        float runA = cprod * (PB * PBo) * (hf == 0 ? PAo : 1.f); float runB = cprod * (hf == 0 ? PBo : 1.f); \
        float w[16]; \
        _Pragma("unroll") for (int r = 7; r >= 0; --r) { w[r] = sg[r] * runA; runA *= ns[r]; } \
        _Pragma("unroll") for (int r = 15; r >= 8; --r) { w[r] = sg[r] * runB; runB *= ns[r]; } \
        cprod *= (PA * PAo) * (PB * PBo); \
        _Pragma("unroll") for (int s = 0; s < 2; ++s) { \
            u32x4 pw; pw.x = cvt_pk_bf16(w[8 * s], w[8 * s + 1]); pw.y = cvt_pk_bf16(w[8 * s + 2], w[8 * s + 3]); pw.z = cvt_pk_bf16(w[8 * s + 4], w[8 * s + 5]); pw.w = cvt_pk_bf16(w[8 * s + 6], w[8 * s + 7]); \
            const bf16x8 wf = __builtin_bit_cast(bf16x8, pw); \
            o0 = __builtin_amdgcn_mfma_f32_32x32x16_bf16(wf, vf[s][0], o0, 0, 0, 0); \
            o1 = __builtin_amdgcn_mfma_f32_32x32x16_bf16(wf, vf[s][1], o1, 0, 0, 0); } \
        _Pragma("unroll") for (int s = 0; s < 4; ++s) kf[s] = kf2[s]; \
        _Pragma("unroll") for (int s = 0; s < 2; ++s) { vf[s][0] = vf2[s][0]; vf[s][1] = vf2[s][1]; } \
        kb -= 32; }
    { int kb = q0;
      ATT_TILE(true)
      if (kb >= 0 && !__all(cprod < 1.17549435e-38f)) {
          _Pragma("nounroll") for (;;) { ATT_TILE(false) if (kb < 0 || __all(cprod < 1.17549435e-38f)) break; } } }
#undef ATT_TILE
#pragma unroll
    for (int r = 0; r < 16; ++r) { const int q = 8 * (r >> 2) + 4 * hf + (r & 3); patch[q * 68 + ql] = o0[r]; patch[q * 68 + 32 + ql] = o1[r]; }
    asm volatile("s_waitcnt lgkmcnt(0)" ::: "memory");
    { const int q = lane >> 1, dh = 32 * (lane & 1); const size_t tok = (size_t)(b * SEQ + q0 + q);
      const u32x4* gp = (const u32x4*)(GA + tok * 512 + h * 64 + dh); u32x4* cp = (u32x4*)(cat + tok * 1024 + 512 + h * 64 + dh);
#pragma unroll
      for (int i = 0; i < 4; ++i) { const u32x4 gw = gp[i]; const f32x4 a0 = *(const LAS f32x4*)(patch + q * 68 + dh + 8 * i), a1 = *(const LAS f32x4*)(patch + q * 68 + dh + 8 * i + 4);
          u32x4 w; w.x = cvt_pk_bf16(a0[0] * bf_lo(gw.x), a0[1] * bf_hi(gw.x)); w.y = cvt_pk_bf16(a0[2] * bf_lo(gw.y), a0[3] * bf_hi(gw.y));
          w.z = cvt_pk_bf16(a1[0] * bf_lo(gw.z), a1[1] * bf_hi(gw.z)); w.w = cvt_pk_bf16(a1[2] * bf_lo(gw.w), a1[3] * bf_hi(gw.w));
          cp[i] = w; } }
    asm volatile("s_waitcnt lgkmcnt(0)" ::: "memory");
}

DI void sincos_d(double ang, double& s, double& c) {
    const double k = rint(ang * 0.63661977236758134308);
    double y = fma(-k, 1.5707963267948966192, ang); y = fma(-k, 6.123233995736766e-17, y);
    const double y2 = y * y;
    const double sp = y * (1.0 - y2 * (1.0 / 6.0) * (1.0 - y2 * (1.0 / 20.0) * (1.0 - y2 * (1.0 / 42.0) * (1.0 - y2 * (1.0 / 72.0) * (1.0 - y2 * (1.0 / 110.0) * (1.0 - y2 * (1.0 / 156.0) * (1.0 - y2 * (1.0 / 210.0) * (1.0 - y2 * (1.0 / 272.0)))))))));
    const double cp = 1.0 - y2 * (1.0 / 2.0) * (1.0 - y2 * (1.0 / 12.0) * (1.0 - y2 * (1.0 / 30.0) * (1.0 - y2 * (1.0 / 56.0) * (1.0 - y2 * (1.0 / 90.0) * (1.0 - y2 * (1.0 / 132.0) * (1.0 - y2 * (1.0 / 182.0) * (1.0 - y2 * (1.0 / 240.0))))))));
    const int q = (int)((long long)k & 3);
    s = (q == 0) ? sp : (q == 1) ? cp : (q == 2) ? -sp : -cp;
    c = (q == 0) ? cp : (q == 1) ? -sp : (q == 2) ? -cp : sp;
}
DI double exp_d(double x) {
    const double k = rint(x * 1.4426950408889634074); const double r = fma(-k, 0.69314718055994530942, x);
    double t = 1.0;
#pragma unroll
    for (int i = 14; i >= 1; --i) t = 1.0 + t * r * (1.0 / (double)i);
    return ldexp(t, (int)k);
}

template <int MODE>
DI int colmap(int n) {
    if (MODE == 1) { const int pn = n >> 8, r = n & 255, bj = r >> 7, wc = (r >> 5) & 3, c = r & 31; return 256 * pn + 64 * wc + 32 * bj + c; }
    if (MODE == 2) { const int pn = n >> 8, r = n & 255; return r < 128 ? 128 * pn + r : 512 + 128 * pn + (r - 128); }
    if (MODE == 5) { const int rho = n & 31, nn = rho >> 4, i = rho & 15; const int m2 = (n & ~31) + 8 * (i >> 2) + 4 * nn + (i & 3); const int pn = m2 >> 8, r = m2 & 255, bj = r >> 7, wc = (r >> 5) & 3, c = r & 31; return 256 * pn + 64 * wc + 32 * bj + c; }
    if (MODE == 4) { const int rho = n & 31, nn = rho >> 4, i = rho & 15; const int m2 = (n & ~31) + 8 * (i >> 2) + 4 * nn + (i & 3); const int pn = m2 >> 8, r = m2 & 255; return r < 128 ? 128 * pn + r : 512 + 128 * pn + (r - 128); }
    if (MODE == 3) { const int rho = n & 31, nn = rho >> 4, i = rho & 15; return (n & ~31) + 8 * (i >> 2) + 4 * nn + (i & 3); }
    return n;
}
template <int MODE>
DI void transpose_w(const float* W, int K, int N, bf16_t* WT, const float* kscale, LAS float* scr, int gw, int nw, int lane) {
    const int nblk = N >> 5, items = (K >> 6) * nblk;
    for (int item = gw; item < items; item += nw) {
        const int kb = item / nblk, nb = item - kb * nblk, k0 = 64 * kb, n0 = 32 * nb, colL = colmap<MODE>(n0 + (lane & 31));
        float tv[32];
#pragma unroll
        for (int i = 0; i < 32; ++i) { const int kk = 2 * i + (lane >> 5); tv[i] = W[(size_t)(k0 + kk) * N + colL]; }
        if (kscale) {
#pragma unroll
            for (int i = 0; i < 32; ++i) tv[i] *= kscale[k0 + 2 * i + (lane >> 5)]; }
#pragma unroll
        for (int i = 0; i < 32; ++i) { const int kk = 2 * i + (lane >> 5); scr[kk * 33 + (lane & 31)] = tv[i]; }
        asm volatile("s_waitcnt lgkmcnt(0)" ::: "memory");
        const int cc = lane & 7;
#pragma unroll
        for (int j = 0; j < 4; ++j) { const int n = (lane >> 3) + 8 * j; const LAS float* sp = scr + (8 * cc) * 33 + n;
            u32x4 o; o.x = cvt_pk_bf16(sp[0 * 33], sp[1 * 33]); o.y = cvt_pk_bf16(sp[2 * 33], sp[3 * 33]); o.z = cvt_pk_bf16(sp[4 * 33], sp[5 * 33]); o.w = cvt_pk_bf16(sp[6 * 33], sp[7 * 33]);
            *(u32x4*)(WT + (size_t)(n0 + n) * K + k0 + 8 * cc) = o; }
        asm volatile("s_waitcnt lgkmcnt(0)" ::: "memory");
    }
}

DI void ssm_prep(const Params& P, int lg, int qd, LAS unsigned char* lds, int tid) {
    LAS float* apr = (LAS float*)lds;
    LAS float* api = apr + 33 * 64;
    LAS float* bbr = api + 33 * 64;
    LAS float* bbi = bbr + 1024;
    LAS float* cr = bbi + 1024;
    LAS float* ci = cr + 1024;
    LAS float* ktab = ci + 1024;
    LAS float* part = ktab + 8192;
    LAS double* fz = (LAS double*)(part + 8192);
    const double dt = exp_d((double)P.log_dt[lg]);
    for (int idx = tid; idx < 33 * 64; idx += 512) {
        const int tau = idx >> 6, p = idx & 63;
        const double lr = (double)P.a_re[lg * 64 + p], li = (double)P.a_im[lg * 64 + p];
        const double mag = exp_d(lr * dt * (double)tau); double s, c; sincos_d(li * dt * (double)tau, s, c);
        apr[idx] = (float)(mag * c); api[idx] = (float)(mag * s);
        if (tau == 32 && qd == 0) { float* a32 = (float*)(P.ws + WS_MISC) + (size_t)(lg * 64 + p) * 2; a32[0] = (float)(mag * c); a32[1] = (float)(mag * s); }
        if (tau == 1) {
            const double nr = mag * c - 1.0, ni = mag * s, den = lr * lr + li * li;
            fz[2 * p] = (nr * lr + ni * li) / den; fz[2 * p + 1] = (ni * lr - nr * li) / den; }
    }
    for (int idx = tid; idx < 1024; idx += 512) { cr[idx] = P.c_re[(size_t)lg * 1024 + idx]; ci[idx] = P.c_im[(size_t)lg * 1024 + idx]; }
    __syncthreads();
    for (int idx = tid; idx < 1024; idx += 512) { const int p = idx >> 4; const double fr_ = fz[2 * p], fi_ = fz[2 * p + 1];
        const double br = (double)P.b_re[(size_t)lg * 1024 + idx], bi = (double)P.b_im[(size_t)lg * 1024 + idx];
        bbr[idx] = (float)(fr_ * br - fi_ * bi); bbi[idx] = (float)(fr_ * bi + fi_ * br); }
    __syncthreads();
    {
        const int hh = tid & 255, hp = hh >> 4, h = hh & 15, ph = tid >> 8;
        float cbr[32], cbi[32];
#pragma unroll
        for (int i = 0; i < 32; ++i) { const int p = 32 * ph + i; const float c_r = cr[h * 64 + p], c_i = ci[h * 64 + p], x_r = bbr[p * 16 + hp], x_i = bbi[p * 16 + hp];
            cbr[i] = c_r * x_r - c_i * x_i; cbi[i] = c_r * x_i + c_i * x_r; }
        for (int tau = 0; tau < 32; ++tau) { float acc = 0.f;
#pragma unroll
            for (int i = 0; i < 32; ++i) acc += apr[tau * 64 + 32 * ph + i] * cbr[i] - api[tau * 64 + 32 * ph + i] * cbi[i];
            if (ph) part[tau * 256 + hh] = acc; else ktab[tau * 256 + hh] = acc; }
    }
    __syncthreads();
    for (int o = tid; o < 8192; o += 512) ktab[o] += part[o];
    __syncthreads();
    bf16_t* W1 = (bf16_t*)(P.ws + WS_W1) + (size_t)lg * 256 * 512;
    for (int it = tid; it < 128 * 64; it += 512) {
        const int n = 128 * qd + (it >> 6), k8 = it & 63, s = k8 >> 1, hp0 = (k8 & 1) * 8; float v[8];
#pragma unroll
        for (int i = 0; i < 8; ++i) {
            if (n < 128) { const int p = n & 63; const float ar = apr[(31 - s) * 64 + p], ai = api[(31 - s) * 64 + p], xr = bbr[p * 16 + hp0 + i], xi = bbi[p * 16 + hp0 + i];
                v[i] = n < 64 ? ar * xr - ai * xi : ar * xi + ai * xr; }
            else v[i] = 0.f;
        }
        u32x4 o; o.x = cvt_pk_bf16(v[0], v[1]); o.y = cvt_pk_bf16(v[2], v[3]); o.z = cvt_pk_bf16(v[4], v[5]); o.w = cvt_pk_bf16(v[6], v[7]);
        *(u32x4*)(W1 + (size_t)n * 512 + k8 * 8) = o;
    }
    bf16_t* TP = (bf16_t*)(P.ws + WS_TOEP) + (size_t)lg * 512 * 640;
    for (int it = tid; it < 256 * 80; it += 512) {
        const int n = 256 * qd + it / 80, k8 = it % 80, nl = colmap<3>(n), t = nl >> 4, h = nl & 15; float v[8];
        if (k8 < 64) { const int s = k8 >> 1, hp0 = (k8 & 1) * 8;
#pragma unroll
            for (int i = 0; i < 8; ++i) v[i] = (s <= t) ? ktab[(t - s) * 256 + (hp0 + i) * 16 + h] : 0.f;
        } else if (k8 < 72) {
#pragma unroll
            for (int i = 0; i < 8; ++i) { const int p = (k8 - 64) * 8 + i; v[i] = cr[h * 64 + p] * apr[(t + 1) * 64 + p] - ci[h * 64 + p] * api[(t + 1) * 64 + p]; }
        } else {
#pragma unroll
            for (int i = 0; i < 8; ++i) { const int p = (k8 - 72) * 8 + i; v[i] = -(cr[h * 64 + p] * api[(t + 1) * 64 + p] + ci[h * 64 + p] * apr[(t + 1) * 64 + p]); }
        }
        u32x4 o; o.x = cvt_pk_bf16(v[0], v[1]); o.y = cvt_pk_bf16(v[2], v[3]); o.z = cvt_pk_bf16(v[4], v[5]); o.w = cvt_pk_bf16(v[6], v[7]);
        *(u32x4*)(TP + (size_t)n * 640 + k8 * 8) = o;
    }
    __syncthreads();
}

#define XB_TMO      128
#define XB_XCNT(j)  (256  + 64 * (j))
#define XB_XSUB(j)  (1280 + 64 * (j))
#define XB_XGEN(j)  (2304 + 64 * (j))
#define XB_TOP      3328
#define XB_TOPGEN   3392
#define XCD_BAR_WORDS 3456
#define XB_SPIN_CAP (1u << 18)
DI unsigned xb_ld(unsigned* p) { return __hip_atomic_load(p, __ATOMIC_RELAXED, __HIP_MEMORY_SCOPE_AGENT); }
DI unsigned xb_add(unsigned* p, unsigned v) { return __hip_atomic_fetch_add(p, v, __ATOMIC_RELAXED, __HIP_MEMORY_SCOPE_AGENT); }
DI unsigned xb_xcc_id() { return (unsigned)__builtin_amdgcn_s_getreg((3 << 11) | 20) & 0xFu; }
#define XB_SPIN(cond, bar) do { unsigned _sp = 0; while (cond) { __builtin_amdgcn_s_sleep(1); \
    if ((++_sp & 255u) == 0u) { if (xb_ld(&(bar)[XB_TMO])) break; if (_sp > XB_SPIN_CAP) { atomicAdd(&(bar)[XB_TMO], 1u); break; } } } } while (0)
DI void xcd_barrier_complete(unsigned* bar, unsigned x, unsigned G, unsigned& nloc, unsigned& nx) {
    unsigned sum, cnt, mine, sp = 0u;
    for (;;) {
        sum = 0u; cnt = 0u; mine = 0u;
#pragma unroll 1
        for (unsigned j = 0; j < 16; ++j) { const unsigned cj = xb_ld(&bar[XB_XCNT(j)]); sum += cj; cnt += (cj > 0u) ? 1u : 0u; mine = (j == x) ? cj : mine; }
        if (sum == G) break;
        __builtin_amdgcn_s_sleep(1);
        if ((++sp & 255u) == 0u) { if (xb_ld(&bar[XB_TMO])) break; if (sp > XB_SPIN_CAP) { atomicAdd(&bar[XB_TMO], 1u); break; } }
    }
    nloc = mine > 0u ? mine : 1u; nx = cnt > 0u ? cnt : 1u;
}
DI void xcd_barrier(unsigned* bar, volatile LAS unsigned* st, const int wid) {
    asm volatile("" : "+s"(bar));
    asm volatile("s_waitcnt vmcnt(0)" ::: "memory");
    __syncthreads();
    if (wid == 0 && lane_fresh() == 0) {
        const unsigned x = xb_xcc_id();
        __builtin_amdgcn_s_waitcnt(0);
        const unsigned nloc = st[0], nx = st[1];
        const unsigned old = xb_add(&bar[XB_XSUB(x)], 1u);
        const unsigned gen = old / nloc;
        if (old + 1u == (gen + 1u) * nloc) {
            __builtin_amdgcn_fence(__ATOMIC_RELEASE, "agent");
            asm volatile("s_waitcnt vmcnt(0)" ::: "memory");
            const unsigned og = xb_add(&bar[XB_TOP], 1u);
            const unsigned tg = og / nx;
            if (og + 1u == (tg + 1u) * nx) xb_add(&bar[XB_TOPGEN], 1u);
            else XB_SPIN(xb_ld(&bar[XB_TOPGEN]) == tg, bar);
            __builtin_amdgcn_fence(__ATOMIC_ACQUIRE, "agent");
            xb_add(&bar[XB_XGEN(x)], 1u);
            asm volatile("s_waitcnt vmcnt(0)" ::: "memory");
        } else {
            XB_SPIN(xb_ld(&bar[XB_XGEN(x)]) == gen, bar);
            __builtin_amdgcn_fence(__ATOMIC_ACQUIRE, "agent");
            asm volatile("s_waitcnt vmcnt(0)" ::: "memory");
        }
    }
    __syncthreads();
}

__global__ void __launch_bounds__(512) mega(Params P) {
    extern __shared__ __attribute__((aligned(16))) unsigned char shm[];
    LAS unsigned char* lds = (LAS unsigned char*)shm;
    cg::grid_group grid = cg::this_grid();
    const int wid = __builtin_amdgcn_readfirstlane(threadIdx.x >> 6);
    const int G = gridDim.x, c = blockIdx.x;
    const int gthreads = G * 512;
#define LANE lane_fresh()
#define TID (wid * 64 + lane_fresh())
#define GTID (c * 512 + wid * 64 + lane_fresh())
    unsigned char* ws = P.ws;
    float* ssb = (float*)(ws + WS_MISC + 65536);
    bf16_t* hbA = (bf16_t*)(ws + WS_HBA);
    bf16_t* Ucat = (bf16_t*)(ws + WS_UCAT);
    bf16_t* SG = (bf16_t*)(ws + WS_SGGA); bf16_t* GA = SG + (size_t)T * 512; bf16_t* hbB = SG;
    bf16_t* Qb = (bf16_t*)(ws + WS_QK); bf16_t* Kb = Qb + (size_t)T * 512; bf16_t* pp = Qb;
    bf16_t* VT = (bf16_t*)(ws + WS_VT); bf16_t* zb = (bf16_t*)(ws + WS_ZB);
    bf16_t* cat = (bf16_t*)(ws + WS_CAT);
    float* Sbuf = (float*)(ws + WS_SBUF);
    bf16_t* pb = (bf16_t*)(ws + WS_PB);

    unsigned* bar = (unsigned*)(ws + WS_MISC + 786432);
    volatile LAS unsigned* xst = (volatile LAS unsigned*)(lds + STAGE_BYTES);
#define GSYNC() xcd_barrier(bar, xst, wid)
    if (wid == 0 && LANE == 0) { xst[0] = 0u; xst[1] = 0u; (void)xb_add(&bar[XB_XCNT(xb_xcc_id())], 1u); }
    if (P.ws == nullptr) grid.sync();
    for (int rep = 0; rep < REP_P0; ++rep) {
    const int role = (c >> 3) & 1, sc = ((c >> 4) << 3) | (c & 7), SG_ = G >> 1;
    const int sthreads = SG_ * 512;
    if (role == 0) ssm_prep(P, sc >> 1, sc & 1, lds, TID);
    { const int lane = LANE; LAS float* scr = (LAS float*)lds + wid * (64 * 33); const int l = role == 0 ? 1 : 0;
    for (int i = sc * 512 + TID; i < 3 * T; i += SG_ * 512) if (role == 1) ssb[T + i] = 0.f;
    {
        transpose_w<5>(P.w_in + (size_t)l * 1024 * 3072, 1024, 3072, (bf16_t*)(ws + WS_WIN) + (size_t)l * 3072 * 1024, P.mix_g + l * 1024, scr, sc * 8 + wid, SG_ * 8, lane);
        transpose_w<4>(P.w_glu + (size_t)l * 512 * 1024, 512, 1024, (bf16_t*)(ws + WS_WGLU) + (size_t)l * 1024 * 512, nullptr, scr, sc * 8 + wid, SG_ * 8, lane);
        transpose_w<3>(P.w_out + (size_t)l * 1024 * 1024, 1024, 1024, (bf16_t*)(ws + WS_WOUT) + (size_t)l * 1024 * 1024, nullptr, scr, sc * 8 + wid, SG_ * 8, lane);
        transpose_w<3>(P.w_pg + (size_t)l * 1024 * 1024, 1024, 1024, (bf16_t*)(ws + WS_WPG) + (size_t)l * 1024 * 1024, P.ple_g + l * 1024, scr, sc * 8 + wid, SG_ * 8, lane);
        transpose_w<3>(P.w_pp + (size_t)l * 256 * 1024, 256, 1024, (bf16_t*)(ws + WS_WPP) + (size_t)l * 1024 * 256, nullptr, scr, sc * 8 + wid, SG_ * 8, lane);
    } }
    if (role == 1)
    for (int row = (sc * 8 + wid) * 2; row < T; row += SG_ * 16) {
        const int lane = LANE;
        const f32x4* xr = (const f32x4*)(P.x + (size_t)row * 1024); f32x4 v[2][4];
#pragma unroll
        for (int r2 = 0; r2 < 2; ++r2)
#pragma unroll
            for (int j = 0; j < 4; ++j) v[r2][j] = xr[r2 * 256 + lane + 64 * j];
#pragma unroll
        for (int r2 = 0; r2 < 2; ++r2) { float s = 0.f;
#pragma unroll
            for (int j = 0; j < 4; ++j) { const f32x4 q = v[r2][j]; s += (q[0] * q[0] + q[1] * q[1]) + (q[2] * q[2] + q[3] * q[3]);
                u32x2 w; w.x = cvt_pk_bf16(q[0], q[1]); w.y = cvt_pk_bf16(q[2], q[3]); *(u32x2*)(hbA + (size_t)(row + r2) * 1024 + (lane + 64 * j) * 4) = w; }
#pragma unroll
            for (int o = 1; o < 64; o <<= 1) s += __shfl_xor(s, o);
            if (lane == 0) ssb[row + r2] = s; }
    }
    { const size_t pbase = (size_t)(role == 0 ? 1 : 0) * T * 256 / 8, pend = pbase + (size_t)T * 256 / 8;
    for (size_t i = pbase + sc * 512 + TID; i < pend; i += (size_t)4 * sthreads) {
        f32x4 a[4], b[4];
#pragma unroll
        for (int q = 0; q < 4; ++q) { const size_t ii = i + (size_t)q * sthreads; if (ii < pend) { a[q] = ((const f32x4*)P.p)[2 * ii]; b[q] = ((const f32x4*)P.p)[2 * ii + 1]; } }
#pragma unroll
        for (int q = 0; q < 4; ++q) { const size_t ii = i + (size_t)q * sthreads; if (ii < pend) {
            u32x4 o; o.x = cvt_pk_bf16(a[q][0], a[q][1]); o.y = cvt_pk_bf16(a[q][2], a[q][3]); o.z = cvt_pk_bf16(b[q][0], b[q][1]); o.w = cvt_pk_bf16(b[q][2], b[q][3]);
            ((u32x4*)pb)[ii] = o; } }
    }
    }
    }
    if (wid == 0 && LANE == 0) { unsigned nloc, nx; xcd_barrier_complete(bar, xb_xcc_id(), G, nloc, nx); xst[0] = nloc; xst[1] = nx; }
    GSYNC();

    auto layer = [&](const int l) __attribute__((always_inline)) {
        float* ssIn = ssb + (size_t)(2 * l) * T; float* ssMid = ssb + (size_t)(2 * l + 1) * T; float* ssNext = ssb + (size_t)(2 * l + 2 > 3 ? 3 : 2 * l + 2) * T;
        { Gemm g{hbA, (const bf16_t*)(ws + WS_WIN) + (size_t)l * 3072 * 1024, 1024, 1024, 1024, 0, 0};
          Order S; S.init(T / 256, 12, 1, G, c);
          EpiIn E{ssIn, Ucat, SG, GA, Qb, Kb, VT, P.q_g + l * 64, P.k_g + l * 64};
          for (int rep = 0; rep < REP_INPROJ; ++rep) gemm_phase(lds, g, S, E, wid); }
        GSYNC();
        { Gemm g{Ucat, (const bf16_t*)(ws + WS_W1) + (size_t)l * 32 * 256 * 512, 640, 512, 512, (size_t)1024 * 640, (size_t)256 * 512};
          Order S; S.init(4, 1, 32, G, c);
          EpiS E{Sbuf};
          for (int rep = 0; rep < REP_GEMMS; ++rep) gemm_phase(lds, g, S, E, wid); }
        if (c < 128) {
            asm volatile("s_waitcnt vmcnt(0)" ::: "memory"); __syncthreads();
            const int lane = LANE, seg = lane >> 4, pl = lane & 15;
            const int q_ = c >> 3, L_ = ((c & 7) * 4 + (q_ >> 2)) * 4 + (q_ & 3);
            const int pq = wid & 3, g = L_ >> 2, b = 2 * (L_ & 3) + (wid >> 2), p = pq * 16 + pl;
            const float* a32 = (const float*)(ws + WS_MISC) + (size_t)((l * 32 + g) * 64 + p) * 2; const float ar = a32[0], ai = a32[1];
            const size_t row0 = (size_t)g * 1024 + b * 128 + seg * 32;
            const float* __restrict__ Sp = Sbuf + row0 * 128 + p;
            float sr[32], si[32];
#pragma unroll
            for (int j = 0; j < 32; ++j) { sr[j] = Sp[(size_t)j * 128]; si[j] = Sp[(size_t)j * 128 + 64]; }
            float hr = 0.f, hi = 0.f, wr_ = 1.f, wi_ = 0.f;
#pragma unroll
            for (int j = 0; j < 32; ++j) { const float nr = ar * hr - ai * hi + sr[j], ni = ar * hi + ai * hr + si[j]; hr = nr; hi = ni;
                const float xr = ar * wr_ - ai * wi_, xi = ar * wi_ + ai * wr_; wr_ = xr; wi_ = xi; }
            const float e0r = __shfl(hr, pl), e0i = __shfl(hi, pl), e1r = __shfl(hr, pl + 16), e1i = __shfl(hi, pl + 16), e2r = __shfl(hr, pl + 32), e2i = __shfl(hi, pl + 32);
            const float h1r = e0r, h1i = e0i;
            const float h2r = wr_ * h1r - wi_ * h1i + e1r, h2i = wr_ * h1i + wi_ * h1r + e1i;
            const float h3r = wr_ * h2r - wi_ * h2i + e2r, h3i = wr_ * h2i + wi_ * h2r + e2i;
            const float cinr = seg == 0 ? 0.f : seg == 1 ? h1r : seg == 2 ? h2r : h3r, cini = seg == 0 ? 0.f : seg == 1 ? h1i : seg == 2 ? h2i : h3i;
            bf16_t* __restrict__ Up = Ucat + row0 * 640 + 512 + p;
            hr = 0.f; hi = 0.f; float cr_ = cinr, ci_ = cini;
#pragma unroll
            for (int j = 0; j < 32; ++j) {
                const unsigned pk = cvt_pk_bf16(hr + cr_, hi + ci_);
                Up[(size_t)j * 640] = (bf16_t)(pk & 0xffffu); Up[(size_t)j * 640 + 64] = (bf16_t)(pk >> 16);
                const float nr = ar * hr - ai * hi + sr[j], ni = ar * hi + ai * hr + si[j]; hr = nr; hi = ni;
                const float xr = ar * cr_ - ai * ci_, xi = ar * ci_ + ai * cr_; cr_ = xr; ci_ = xi; }
            asm volatile("s_waitcnt vmcnt(0)" ::: "memory"); __syncthreads();
            { Gemm gy{Ucat, (const bf16_t*)(ws + WS_TOEP) + (size_t)l * 32 * 512 * 640, 640, 640, 640, (size_t)1024 * 640, (size_t)512 * 640};
              Order SY; SY.nwg = -1; SY.nM = g; SY.nN = L_ & 3; SY.lim = 2; SY.total = 0; SY.G = 0; SY.c = 0;
              EpiY EY{Ucat, P.dsk + l * 512, zb};
              for (int rep = 0; rep < REP_Y; ++rep) gemm_phase(lds, gy, SY, EY, wid); }
        }
        for (int rep = 0; rep < REP_ATTN; ++rep)
        {
            const int nit = c < 128 ? 1 : 7, base = c < 128 ? (c * 8 + wid) : 1024 + (c - 128) * 56 + wid;
            for (int j = 0; j < nit; ++j) attn_item(base + 8 * j, Qb, Kb, VT, GA, cat, LANE, (LAS float*)(lds + wid * 8704)); }
        GSYNC();
        { Gemm g{zb, (const bf16_t*)(ws + WS_WGLU) + (size_t)l * 1024 * 512, 512, 512, 512, 0, 0};
          Order S; S.init(T / 256, 4, 1, G, c);
          EpiGlu E{P.b_glu + l * 1024, SG, cat};
          for (int rep = 0; rep < REP_GLU; ++rep) gemm_phase(lds, g, S, E, wid); }
        { Gemm g{pb + (size_t)l * T * 256, (const bf16_t*)(ws + WS_WPP) + (size_t)l * 1024 * 256, 256, 256, 256, 0, 0};
          Order S; S.init(T / 256, 4, 1, G, c);
          EpiPP E{pp};
          for (int rep = 0; rep < REP_PP; ++rep) gemm_phase(lds, g, S, E, wid); }
        GSYNC();
        { Gemm g{cat, (const bf16_t*)(ws + WS_WOUT) + (size_t)l * 1024 * 1024, 1024, 1024, 1024, 0, 0};
          Order S; S.init(T / 256, 4, 1, G, c);
          EpiOut E{hbA, hbB, ssMid};
          gemm_phase(lds, g, S, E, wid); }
        GSYNC();
        { Gemm g{hbB, (const bf16_t*)(ws + WS_WPG) + (size_t)l * 1024 * 1024, 1024, 1024, 1024, 0, 0};
          Order S; S.init(T / 256, 4, 1, G, c);
          EpiPle E{ssMid, hbB, P.out, pp, hbA, ssNext, l == 1 ? 1 : 0};
          gemm_phase(lds, g, S, E, wid); }
        if (l == 0) GSYNC();
    };
    layer(0); layer(1);
}

extern "C" void kernel_launch(void* const* d_in, const int* in_sizes, int n_in, void* d_out, int out_size, void* d_ws, size_t ws_size, hipStream_t stream) {
    static int grid = 0;
    if (grid == 0) {
        if (n_in != 20 || ws_size < WS_END) { fprintf(stderr, "kernel_launch: unexpected inputs (n_in %d, ws %zu < %zu)\n", n_in, ws_size, (size_t)WS_END); grid = -1; return; }
        int dev = 0, cus = 0, per_cu = 0;
        hipGetDevice(&dev); hipDeviceGetAttribute(&cus, hipDeviceAttributeMultiprocessorCount, dev);
        if (hipFuncSetAttribute((const void*)mega, hipFuncAttributeMaxDynamicSharedMemorySize, LDS_BYTES) != hipSuccess) { fprintf(stderr, "hipFuncSetAttribute failed\n"); grid = -1; return; }
        if (hipOccupancyMaxActiveBlocksPerMultiprocessor(&per_cu, (const void*)mega, 512, LDS_BYTES) != hipSuccess || per_cu < 1) { fprintf(stderr, "occupancy query: %d\n", per_cu); per_cu = 1; }
        (void)hipGetLastError();
        if (cus < 256) { fprintf(stderr, "kernel_launch: built for a 256-CU device (static work partition over 256 workgroups), found %d CUs; nothing launched\n", cus); grid = -1; return; }
        grid = 256;
    }
    if (grid < 0) return;
    if (hipMemsetAsync((char*)d_ws + WS_MISC + 786432, 0, XCD_BAR_WORDS * 4, stream) != hipSuccess) { fprintf(stderr, "kernel_launch: hipMemsetAsync failed\n"); return; }
    Params P{};
    const float** pp = (const float**)&P;
    for (int i = 0; i < 20; ++i) pp[i] = (const float*)d_in[i];
    P.out = (float*)d_out; P.ws = (unsigned char*)d_ws;
    void* args[] = {&P};
    hipError_t e = hipLaunchCooperativeKernel((const void*)mega, dim3(grid), dim3(512), args, LDS_BYTES, stream);
    if (e != hipSuccess) fprintf(stderr, "cooperative launch failed: %s (grid %d)\n", hipGetErrorString(e), grid);
}
```

```cpp
#ifndef REP_P0
#define REP_P0 1
#define REP_INPROJ 1
#define REP_ATTN 1
#define REP_SCAN 1
#define REP_SYNC 1
#define REP_GEMMS 1
#define REP_PP 1
#define REP_Y 1
#define REP_GLU 1
#endif
#include <hip/hip_runtime.h>
#include <hip/hip_cooperative_groups.h>
#include <cstdio>
namespace cg = cooperative_groups;

#define LAS __attribute__((address_space(3)))
#define DI __device__ __forceinline__
typedef unsigned short bf16_t;
typedef short bf16x8 __attribute__((ext_vector_type(8)));
typedef float f32x4 __attribute__((ext_vector_type(4)));
typedef float f32x16 __attribute__((ext_vector_type(16)));
typedef unsigned u32x4 __attribute__((ext_vector_type(4)));
typedef unsigned u32x2 __attribute__((ext_vector_type(2)));

constexpr int T = 32768, SEQ = 4096;
constexpr int BM = 256, BK = 64, HALF = 128, HTB = HALF * BK * 2, STAGE_BYTES = 8 * HTB, NXCD = 8, WGM = 2;
constexpr int LDS_DUMMY = STAGE_BYTES + 16;
constexpr int LDS_BYTES = STAGE_BYTES + 16 + 2048;

constexpr size_t MBy = 1u << 20;
constexpr size_t WS_WIN = 0;
constexpr size_t WS_WGLU = WS_WIN + 12 * MBy;
constexpr size_t WS_WOUT = WS_WGLU + 2 * MBy;
constexpr size_t WS_WPG = WS_WOUT + 4 * MBy;
constexpr size_t WS_WPP = WS_WPG + 4 * MBy;
constexpr size_t WS_W1 = WS_WPP + 1 * MBy;
constexpr size_t WS_TOEP = WS_W1 + 16 * MBy;
constexpr size_t WS_MISC = WS_TOEP + 40 * MBy;
constexpr size_t WS_HBA = WS_MISC + 1 * MBy;
constexpr size_t WS_UCAT = WS_HBA + 64 * MBy;
constexpr size_t WS_SGGA = WS_UCAT + 40 * MBy;
constexpr size_t WS_QK = WS_SGGA + 64 * MBy;
constexpr size_t WS_VT = WS_QK + 64 * MBy;
constexpr size_t WS_CAT = WS_VT + 32 * MBy;
constexpr size_t WS_SBUF = WS_CAT + 64 * MBy;
constexpr size_t WS_PB = WS_SBUF + 16 * MBy;
constexpr size_t WS_ZB = WS_PB + 32 * MBy;
constexpr size_t WS_END = WS_ZB + 32 * MBy;

struct Params {
    const float *x, *p, *mix_g, *w_in, *a_re, *a_im, *log_dt, *b_re, *b_im, *c_re, *c_im, *dsk, *w_glu, *b_glu, *q_g, *k_g, *w_out, *ple_g, *w_pg, *w_pp;
    float* out; unsigned char* ws;
};

DI int lane_fresh() { int l; asm volatile("v_mbcnt_lo_u32_b32 %0, -1, 0\n\tv_mbcnt_hi_u32_b32 %0, -1, %0" : "=v"(l)); return l; }
DI unsigned cvt_pk_bf16(float lo, float hi) { unsigned r; asm volatile("v_cvt_pk_bf16_f32 %0, %1, %2" : "=v"(r) : "v"(lo), "v"(hi)); return r; }
DI float bf_lo(unsigned w) { return __uint_as_float(w << 16); }
DI float bf_hi(unsigned w) { return __uint_as_float(w & 0xffff0000u); }
DI float fsigmoid(float x) { return __builtin_amdgcn_rcpf(1.0f + __expf(-x)); }
DI float fsilu(float x) { return x * fsigmoid(x); }
DI float fgelu_tanh(float y) { const float u2 = 1.5957691216057308f * (y + 0.044715f * y * y * y); return y * fsigmoid(u2); }

DI int lds_byte(int r, int c) { const int st = (r >> 4) * 2 + (c >> 5), rr = r & 15, cc = c & 31, ob = rr * 64 + cc * 2; return st * 1024 + (ob ^ (((ob >> 9) & 1) << 5)); }
DI void stage_rc(int b, int& R, int& C) { const int st = b / 1024, sb = b % 1024, swz = sb ^ (((sb >> 9) & 1) << 5); R = (st >> 1) * 16 + swz / 64; C = (st & 1) * 32 + (swz % 64) / 2; }

struct Unit { int pm, pn, g; };
struct Gemm { const bf16_t* A; const bf16_t* Bt; int lda, ldb, K; size_t gsA, gsB; };
struct Order {
    int nM, nN, nwg, total, G, c, lim;
    DI void init(int nM_, int nN_, int nG, int G_, int c_) { nM = nM_; nN = nN_; nwg = nM * nN; total = nwg * nG; lim = total; G = G_; c = c_; asm volatile("" : "+s"(c)); }
    DI bool next(int i, Unit& u) const {
        if (nwg < 0) { if (i >= lim) return false; u.g = nM; u.pm = nN; u.pn = i; return true; }
        int L = i * G + c; if (L >= lim) return false;
        if (total > nwg) {
            const int gpx = (total / nwg) >> 3, q = (c >> 3) + (G >> 3) * i; if (q >= gpx * nwg) return false;
            L = ((c & 7) * gpx + q / nwg) * nwg + q % nwg; }
        u.g = L / nwg; int wgid = L - u.g * nwg;
        { const int q = nwg / NXCD, r = nwg % NXCD, xcd = wgid % NXCD, off = wgid / NXCD; wgid = (xcd < r ? xcd * (q + 1) : r * (q + 1) + (xcd - r) * q) + off; }
        const int nig = WGM * nN, gid = wgid / nig, fm = gid * WGM, gsz = (nM - fm) < WGM ? (nM - fm) : WGM;
        u.pm = fm + ((wgid % nig) % gsz); u.pn = (wgid % nig) / gsz; return true;
    }
};

template <class Epi>
DI void gemm_phase(LAS unsigned char* lds, const Gemm g, const Order& S, const Epi& E, const int wid) {
    const int lane = lane_fresh(), tid = wid * 64 + lane, wr = wid >> 2, wc = wid & 3, fr = lane & 15, fq = lane >> 4;
    const int K = g.K, nt = K / BK;
    unsigned voffA[2], voffB[2];
#pragma unroll
    for (int i = 0; i < 2; ++i) { int R, C; stage_rc(tid * 16 + i * 8192, R, C); voffA[i] = (unsigned)(R * g.lda + C) * 2u; voffB[i] = (unsigned)(R * g.ldb + C) * 2u; }
    const size_t kstep = (size_t)(BK * 2);
    const size_t hstepA = (size_t)HALF * g.lda * 2, hstepB = (size_t)HALF * g.ldb * 2;
    const size_t tstepA = 2 * hstepA, tstepB = 2 * hstepB;
    const unsigned ldsw = (unsigned)wid * 1024u;
    const int aoff = lds_byte(wr * 64 + fr, fq * 8), boff = lds_byte(wc * 32 + fr, fq * 8);
#define PG8_SA(b, h) (((b) * 2 + (h)) * HTB)
#define PG8_SB(b, h) ((4 + (b) * 2 + (h)) * HTB)
#define PG8_STAGE(bufoff, gbase, voff) do { _Pragma("unroll") for (int _i = 0; _i < 2; ++_i) \
        __builtin_amdgcn_global_load_lds((const unsigned*)((const char*)(gbase) + (voff)[_i]), (LAS unsigned*)(lds + (bufoff) + ldsw + _i * 8192), 16, 0, 0); } while (0)
#define PG8_LDA(dst, b, h) do { _Pragma("unroll") for (int m = 0; m < 4; ++m) _Pragma("unroll") for (int k = 0; k < 2; ++k) dst[m][k] = *(const LAS bf16x8*)(lds + PG8_SA(b, h) + aoff + m * 2048 + k * 1024); } while (0)
#define PG8_LDB(dst, b, h) do { _Pragma("unroll") for (int n = 0; n < 2; ++n) _Pragma("unroll") for (int k = 0; k < 2; ++k) dst[n][k] = *(const LAS bf16x8*)(lds + PG8_SB(b, h) + boff + n * 2048 + k * 1024); } while (0)
#define PG8_MMA(ai, bj, At, Bt) do { __builtin_amdgcn_s_setprio(1); _Pragma("unroll") for (int m = 0; m < 4; ++m) _Pragma("unroll") for (int n = 0; n < 2; ++n) _Pragma("unroll") for (int k = 0; k < 2; ++k) \
        acc[ai][bj][m][n] = __builtin_amdgcn_mfma_f32_16x16x32_bf16(Bt[n][k], At[m][k], acc[ai][bj][m][n], 0, 0, 0); __builtin_amdgcn_s_setprio(0); } while (0)
#define PG8_WAIT_V(n) asm volatile("s_waitcnt vmcnt(" #n ")" ::: "memory")
#define PG8_WAIT_L(n) asm volatile("s_waitcnt lgkmcnt(" #n ")" ::: "memory")
#define PG8_BAR __builtin_amdgcn_s_barrier()
#define PG8_SCHED __builtin_amdgcn_sched_barrier(0)
    Unit cur, nxt; int ui = 0;
    if (!S.next(0, cur)) return;
    f32x4 acc[2][2][4][2];
#pragma unroll
    for (int a = 0; a < 2; ++a)
#pragma unroll
        for (int b = 0; b < 2; ++b)
#pragma unroll
            for (int m = 0; m < 4; ++m)
#pragma unroll
                for (int n = 0; n < 2; ++n) acc[a][b][m][n] = (f32x4){0.f, 0.f, 0.f, 0.f};
    bf16x8 At[4][2], B0[2][2], B1[2][2];
    const char* cA = (const char*)(g.A + (size_t)cur.g * g.gsA) + (size_t)cur.pm * tstepA;
    const char* cB = (const char*)(g.Bt + (size_t)cur.g * g.gsB) + (size_t)cur.pn * tstepB;
    PG8_STAGE(PG8_SB(0, 0), cB, voffB); PG8_STAGE(PG8_SB(0, 1), cB + hstepB, voffB); PG8_STAGE(PG8_SA(0, 0), cA, voffA); PG8_STAGE(PG8_SA(0, 1), cA + hstepA, voffA);
    if (wr == 1) PG8_BAR;
    PG8_WAIT_V(2); PG8_BAR;
    PG8_STAGE(PG8_SB(1, 0), cB + kstep, voffB); PG8_STAGE(PG8_SA(1, 0), cA + kstep, voffA); PG8_STAGE(PG8_SB(1, 1), cB + hstepB + kstep, voffB);
    PG8_WAIT_V(6); PG8_BAR;
    for (;;) {
        const bool has_next = S.next(ui + 1, nxt);
        const char* nA = has_next ? (const char*)(g.A + (size_t)nxt.g * g.gsA) + (size_t)nxt.pm * tstepA : cA;
        const char* nB = has_next ? (const char*)(g.Bt + (size_t)nxt.g * g.gsB) + (size_t)nxt.pn * tstepB : cB;
        for (int t = 0; t < nt; t += 2) {
            const bool last = (t == nt - 2);
            const char* a1 = cA + (size_t)(t + 1) * kstep;
            const char* a2 = last ? nA : cA + (size_t)(t + 2) * kstep; const char* b2 = last ? nB : cB + (size_t)(t + 2) * kstep;
            const char* a3 = a2 + kstep; const char* b3 = b2 + kstep;
            if (t == nt - 2) E.prefetch(cur, lds, wid);
            PG8_LDB(B0, 0, 0); PG8_LDB(B1, 0, 1); PG8_SCHED; PG8_LDA(At, 0, 0); PG8_STAGE(PG8_SA(1, 1), a1 + hstepA, voffA);
            PG8_WAIT_V(8); PG8_WAIT_L(0); PG8_BAR; PG8_MMA(0, 0, At, B0); PG8_MMA(0, 1, At, B1); PG8_BAR; PG8_SCHED;
            PG8_LDA(At, 0, 1); PG8_STAGE(PG8_SB(0, 0), b2, voffB); PG8_STAGE(PG8_SB(0, 1), b2 + hstepB, voffB); PG8_STAGE(PG8_SA(0, 0), a2, voffA);
            PG8_WAIT_V(8); PG8_WAIT_L(0); PG8_BAR; PG8_MMA(1, 0, At, B0); PG8_MMA(1, 1, At, B1); PG8_BAR; PG8_SCHED;
            PG8_LDB(B0, 1, 0); PG8_LDB(B1, 1, 1); PG8_SCHED; PG8_LDA(At, 1, 0); PG8_STAGE(PG8_SA(0, 1), a2 + hstepA, voffA);
            PG8_WAIT_V(8); PG8_WAIT_L(0); PG8_BAR; PG8_MMA(0, 0, At, B0); PG8_MMA(0, 1, At, B1); PG8_BAR; PG8_SCHED;
            PG8_LDA(At, 1, 1); PG8_STAGE(PG8_SB(1, 0), b3, voffB); PG8_STAGE(PG8_SB(1, 1), b3 + hstepB, voffB); PG8_STAGE(PG8_SA(1, 0), a3, voffA);
            PG8_WAIT_V(8); PG8_WAIT_L(0); PG8_BAR; PG8_MMA(1, 0, At, B0); PG8_MMA(1, 1, At, B1); PG8_BAR; PG8_SCHED;
        }
        if (wr == 0) PG8_BAR;
        { const int le = lane_fresh(); E(acc, cur, wr, wc, le & 15, le >> 4); }
        if (!has_next) break;
#pragma unroll
        for (int a = 0; a < 2; ++a)
#pragma unroll
            for (int b = 0; b < 2; ++b)
#pragma unroll
                for (int m = 0; m < 4; ++m)
#pragma unroll
                    for (int n = 0; n < 2; ++n) acc[a][b][m][n] = (f32x4){0.f, 0.f, 0.f, 0.f};
        cur = nxt; cA = nA; cB = nB; ++ui;
        if (wr == 1) PG8_BAR;
    }
    PG8_WAIT_V(0);
    PG8_BAR;
#undef PG8_SA
#undef PG8_SB
#undef PG8_STAGE
#undef PG8_LDA
#undef PG8_LDB
#undef PG8_MMA
#undef PG8_WAIT_V
#undef PG8_WAIT_L
#undef PG8_BAR
#undef PG8_SCHED
}

#define EPI_ROWS _Pragma("unroll") for (int ai = 0; ai < 2; ++ai) _Pragma("unroll") for (int m = 0; m < 4; ++m) if ((__extension__({ if (m == 0) asm volatile("" ::: "memory"); 1; })))
#define EPI_ROWS_NF _Pragma("unroll") for (int ai = 0; ai < 2; ++ai) _Pragma("unroll") for (int m = 0; m < 4; ++m)
#define EPI_COLS _Pragma("unroll") for (int bj = 0; bj < 2; ++bj) _Pragma("unroll") for (int n = 0; n < 2; ++n)

struct EpiIn {
    DI void prefetch(const Unit& u, LAS unsigned char* lds, int wid) const {
        if (wid < 4) __builtin_amdgcn_global_load_lds((const unsigned*)(ss + u.pm * BM + wid * 64 + lane_fresh()), (LAS unsigned*)(lds + LDS_DUMMY + wid * 256), 4, 0, 0);
    }
    const float* ss; bf16_t *Ucat, *SG, *GA, *Q, *Kb, *VT; const float *qg, *kg;
    DI void operator()(const f32x4 (&acc)[2][2][4][2], const Unit& u, int wr, int wc, int fr, int fq) const {
        const int type = u.pn >> 1, hf = u.pn & 1;
        float rsv[2][4];
        EPI_ROWS_NF rsv[ai][m] = ss[u.pm * BM + ai * HALF + wr * 64 + m * 16 + fr];
        EPI_ROWS_NF rsv[ai][m] = rsqrtf(rsv[ai][m] * (1.f / 1024.f) + 1e-6f);
#define EPI_BJ _Pragma("unroll") for (int bj = 0; bj < 2; ++bj)
#define PACK8(w, a0, a1) do { w.x = cvt_pk_bf16(a0[0], a0[1]); w.y = cvt_pk_bf16(a0[2], a0[3]); w.z = cvt_pk_bf16(a1[0], a1[1]); w.w = cvt_pk_bf16(a1[2], a1[3]); } while (0)
        if (type == 0) {
            EPI_ROWS_NF { const int row = u.pm * BM + ai * HALF + wr * 64 + m * 16 + fr; const float rs = rsv[ai][m];
                EPI_BJ { const f32x4 v0 = acc[ai][bj][m][0] * rs, v1 = acc[ai][bj][m][1] * rs; const int g = 16 * hf + 4 * wc + 2 * bj + (fq >> 1);
                    u32x4 w; PACK8(w, v0, v1);
                    *(u32x4*)(Ucat + ((size_t)(g * 1024 + (row >> 5)) * 640 + (row & 31) * 16 + 8 * (fq & 1))) = w; } }
        } else if (type == 1 || type == 5) {
            bf16_t* dst = type == 1 ? SG : GA;
            EPI_ROWS_NF { const int row = u.pm * BM + ai * HALF + wr * 64 + m * 16 + fr; const float rs = rsv[ai][m];
                EPI_BJ { f32x4 v0 = acc[ai][bj][m][0] * rs, v1 = acc[ai][bj][m][1] * rs; const int cs = 256 * hf + 64 * wc + 32 * bj + 8 * fq;
#pragma unroll
                    for (int j = 0; j < 4; ++j) { v0[j] = fsilu(v0[j]); v1[j] = fsilu(v1[j]); }
                    u32x4 w; PACK8(w, v0, v1);
                    *(u32x4*)(dst + (size_t)row * 512 + cs) = w; } }
        } else if (type == 2 || type == 3) {
            bf16_t* dst = type == 2 ? Q : Kb; const float* gam = type == 2 ? qg : kg; const float sc = type == 2 ? 0.125f : 1.0f;
            f32x4 gv[2][2];
            EPI_COLS gv[bj][n] = *(const f32x4*)(gam + 32 * bj + 8 * fq + 4 * n) * sc;
            EPI_ROWS_NF { const int row = u.pm * BM + ai * HALF + wr * 64 + m * 16 + fr; const float rs = rsv[ai][m];
                f32x4 v[2][2]; float s = 0.f;
                EPI_COLS { v[bj][n] = acc[ai][bj][m][n] * rs; s += (v[bj][n][0] * v[bj][n][0] + v[bj][n][1] * v[bj][n][1]) + (v[bj][n][2] * v[bj][n][2] + v[bj][n][3] * v[bj][n][3]); }
                s += __shfl_xor(s, 16); s += __shfl_xor(s, 32);
                const float ri = rsqrtf(s * (1.f / 64.f) + 1e-6f);
                EPI_BJ { const f32x4 o0 = v[bj][0] * ri * gv[bj][0], o1 = v[bj][1] * ri * gv[bj][1]; const int cs = 256 * hf + 64 * wc + 32 * bj + 8 * fq;
                    u32x4 w; PACK8(w, o0, o1);
                    {
                        const int key = row & 4095; (void)cs;
                        *(u32x4*)(dst + (((size_t)((row >> 12) * 8 + 4 * hf + wc)) << 18) + (key >> 5) * 2048 + (2 * bj + (fq >> 1)) * 512 + (key & 31) * 16 + 8 * (fq & 1)) = w; } } }
        } else {
            EPI_ROWS_NF { const int row = u.pm * BM + ai * HALF + wr * 64 + m * 16 + fr; const float rs = rsv[ai][m];
                const int b = row >> 12, s = row & 4095, head = 4 * hf + wc;
                EPI_COLS { const f32x4 v = acc[ai][bj][m][n] * rs;
                    const unsigned w0 = cvt_pk_bf16(v[0], v[1]), w1 = cvt_pk_bf16(v[2], v[3]);
                    bf16_t* o = VT + (((size_t)(b * 8 + head)) << 18) + (s >> 5) * 2048 + bj * 1024 + ((s >> 4) & 1) * 512 + (8 * fq + 4 * n) * 16 + (s & 15);
                    o[0] = (bf16_t)(w0 & 0xffffu); o[16] = (bf16_t)(w0 >> 16); o[32] = (bf16_t)(w1 & 0xffffu); o[48] = (bf16_t)(w1 >> 16); } }
        }
#undef EPI_BJ
#undef PACK8
    }
};
struct EpiS {
    DI void prefetch(const Unit&, LAS unsigned char*, int) const {}
    float* Sbuf;
    DI void operator()(const f32x4 (&acc)[2][2][4][2], const Unit& u, int wr, int wc, int fr, int fq) const {
        EPI_ROWS { const int R = u.pm * BM + ai * HALF + wr * 64 + m * 16 + fr;
#pragma unroll
            for (int n = 0; n < 2; ++n) *(f32x4*)(Sbuf + ((size_t)(u.g * 1024 + R) * 128 + 32 * wc + 16 * n + 4 * fq)) = acc[ai][0][m][n]; }
    }
};
struct EpiY {
    DI void prefetch(const Unit&, LAS unsigned char*, int) const {}
    const bf16_t* Ucat; const float* dsk; bf16_t* zb;
    DI void operator()(const f32x4 (&acc)[2][2][4][2], const Unit& u, int wr, int wc, int fr, int fq) const {
        const int h0 = 8 * (fq & 1);
        const f32x4 dv0 = *(const f32x4*)(dsk + u.g * 16 + h0), dv1 = *(const f32x4*)(dsk + u.g * 16 + h0 + 4);
        EPI_ROWS { const int R = u.pm * BM + ai * HALF + wr * 64 + m * 16 + fr;
#pragma unroll
            for (int bj = 0; bj < 2; ++bj) { const int ncol = u.pn * BM + bj * HALF + 32 * wc + 8 * fq;
                const u32x4 ub = *(const u32x4*)(Ucat + ((size_t)(u.g * 1024 + R) * 640 + ncol));
                f32x4 y0 = acc[ai][bj][m][0], y1 = acc[ai][bj][m][1];
                y0[0] += dv0[0] * bf_lo(ub.x); y0[1] += dv0[1] * bf_hi(ub.x); y0[2] += dv0[2] * bf_lo(ub.y); y0[3] += dv0[3] * bf_hi(ub.y);
                y1[0] += dv1[0] * bf_lo(ub.z); y1[1] += dv1[1] * bf_hi(ub.z); y1[2] += dv1[2] * bf_lo(ub.w); y1[3] += dv1[3] * bf_hi(ub.w);
                u32x4 w; w.x = cvt_pk_bf16(fgelu_tanh(y0[0]), fgelu_tanh(y0[1])); w.y = cvt_pk_bf16(fgelu_tanh(y0[2]), fgelu_tanh(y0[3]));
                w.z = cvt_pk_bf16(fgelu_tanh(y1[0]), fgelu_tanh(y1[1])); w.w = cvt_pk_bf16(fgelu_tanh(y1[2]), fgelu_tanh(y1[3]));
                const int token = R * 32 + (ncol >> 4);
                *(u32x4*)(zb + (size_t)token * 512 + u.g * 16 + h0) = w; } }
    }
};
struct EpiGlu {
    DI void prefetch(const Unit& u, LAS unsigned char* lds, int wid) const {
        const int id = wid * 64 + lane_fresh(), row = id >> 1, seg = id & 1;
        __builtin_amdgcn_global_load_lds((const unsigned*)(SG + (size_t)(u.pm * BM + row) * 512 + u.pn * 128 + seg * 64), (LAS unsigned*)(lds + LDS_DUMMY + wid * 256), 4, 0, 0);
    }
    const float* bglu; const bf16_t* SG; bf16_t* cat;
    DI void operator()(const f32x4 (&acc)[2][2][4][2], const Unit& u, int wr, int wc, int fr, int fq) const {
        const int ch = u.pn * 128 + 32 * wc + 8 * fq;
        f32x4 bv[2], bg[2];
#pragma unroll
        for (int n = 0; n < 2; ++n) { bv[n] = *(const f32x4*)(bglu + ch + 4 * n); bg[n] = *(const f32x4*)(bglu + 512 + ch + 4 * n); }
        EPI_ROWS { const int row = u.pm * BM + ai * HALF + wr * 64 + m * 16 + fr;
            const f32x4 v0 = acc[ai][0][m][0] + bv[0], g0 = acc[ai][1][m][0] + bg[0], v1 = acc[ai][0][m][1] + bv[1], g1 = acc[ai][1][m][1] + bg[1];
            const u32x4 sg = *(const u32x4*)(SG + (size_t)row * 512 + ch);
            u32x4 w;
            w.x = cvt_pk_bf16(v0[0] * fsigmoid(g0[0]) * bf_lo(sg.x), v0[1] * fsigmoid(g0[1]) * bf_hi(sg.x)); w.y = cvt_pk_bf16(v0[2] * fsigmoid(g0[2]) * bf_lo(sg.y), v0[3] * fsigmoid(g0[3]) * bf_hi(sg.y));
            w.z = cvt_pk_bf16(v1[0] * fsigmoid(g1[0]) * bf_lo(sg.z), v1[1] * fsigmoid(g1[1]) * bf_hi(sg.z)); w.w = cvt_pk_bf16(v1[2] * fsigmoid(g1[2]) * bf_lo(sg.w), v1[3] * fsigmoid(g1[3]) * bf_hi(sg.w));
            *(u32x4*)(cat + (size_t)row * 1024 + ch) = w; }
    }
};
struct EpiOut {
    DI void prefetch(const Unit& u, LAS unsigned char* lds, int wid) const {
        const int tid = wid * 64 + lane_fresh();
#pragma unroll
        for (int i = 0; i < 2; ++i) { const int id = tid + 512 * i, row = id >> 2, seg = id & 3;
            __builtin_amdgcn_global_load_lds((const unsigned*)(hin + (size_t)(u.pm * BM + row) * 1024 + u.pn * BM + seg * 64), (LAS unsigned*)(lds + LDS_DUMMY + wid * 256), 4, 0, 0); }
    }
    const bf16_t* hin; bf16_t* hb; float* ss;
    DI void operator()(const f32x4 (&acc)[2][2][4][2], const Unit& u, int wr, int wc, int fr, int fq) const {
        EPI_ROWS { const int row = u.pm * BM + ai * HALF + wr * 64 + m * 16 + fr; float s = 0.f;
#pragma unroll
            for (int bj = 0; bj < 2; ++bj) { const size_t off = (size_t)row * 1024 + u.pn * BM + bj * HALF + 32 * wc + 8 * fq;
                const u32x4 rw = *(const u32x4*)(hin + off); f32x4 h0 = acc[ai][bj][m][0], h1_ = acc[ai][bj][m][1];
                h0[0] += bf_lo(rw.x); h0[1] += bf_hi(rw.x); h0[2] += bf_lo(rw.y); h0[3] += bf_hi(rw.y); h1_[0] += bf_lo(rw.z); h1_[1] += bf_hi(rw.z); h1_[2] += bf_lo(rw.w); h1_[3] += bf_hi(rw.w);
                u32x4 w; w.x = cvt_pk_bf16(h0[0], h0[1]); w.y = cvt_pk_bf16(h0[2], h0[3]); w.z = cvt_pk_bf16(h1_[0], h1_[1]); w.w = cvt_pk_bf16(h1_[2], h1_[3]); *(u32x4*)(hb + off) = w;
                s += ((h0[0] * h0[0] + h0[1] * h0[1]) + (h0[2] * h0[2] + h0[3] * h0[3])) + ((h1_[0] * h1_[0] + h1_[1] * h1_[1]) + (h1_[2] * h1_[2] + h1_[3] * h1_[3])); }
            s += __shfl_xor(s, 16); s += __shfl_xor(s, 32);
            if (fq == 0) atomicAdd(ss + row, s); }
    }
};
struct EpiPle {
    DI void prefetch(const Unit& u, LAS unsigned char* lds, int wid) const {
        const int tid = wid * 64 + lane_fresh();
#pragma unroll
        for (int i = 0; i < 2; ++i) { const int id = tid + 512 * i, row = id >> 2, seg = id & 3; const size_t off = (size_t)(u.pm * BM + row) * 1024 + u.pn * BM + seg * 64;
            __builtin_amdgcn_global_load_lds((const unsigned*)(h1 + off), (LAS unsigned*)(lds + LDS_DUMMY + wid * 256), 4, 0, 0);
            __builtin_amdgcn_global_load_lds((const unsigned*)(pp + off), (LAS unsigned*)(lds + LDS_DUMMY + wid * 256), 4, 0, 0); }
        if (wid < 4) __builtin_amdgcn_global_load_lds((const unsigned*)(ss1 + u.pm * BM + tid), (LAS unsigned*)(lds + LDS_DUMMY + wid * 256), 4, 0, 0);
    }
    const float* ss1; const bf16_t* h1; float* h; const bf16_t* pp; bf16_t* hb; float* ss2; int last;
    DI void operator()(const f32x4 (&acc)[2][2][4][2], const Unit& u, int wr, int wc, int fr, int fq) const {
        float rsv[2][4];
        EPI_ROWS_NF rsv[ai][m] = ss1[u.pm * BM + ai * HALF + wr * 64 + m * 16 + fr];
        EPI_ROWS_NF rsv[ai][m] = rsqrtf(rsv[ai][m] * (1.f / 1024.f) + 1e-6f);
        EPI_ROWS { const int row = u.pm * BM + ai * HALF + wr * 64 + m * 16 + fr; float s = 0.f;
            const float rs = rsv[ai][m];
#pragma unroll
            for (int bj = 0; bj < 2; ++bj) { const size_t off = (size_t)row * 1024 + u.pn * BM + bj * HALF + 32 * wc + 8 * fq;
                const f32x4 a0 = acc[ai][bj][m][0] * rs, a1 = acc[ai][bj][m][1] * rs; const u32x4 pw = *(const u32x4*)(pp + off); const u32x4 hw = *(const u32x4*)(h1 + off);
                f32x4 h0, h1_;
                h0[0] = bf_lo(hw.x) + fsigmoid(a0[0]) * bf_lo(pw.x); h0[1] = bf_hi(hw.x) + fsigmoid(a0[1]) * bf_hi(pw.x); h0[2] = bf_lo(hw.y) + fsigmoid(a0[2]) * bf_lo(pw.y); h0[3] = bf_hi(hw.y) + fsigmoid(a0[3]) * bf_hi(pw.y);
                h1_[0] = bf_lo(hw.z) + fsigmoid(a1[0]) * bf_lo(pw.z); h1_[1] = bf_hi(hw.z) + fsigmoid(a1[1]) * bf_hi(pw.z); h1_[2] = bf_lo(hw.w) + fsigmoid(a1[2]) * bf_lo(pw.w); h1_[3] = bf_hi(hw.w) + fsigmoid(a1[3]) * bf_hi(pw.w);
                if (last) { *(f32x4*)(h + off) = h0; *(f32x4*)(h + off + 4) = h1_; }
                if (!last) { u32x4 w; w.x = cvt_pk_bf16(h0[0], h0[1]); w.y = cvt_pk_bf16(h0[2], h0[3]); w.z = cvt_pk_bf16(h1_[0], h1_[1]); w.w = cvt_pk_bf16(h1_[2], h1_[3]); *(u32x4*)(hb + off) = w;
                    s += ((h0[0] * h0[0] + h0[1] * h0[1]) + (h0[2] * h0[2] + h0[3] * h0[3])) + ((h1_[0] * h1_[0] + h1_[1] * h1_[1]) + (h1_[2] * h1_[2] + h1_[3] * h1_[3])); } }
            if (!last) { s += __shfl_xor(s, 16); s += __shfl_xor(s, 32); if (fq == 0) atomicAdd(ss2 + row, s); } }
    }
};
struct EpiPP {
    DI void prefetch(const Unit&, LAS unsigned char*, int) const {}
    bf16_t* pp;
    DI void operator()(const f32x4 (&acc)[2][2][4][2], const Unit& u, int wr, int wc, int fr, int fq) const {
        EPI_ROWS { const int row = u.pm * BM + ai * HALF + wr * 64 + m * 16 + fr;
#pragma unroll
            for (int bj = 0; bj < 2; ++bj) { const size_t off = (size_t)row * 1024 + u.pn * BM + bj * HALF + 32 * wc + 8 * fq; const f32x4 a0 = acc[ai][bj][m][0] * 1.0f, a1 = acc[ai][bj][m][1] * 1.0f;
                u32x4 w; w.x = cvt_pk_bf16(a0[0], a0[1]); w.y = cvt_pk_bf16(a0[2], a0[3]); w.z = cvt_pk_bf16(a1[0], a1[1]); w.w = cvt_pk_bf16(a1[2], a1[3]); *(u32x4*)(pp + off) = w; } }
    }
};

DI void attn_item(int item, const bf16_t* Q, const bf16_t* Kb, const bf16_t* VT, const bf16_t* GA, bf16_t* cat, int lane, LAS float* patch) {
    const int qb = item & 127, h = (item >> 7) & 7, b = item >> 10;
    const int q0 = qb * 32, hf = lane >> 5, ql = lane & 31;
    const bf16_t* qp = Q + (((size_t)(b * 8 + h)) << 18) + (size_t)(q0 >> 5) * 2048 + ql * 16 + 8 * hf;
    bf16x8 qf[4];
#pragma unroll
    for (int s = 0; s < 4; ++s) qf[s] = *(const bf16x8*)(qp + 512 * s);
    const int kperm = (ql & 16) | ((ql & 4) << 1) | ((ql & 8) >> 1) | (ql & 3);
    const bf16_t* kbase = Kb + (((size_t)(b * 8 + h)) << 18) + kperm * 16 + 8 * hf;
    const bf16_t* vbase = VT + (((size_t)(b * 8 + h)) << 18) + ql * 16 + 8 * hf;
    f32x16 o0, o1;
#pragma unroll
    for (int i = 0; i < 16; ++i) { o0[i] = 0.f; o1[i] = 0.f; }
    float cprod = 1.f;
    bf16x8 kf[4], vf[2][2];
    { const bf16_t* kp = kbase + (size_t)(q0 >> 5) * 2048; const bf16_t* vp = vbase + (size_t)(q0 >> 5) * 2048;
#pragma unroll
      for (int s = 0; s < 4; ++s) kf[s] = *(const bf16x8*)(kp + 512 * s);
#pragma unroll
      for (int s = 0; s < 2; ++s) { vf[s][0] = *(const bf16x8*)(vp + 512 * s); vf[s][1] = *(const bf16x8*)(vp + 1024 + 512 * s); } }
#define ATT_TILE(DIAG) { \
        f32x16 st; _Pragma("unroll") for (int i = 0; i < 16; ++i) st[i] = 0.f; \
        _Pragma("unroll") for (int s = 0; s < 4; ++s) st = __builtin_amdgcn_mfma_f32_32x32x16_bf16(kf[s], qf[s], st, 0, 0, 0); \
        const int kn = kb >= 32 ? kb - 32 : 0; const bf16_t* kp = kbase + (size_t)(kn >> 5) * 2048; const bf16_t* vp = vbase + (size_t)(kn >> 5) * 2048; \
        bf16x8 kf2[4], vf2[2][2]; \
        _Pragma("unroll") for (int s = 0; s < 4; ++s) kf2[s] = *(const bf16x8*)(kp + 512 * s); \
        _Pragma("unroll") for (int s = 0; s < 2; ++s) { vf2[s][0] = *(const bf16x8*)(vp + 512 * s); vf2[s][1] = *(const bf16x8*)(vp + 1024 + 512 * s); } \
        float sg[16], ns[16]; float PA = 1.f, PB = 1.f; \
        _Pragma("unroll") for (int r = 0; r < 16; ++r) { \
            const float t = st[r] * -1.4426950408889634f; \
            const float e = __builtin_amdgcn_exp2f(fminf(t, 115.0f));        \
            float sgm = __builtin_amdgcn_rcpf(1.0f + e);                     \
            float nsv = e * sgm;                                             \
            if (DIAG) { const int koff = 16 * (r >> 3) + 8 * hf + (r & 7); if (koff >= ql) { sgm = 0.f; nsv = 1.f; } } \
            sg[r] = sgm; ns[r] = nsv; if (r < 8) PA *= nsv; else PB *= nsv; } \
        const float PAo = __shfl_xor(PA, 32), PBo = __shfl_xor(PB, 32); \
        float runA = cprod * (PB * PBo) * (hf == 0 ? PAo : 1.f); float runB = cprod * (hf == 0 ? PBo : 1.f); \
        float w[16]; \
        _Pragma("unroll") for (int r = 7; r >= 0; --r) { w[r] = sg[r] * runA; runA *= ns[r]; } \
        _Pragma("unroll") for (int r = 15; r >= 8; --r) { w[r] = sg[r] * runB; runB *= ns[r]; } \
        cprod *= (PA * PAo) * (PB * PBo); \
        _Pragma("unroll") for (int s = 0; s < 2; ++s) { \
            u32x4 pw; pw.x = cvt_pk_bf16(w[8 * s], w[8 * s + 1]); pw.y = cvt_pk_bf16(w[8 * s + 2], w[8 * s + 3]); pw.z = cvt_pk_bf16(w[8 * s + 4], w[8 * s + 5]); pw.w = cvt_pk_bf16(w[8 * s + 6], w[8 * s + 7]); \
            const bf16x8 wf = __builtin_bit_cast(bf16x8, pw); \
            o0 = __builtin_amdgcn_mfma_f32_32x32x16_bf16(wf, vf[s][0], o0, 0, 0, 0); \
            o1 = __builtin_amdgcn_mfma_f32_32x32x16_bf16(wf, vf[s][1], o1, 0, 0, 0); } \
        _Pragma("unroll") for (int s = 0; s < 4; ++s) kf[s] = kf2[s]; \
        _Pragma("unroll") for (int s = 0; s < 2; ++s) { vf[s][0] = vf2[s][0]; vf[s][1] = vf2[s][1]; } \
        kb -= 32; }
    { int kb = q0;
      ATT_TILE(true)
      if (kb >= 0 && !__all(cprod < 1.17549435e-38f)) {
          _Pragma("nounroll") for (;;) { ATT_TILE(false) if (kb < 0 || __all(cprod < 1.17549435e-38f)) break; } } }
#undef ATT_TILE
#pragma unroll
    for (int r = 0; r < 16; ++r) { const int q = 8 * (r >> 2) + 4 * hf + (r & 3); patch[q * 68 + ql] = o0[r]; patch[q * 68 + 32 + ql] = o1[r]; }
    asm volatile("s_waitcnt lgkmcnt(0)" ::: "memory");
    { const int q = lane >> 1, dh = 32 * (lane & 1); const size_t tok = (size_t)(b * SEQ + q0 + q);
      const u32x4* gp = (const u32x4*)(GA + tok * 512 + h * 64 + dh); u32x4* cp = (u32x4*)(cat + tok * 1024 + 512 + h * 64 + dh);
#pragma unroll
      for (int i = 0; i < 4; ++i) { const u32x4 gw = gp[i]; const f32x4 a0 = *(const LAS f32x4*)(patch + q * 68 + dh + 8 * i), a1 = *(const LAS f32x4*)(patch + q * 68 + dh + 8 * i + 4);
          u32x4 w; w.x = cvt_pk_bf16(a0[0] * bf_lo(gw.x), a0[1] * bf_hi(gw.x)); w.y = cvt_pk_bf16(a0[2] * bf_lo(gw.y), a0[3] * bf_hi(gw.y));
          w.z = cvt_pk_bf16(a1[0] * bf_lo(gw.z), a1[1] * bf_hi(gw.z)); w.w = cvt_pk_bf16(a1[2] * bf_lo(gw.w), a1[3] * bf_hi(gw.w));
          cp[i] = w; } }
    asm volatile("s_waitcnt lgkmcnt(0)" ::: "memory");
}

DI void sincos_d(double ang, double& s, double& c) {
    const double k = rint(ang * 0.63661977236758134308);
    double y = fma(-k, 1.5707963267948966192, ang); y = fma(-k, 6.123233995736766e-17, y);
    const double y2 = y * y;
    const double sp = y * (1.0 - y2 * (1.0 / 6.0) * (1.0 - y2 * (1.0 / 20.0) * (1.0 - y2 * (1.0 / 42.0) * (1.0 - y2 * (1.0 / 72.0) * (1.0 - y2 * (1.0 / 110.0) * (1.0 - y2 * (1.0 / 156.0) * (1.0 - y2 * (1.0 / 210.0) * (1.0 - y2 * (1.0 / 272.0)))))))));
    const double cp = 1.0 - y2 * (1.0 / 2.0) * (1.0 - y2 * (1.0 / 12.0) * (1.0 - y2 * (1.0 / 30.0) * (1.0 - y2 * (1.0 / 56.0) * (1.0 - y2 * (1.0 / 90.0) * (1.0 - y2 * (1.0 / 132.0) * (1.0 - y2 * (1.0 / 182.0) * (1.0 - y2 * (1.0 / 240.0))))))));
    const int q = (int)((long long)k & 3);
    s = (q == 0) ? sp : (q == 1) ? cp : (q == 2) ? -sp : -cp;
    c = (q == 0) ? cp : (q == 1) ? -sp : (q == 2) ? -cp : sp;
}
DI double exp_d(double x) {
    const double k = rint(x * 1.4426950408889634074); const double r = fma(-k, 0.69314718055994530942, x);
    double t = 1.0;
#pragma unroll
    for (int i = 14; i >= 1; --i) t = 1.0 + t * r * (1.0 / (double)i);
    return ldexp(t, (int)k);
}

template <int MODE>
DI int colmap(int n) {
    if (MODE == 1) { const int pn = n >> 8, r = n & 255, bj = r >> 7, wc = (r >> 5) & 3, c = r & 31; return 256 * pn + 64 * wc + 32 * bj + c; }
    if (MODE == 2) { const int pn = n >> 8, r = n & 255; return r < 128 ? 128 * pn + r : 512 + 128 * pn + (r - 128); }
    if (MODE == 5) { const int rho = n & 31, nn = rho >> 4, i = rho & 15; const int m2 = (n & ~31) + 8 * (i >> 2) + 4 * nn + (i & 3); const int pn = m2 >> 8, r = m2 & 255, bj = r >> 7, wc = (r >> 5) & 3, c = r & 31; return 256 * pn + 64 * wc + 32 * bj + c; }
    if (MODE == 4) { const int rho = n & 31, nn = rho >> 4, i = rho & 15; const int m2 = (n & ~31) + 8 * (i >> 2) + 4 * nn + (i & 3); const int pn = m2 >> 8, r = m2 & 255; return r < 128 ? 128 * pn + r : 512 + 128 * pn + (r - 128); }
    if (MODE == 3) { const int rho = n & 31, nn = rho >> 4, i = rho & 15; return (n & ~31) + 8 * (i >> 2) + 4 * nn + (i & 3); }
    return n;
}
template <int MODE>
DI void transpose_w(const float* W, int K, int N, bf16_t* WT, const float* kscale, LAS float* scr, int gw, int nw, int lane) {
    const int nblk = N >> 5, items = (K >> 6) * nblk;
    for (int item = gw; item < items; item += nw) {
        const int kb = item / nblk, nb = item - kb * nblk, k0 = 64 * kb, n0 = 32 * nb, colL = colmap<MODE>(n0 + (lane & 31));
        float tv[32];
#pragma unroll
        for (int i = 0; i < 32; ++i) { const int kk = 2 * i + (lane >> 5); tv[i] = W[(size_t)(k0 + kk) * N + colL]; }
        if (kscale) {
#pragma unroll
            for (int i = 0; i < 32; ++i) tv[i] *= kscale[k0 + 2 * i + (lane >> 5)]; }
#pragma unroll
        for (int i = 0; i < 32; ++i) { const int kk = 2 * i + (lane >> 5); scr[kk * 33 + (lane & 31)] = tv[i]; }
        asm volatile("s_waitcnt lgkmcnt(0)" ::: "memory");
        const int cc = lane & 7;
#pragma unroll
        for (int j = 0; j < 4; ++j) { const int n = (lane >> 3) + 8 * j; const LAS float* sp = scr + (8 * cc) * 33 + n;
            u32x4 o; o.x = cvt_pk_bf16(sp[0 * 33], sp[1 * 33]); o.y = cvt_pk_bf16(sp[2 * 33], sp[3 * 33]); o.z = cvt_pk_bf16(sp[4 * 33], sp[5 * 33]); o.w = cvt_pk_bf16(sp[6 * 33], sp[7 * 33]);
            *(u32x4*)(WT + (size_t)(n0 + n) * K + k0 + 8 * cc) = o; }
        asm volatile("s_waitcnt lgkmcnt(0)" ::: "memory");
    }
}

DI void ssm_prep(const Params& P, int lg, int qd, LAS unsigned char* lds, int tid) {
    LAS float* apr = (LAS float*)lds;
    LAS float* api = apr + 33 * 64;
    LAS float* bbr = api + 33 * 64;
    LAS float* bbi = bbr + 1024;
    LAS float* cr = bbi + 1024;
    LAS float* ci = cr + 1024;
    LAS float* ktab = ci + 1024;
    LAS float* part = ktab + 8192;
    LAS double* fz = (LAS double*)(part + 8192);
    const double dt = exp_d((double)P.log_dt[lg]);
    for (int idx = tid; idx < 33 * 64; idx += 512) {
        const int tau = idx >> 6, p = idx & 63;
        const double lr = (double)P.a_re[lg * 64 + p], li = (double)P.a_im[lg * 64 + p];
        const double mag = exp_d(lr * dt * (double)tau); double s, c; sincos_d(li * dt * (double)tau, s, c);
        apr[idx] = (float)(mag * c); api[idx] = (float)(mag * s);
        if (tau == 32 && qd == 0) { float* a32 = (float*)(P.ws + WS_MISC) + (size_t)(lg * 64 + p) * 2; a32[0] = (float)(mag * c); a32[1] = (float)(mag * s); }
        if (tau == 1) {
            const double nr = mag * c - 1.0, ni = mag * s, den = lr * lr + li * li;
            fz[2 * p] = (nr * lr + ni * li) / den; fz[2 * p + 1] = (ni * lr - nr * li) / den; }
    }
    for (int idx = tid; idx < 1024; idx += 512) { cr[idx] = P.c_re[(size_t)lg * 1024 + idx]; ci[idx] = P.c_im[(size_t)lg * 1024 + idx]; }
    __syncthreads();
    for (int idx = tid; idx < 1024; idx += 512) { const int p = idx >> 4; const double fr_ = fz[2 * p], fi_ = fz[2 * p + 1];
        const double br = (double)P.b_re[(size_t)lg * 1024 + idx], bi = (double)P.b_im[(size_t)lg * 1024 + idx];
        bbr[idx] = (float)(fr_ * br - fi_ * bi); bbi[idx] = (float)(fr_ * bi + fi_ * br); }
    __syncthreads();
    {
        const int hh = tid & 255, hp = hh >> 4, h = hh & 15, ph = tid >> 8;
        float cbr[32], cbi[32];
#pragma unroll
        for (int i = 0; i < 32; ++i) { const int p = 32 * ph + i; const float c_r = cr[h * 64 + p], c_i = ci[h * 64 + p], x_r = bbr[p * 16 + hp], x_i = bbi[p * 16 + hp];
            cbr[i] = c_r * x_r - c_i * x_i; cbi[i] = c_r * x_i + c_i * x_r; }
        for (int tau = 0; tau < 32; ++tau) { float acc = 0.f;
#pragma unroll
            for (int i = 0; i < 32; ++i) acc += apr[tau * 64 + 32 * ph + i] * cbr[i] - api[tau * 64 + 32 * ph + i] * cbi[i];
            if (ph) part[tau * 256 + hh] = acc; else ktab[tau * 256 + hh] = acc; }
    }
    __syncthreads();
    for (int o = tid; o < 8192; o += 512) ktab[o] += part[o];
    __syncthreads();
    bf16_t* W1 = (bf16_t*)(P.ws + WS_W1) + (size_t)lg * 256 * 512;
    for (int it = tid; it < 128 * 64; it += 512) {
        const int n = 128 * qd + (it >> 6), k8 = it & 63, s = k8 >> 1, hp0 = (k8 & 1) * 8; float v[8];
#pragma unroll
        for (int i = 0; i < 8; ++i) {
            if (n < 128) { const int p = n & 63; const float ar = apr[(31 - s) * 64 + p], ai = api[(31 - s) * 64 + p], xr = bbr[p * 16 + hp0 + i], xi = bbi[p * 16 + hp0 + i];
                v[i] = n < 64 ? ar * xr - ai * xi : ar * xi + ai * xr; }
            else v[i] = 0.f;
        }
        u32x4 o; o.x = cvt_pk_bf16(v[0], v[1]); o.y = cvt_pk_bf16(v[2], v[3]); o.z = cvt_pk_bf16(v[4], v[5]); o.w = cvt_pk_bf16(v[6], v[7]);
        *(u32x4*)(W1 + (size_t)n * 512 + k8 * 8) = o;
    }
    bf16_t* TP = (bf16_t*)(P.ws + WS_TOEP) + (size_t)lg * 512 * 640;
    for (int it = tid; it < 256 * 80; it += 512) {
        const int n = 256 * qd + it / 80, k8 = it % 80, nl = colmap<3>(n), t = nl >> 4, h = nl & 15; float v[8];
        if (k8 < 64) { const int s = k8 >> 1, hp0 = (k8 & 1) * 8;
#pragma unroll
            for (int i = 0; i < 8; ++i) v[i] = (s <= t) ? ktab[(t - s) * 256 + (hp0 + i) * 16 + h] : 0.f;
        } else if (k8 < 72) {
#pragma unroll
            for (int i = 0; i < 8; ++i) { const int p = (k8 - 64) * 8 + i; v[i] = cr[h * 64 + p] * apr[(t + 1) * 64 + p] - ci[h * 64 + p] * api[(t + 1) * 64 + p]; }
        } else {
#pragma unroll
            for (int i = 0; i < 8; ++i) { const int p = (k8 - 72) * 8 + i; v[i] = -(cr[h * 64 + p] * api[(t + 1) * 64 + p] + ci[h * 64 + p] * apr[(t + 1) * 64 + p]); }
        }
        u32x4 o; o.x = cvt_pk_bf16(v[0], v[1]); o.y = cvt_pk_bf16(v[2], v[3]); o.z = cvt_pk_bf16(v[4], v[5]); o.w = cvt_pk_bf16(v[6], v[7]);
        *(u32x4*)(TP + (size_t)n * 640 + k8 * 8) = o;
    }
    __syncthreads();
}

#define XB_TMO      128
#define XB_XCNT(j)  (256  + 64 * (j))
#define XB_XSUB(j)  (1280 + 64 * (j))
#define XB_XGEN(j)  (2304 + 64 * (j))
#define XB_TOP      3328
#define XB_TOPGEN   3392
#define XCD_BAR_WORDS 3456
#define XB_SPIN_CAP (1u << 18)
DI unsigned xb_ld(unsigned* p) { return __hip_atomic_load(p, __ATOMIC_RELAXED, __HIP_MEMORY_SCOPE_AGENT); }
DI unsigned xb_add(unsigned* p, unsigned v) { return __hip_atomic_fetch_add(p, v, __ATOMIC_RELAXED, __HIP_MEMORY_SCOPE_AGENT); }
DI unsigned xb_xcc_id() { return (unsigned)__builtin_amdgcn_s_getreg((3 << 11) | 20) & 0xFu; }
#define XB_SPIN(cond, bar) do { unsigned _sp = 0; while (cond) { __builtin_amdgcn_s_sleep(1); \
    if ((++_sp & 255u) == 0u) { if (xb_ld(&(bar)[XB_TMO])) break; if (_sp > XB_SPIN_CAP) { atomicAdd(&(bar)[XB_TMO], 1u); break; } } } } while (0)
DI void xcd_barrier_complete(unsigned* bar, unsigned x, unsigned G, unsigned& nloc, unsigned& nx) {
    unsigned sum, cnt, mine, sp = 0u;
    for (;;) {
        sum = 0u; cnt = 0u; mine = 0u;
#pragma unroll 1
        for (unsigned j = 0; j < 16; ++j) { const unsigned cj = xb_ld(&bar[XB_XCNT(j)]); sum += cj; cnt += (cj > 0u) ? 1u : 0u; mine = (j == x) ? cj : mine; }
        if (sum == G) break;
        __builtin_amdgcn_s_sleep(1);
        if ((++sp & 255u) == 0u) { if (xb_ld(&bar[XB_TMO])) break; if (sp > XB_SPIN_CAP) { atomicAdd(&bar[XB_TMO], 1u); break; } }
    }
    nloc = mine > 0u ? mine : 1u; nx = cnt > 0u ? cnt : 1u;
}
DI void xcd_barrier(unsigned* bar, volatile LAS unsigned* st, const int wid) {
    asm volatile("" : "+s"(bar));
    asm volatile("s_waitcnt vmcnt(0)" ::: "memory");
    __syncthreads();
    if (wid == 0 && lane_fresh() == 0) {
        const unsigned x = xb_xcc_id();
        __builtin_amdgcn_s_waitcnt(0);
        const unsigned nloc = st[0], nx = st[1];
        const unsigned old = xb_add(&bar[XB_XSUB(x)], 1u);
        const unsigned gen = old / nloc;
        if (old + 1u == (gen + 1u) * nloc) {
            __builtin_amdgcn_fence(__ATOMIC_RELEASE, "agent");
            asm volatile("s_waitcnt vmcnt(0)" ::: "memory");
            const unsigned og = xb_add(&bar[XB_TOP], 1u);
            const unsigned tg = og / nx;
            if (og + 1u == (tg + 1u) * nx) xb_add(&bar[XB_TOPGEN], 1u);
            else XB_SPIN(xb_ld(&bar[XB_TOPGEN]) == tg, bar);
            __builtin_amdgcn_fence(__ATOMIC_ACQUIRE, "agent");
            xb_add(&bar[XB_XGEN(x)], 1u);
            asm volatile("s_waitcnt vmcnt(0)" ::: "memory");
        } else {
            XB_SPIN(xb_ld(&bar[XB_XGEN(x)]) == gen, bar);
            __builtin_amdgcn_fence(__ATOMIC_ACQUIRE, "agent");
            asm volatile("s_waitcnt vmcnt(0)" ::: "memory");
        }
    }
    __syncthreads();
}

__global__ void __launch_bounds__(512) mega(Params P) {
    extern __shared__ __attribute__((aligned(16))) unsigned char shm[];
    LAS unsigned char* lds = (LAS unsigned char*)shm;
    cg::grid_group grid = cg::this_grid();
    const int wid = __builtin_amdgcn_readfirstlane(threadIdx.x >> 6);
    const int G = gridDim.x, c = blockIdx.x;
    const int gthreads = G * 512;
#define LANE lane_fresh()
#define TID (wid * 64 + lane_fresh())
#define GTID (c * 512 + wid * 64 + lane_fresh())
    unsigned char* ws = P.ws;
    float* ssb = (float*)(ws + WS_MISC + 65536);
    bf16_t* hbA = (bf16_t*)(ws + WS_HBA);
    bf16_t* Ucat = (bf16_t*)(ws + WS_UCAT);
    bf16_t* SG = (bf16_t*)(ws + WS_SGGA); bf16_t* GA = SG + (size_t)T * 512; bf16_t* hbB = SG;
    bf16_t* Qb = (bf16_t*)(ws + WS_QK); bf16_t* Kb = Qb + (size_t)T * 512; bf16_t* pp = Qb;
    bf16_t* VT = (bf16_t*)(ws + WS_VT); bf16_t* zb = (bf16_t*)(ws + WS_ZB);
    bf16_t* cat = (bf16_t*)(ws + WS_CAT);
    float* Sbuf = (float*)(ws + WS_SBUF);
    bf16_t* pb = (bf16_t*)(ws + WS_PB);

    unsigned* bar = (unsigned*)(ws + WS_MISC + 786432);
    volatile LAS unsigned* xst = (volatile LAS unsigned*)(lds + STAGE_BYTES);
#define GSYNC() xcd_barrier(bar, xst, wid)
    if (wid == 0 && LANE == 0) { xst[0] = 0u; xst[1] = 0u; (void)xb_add(&bar[XB_XCNT(xb_xcc_id())], 1u); }
    if (P.ws == nullptr) grid.sync();
    for (int rep = 0; rep < REP_P0; ++rep) {
    const int role = (c >> 3) & 1, sc = ((c >> 4) << 3) | (c & 7), SG_ = G >> 1;
    const int sthreads = SG_ * 512;
    if (role == 0) ssm_prep(P, sc >> 1, sc & 1, lds, TID);
    { const int lane = LANE; LAS float* scr = (LAS float*)lds + wid * (64 * 33); const int l = role == 0 ? 1 : 0;
    for (int i = sc * 512 + TID; i < 3 * T; i += SG_ * 512) if (role == 1) ssb[T + i] = 0.f;
    {
        transpose_w<5>(P.w_in + (size_t)l * 1024 * 3072, 1024, 3072, (bf16_t*)(ws + WS_WIN) + (size_t)l * 3072 * 1024, P.mix_g + l * 1024, scr, sc * 8 + wid, SG_ * 8, lane);
        transpose_w<4>(P.w_glu + (size_t)l * 512 * 1024, 512, 1024, (bf16_t*)(ws + WS_WGLU) + (size_t)l * 1024 * 512, nullptr, scr, sc * 8 + wid, SG_ * 8, lane);
        transpose_w<3>(P.w_out + (size_t)l * 1024 * 1024, 1024, 1024, (bf16_t*)(ws + WS_WOUT) + (size_t)l * 1024 * 1024, nullptr, scr, sc * 8 + wid, SG_ * 8, lane);
        transpose_w<3>(P.w_pg + (size_t)l * 1024 * 1024, 1024, 1024, (bf16_t*)(ws + WS_WPG) + (size_t)l * 1024 * 1024, P.ple_g + l * 1024, scr, sc * 8 + wid, SG_ * 8, lane);
        transpose_w<3>(P.w_pp + (size_t)l * 256 * 1024, 256, 1024, (bf16_t*)(ws + WS_WPP) + (size_t)l * 1024 * 256, nullptr, scr, sc * 8 + wid, SG_ * 8, lane);
    } }
    if (role == 1)
    for (int row = (sc * 8 + wid) * 2; row < T; row += SG_ * 16) {
        const int lane = LANE;
        const f32x4* xr = (const f32x4*)(P.x + (size_t)row * 1024); f32x4 v[2][4];
#pragma unroll
        for (int r2 = 0; r2 < 2; ++r2)
#pragma unroll
            for (int j = 0; j < 4; ++j) v[r2][j] = xr[r2 * 256 + lane + 64 * j];
#pragma unroll
        for (int r2 = 0; r2 < 2; ++r2) { float s = 0.f;
#pragma unroll
            for (int j = 0; j < 4; ++j) { const f32x4 q = v[r2][j]; s += (q[0] * q[0] + q[1] * q[1]) + (q[2] * q[2] + q[3] * q[3]);
                u32x2 w; w.x = cvt_pk_bf16(q[0], q[1]); w.y = cvt_pk_bf16(q[2], q[3]); *(u32x2*)(hbA + (size_t)(row + r2) * 1024 + (lane + 64 * j) * 4) = w; }
#pragma unroll
            for (int o = 1; o < 64; o <<= 1) s += __shfl_xor(s, o);
            if (lane == 0) ssb[row + r2] = s; }
    }
    { const size_t pbase = (size_t)(role == 0 ? 1 : 0) * T * 256 / 8, pend = pbase + (size_t)T * 256 / 8;
    for (size_t i = pbase + sc * 512 + TID; i < pend; i += (size_t)4 * sthreads) {
        f32x4 a[4], b[4];
#pragma unroll
        for (int q = 0; q < 4; ++q) { const size_t ii = i + (size_t)q * sthreads; if (ii < pend) { a[q] = ((const f32x4*)P.p)[2 * ii]; b[q] = ((const f32x4*)P.p)[2 * ii + 1]; } }
#pragma unroll
        for (int q = 0; q < 4; ++q) { const size_t ii = i + (size_t)q * sthreads; if (ii < pend) {
            u32x4 o; o.x = cvt_pk_bf16(a[q][0], a[q][1]); o.y = cvt_pk_bf16(a[q][2], a[q][3]); o.z = cvt_pk_bf16(b[q][0], b[q][1]); o.w = cvt_pk_bf16(b[q][2], b[q][3]);
            ((u32x4*)pb)[ii] = o; } }
    }
    }
    }
    if (wid == 0 && LANE == 0) { unsigned nloc, nx; xcd_barrier_complete(bar, xb_xcc_id(), G, nloc, nx); xst[0] = nloc; xst[1] = nx; }
    GSYNC();

    auto layer = [&](const int l) __attribute__((always_inline)) {
        float* ssIn = ssb + (size_t)(2 * l) * T; float* ssMid = ssb + (size_t)(2 * l + 1) * T; float* ssNext = ssb + (size_t)(2 * l + 2 > 3 ? 3 : 2 * l + 2) * T;
        { Gemm g{hbA, (const bf16_t*)(ws + WS_WIN) + (size_t)l * 3072 * 1024, 1024, 1024, 1024, 0, 0};
          Order S; S.init(T / 256, 12, 1, G, c);
          EpiIn E{ssIn, Ucat, SG, GA, Qb, Kb, VT, P.q_g + l * 64, P.k_g + l * 64};
          for (int rep = 0; rep < REP_INPROJ; ++rep) gemm_phase(lds, g, S, E, wid); }
        GSYNC();
        { Gemm g{Ucat, (const bf16_t*)(ws + WS_W1) + (size_t)l * 32 * 256 * 512, 640, 512, 512, (size_t)1024 * 640, (size_t)256 * 512};
          Order S; S.init(4, 1, 32, G, c);
          EpiS E{Sbuf};
          for (int rep = 0; rep < REP_GEMMS; ++rep) gemm_phase(lds, g, S, E, wid); }
        if (c < 128) {
            asm volatile("s_waitcnt vmcnt(0)" ::: "memory"); __syncthreads();
            const int lane = LANE, seg = lane >> 4, pl = lane & 15;
            const int q_ = c >> 3, L_ = ((c & 7) * 4 + (q_ >> 2)) * 4 + (q_ & 3);
            const int pq = wid & 3, g = L_ >> 2, b = 2 * (L_ & 3) + (wid >> 2), p = pq * 16 + pl;
            const float* a32 = (const float*)(ws + WS_MISC) + (size_t)((l * 32 + g) * 64 + p) * 2; const float ar = a32[0], ai = a32[1];
            const size_t row0 = (size_t)g * 1024 + b * 128 + seg * 32;
            const float* __restrict__ Sp = Sbuf + row0 * 128 + p;
            float sr[32], si[32];
#pragma unroll
            for (int j = 0; j < 32; ++j) { sr[j] = Sp[(size_t)j * 128]; si[j] = Sp[(size_t)j * 128 + 64]; }
            float hr = 0.f, hi = 0.f, wr_ = 1.f, wi_ = 0.f;
#pragma unroll
            for (int j = 0; j < 32; ++j) { const float nr = ar * hr - ai * hi + sr[j], ni = ar * hi + ai * hr + si[j]; hr = nr; hi = ni;
                const float xr = ar * wr_ - ai * wi_, xi = ar * wi_ + ai * wr_; wr_ = xr; wi_ = xi; }
            const float e0r = __shfl(hr, pl), e0i = __shfl(hi, pl), e1r = __shfl(hr, pl + 16), e1i = __shfl(hi, pl + 16), e2r = __shfl(hr, pl + 32), e2i = __shfl(hi, pl + 32);
            const float h1r = e0r, h1i = e0i;
            const float h2r = wr_ * h1r - wi_ * h1i + e1r, h2i = wr_ * h1i + wi_ * h1r + e1i;
            const float h3r = wr_ * h2r - wi_ * h2i + e2r, h3i = wr_ * h2i + wi_ * h2r + e2i;
            const float cinr = seg == 0 ? 0.f : seg == 1 ? h1r : seg == 2 ? h2r : h3r, cini = seg == 0 ? 0.f : seg == 1 ? h1i : seg == 2 ? h2i : h3i;
            bf16_t* __restrict__ Up = Ucat + row0 * 640 + 512 + p;
            hr = 0.f; hi = 0.f; float cr_ = cinr, ci_ = cini;
#pragma unroll
            for (int j = 0; j < 32; ++j) {
                const unsigned pk = cvt_pk_bf16(hr + cr_, hi + ci_);
                Up[(size_t)j * 640] = (bf16_t)(pk & 0xffffu); Up[(size_t)j * 640 + 64] = (bf16_t)(pk >> 16);
                const float nr = ar * hr - ai * hi + sr[j], ni = ar * hi + ai * hr + si[j]; hr = nr; hi = ni;
                const float xr = ar * cr_ - ai * ci_, xi = ar * ci_ + ai * cr_; cr_ = xr; ci_ = xi; }
            asm volatile("s_waitcnt vmcnt(0)" ::: "memory"); __syncthreads();
            { Gemm gy{Ucat, (const bf16_t*)(ws + WS_TOEP) + (size_t)l * 32 * 512 * 640, 640, 640, 640, (size_t)1024 * 640, (size_t)512 * 640};
              Order SY; SY.nwg = -1; SY.nM = g; SY.nN = L_ & 3; SY.lim = 2; SY.total = 0; SY.G = 0; SY.c = 0;
              EpiY EY{Ucat, P.dsk + l * 512, zb};
              for (int rep = 0; rep < REP_Y; ++rep) gemm_phase(lds, gy, SY, EY, wid); }
        }
        for (int rep = 0; rep < REP_ATTN; ++rep)
        {
            const int nit = c < 128 ? 1 : 7, base = c < 128 ? (c * 8 + wid) : 1024 + (c - 128) * 56 + wid;
            for (int j = 0; j < nit; ++j) attn_item(base + 8 * j, Qb, Kb, VT, GA, cat, LANE, (LAS float*)(lds + wid * 8704)); }
        GSYNC();
        { Gemm g{zb, (const bf16_t*)(ws + WS_WGLU) + (size_t)l * 1024 * 512, 512, 512, 512, 0, 0};
          Order S; S.init(T / 256, 4, 1, G, c);
          EpiGlu E{P.b_glu + l * 1024, SG, cat};
          for (int rep = 0; rep < REP_GLU; ++rep) gemm_phase(lds, g, S, E, wid); }
        { Gemm g{pb + (size_t)l * T * 256, (const bf16_t*)(ws + WS_WPP) + (size_t)l * 1024 * 256, 256, 256, 256, 0, 0};
          Order S; S.init(T / 256, 4, 1, G, c);
          EpiPP E{pp};
          for (int rep = 0; rep < REP_PP; ++rep) gemm_phase(lds, g, S, E, wid); }
        GSYNC();
        { Gemm g{cat, (const bf16_t*)(ws + WS_WOUT) + (size_t)l * 1024 * 1024, 1024, 1024, 1024, 0, 0};
          Order S; S.init(T / 256, 4, 1, G, c);
          EpiOut E{hbA, hbB, ssMid};
          gemm_phase(lds, g, S, E, wid); }
        GSYNC();
        { Gemm g{hbB, (const bf16_t*)(ws + WS_WPG) + (size_t)l * 1024 * 1024, 1024, 1024, 1024, 0, 0};
          Order S; S.init(T / 256, 4, 1, G, c);
          EpiPle E{ssMid, hbB, P.out, pp, hbA, ssNext, l == 1 ? 1 : 0};
          gemm_phase(lds, g, S, E, wid); }
        if (l == 0) GSYNC();
    };
    layer(0); layer(1);
}

extern "C" void kernel_launch(void* const* d_in, const int* in_sizes, int n_in, void* d_out, int out_size, void* d_ws, size_t ws_size, hipStream_t stream) {
    static int grid = 0;
    if (grid == 0) {
        if (n_in != 20 || ws_size < WS_END) { fprintf(stderr, "kernel_launch: unexpected inputs (n_in %d, ws %zu < %zu)\n", n_in, ws_size, (size_t)WS_END); grid = -1; return; }
        int dev = 0, cus = 0, per_cu = 0;
        hipGetDevice(&dev); hipDeviceGetAttribute(&cus, hipDeviceAttributeMultiprocessorCount, dev);
        if (hipFuncSetAttribute((const void*)mega, hipFuncAttributeMaxDynamicSharedMemorySize, LDS_BYTES) != hipSuccess) { fprintf(stderr, "hipFuncSetAttribute failed\n"); grid = -1; return; }
        if (hipOccupancyMaxActiveBlocksPerMultiprocessor(&per_cu, (const void*)mega, 512, LDS_BYTES) != hipSuccess || per_cu < 1) { fprintf(stderr, "occupancy query: %d\n", per_cu); per_cu = 1; }
        (void)hipGetLastError();
        if (cus < 256) { fprintf(stderr, "kernel_launch: built for a 256-CU device (static work partition over 256 workgroups), found %d CUs; nothing launched\n", cus); grid = -1; return; }
        grid = 256;
    }
    if (grid < 0) return;
    if (hipMemsetAsync((char*)d_ws + WS_MISC + 786432, 0, XCD_BAR_WORDS * 4, stream) != hipSuccess) { fprintf(stderr, "kernel_launch: hipMemsetAsync failed\n"); return; }
    Params P{};
    const float** pp = (const float**)&P;
    for (int i = 0; i < 20; ++i) pp[i] = (const float*)d_in[i];
    P.out = (float*)d_out; P.ws = (unsigned char*)d_ws;
    void* args[] = {&P};
    hipError_t e = hipLaunchCooperativeKernel((const void*)mega, dim3(grid), dim3(512), args, LDS_BYTES, stream);
    if (e != hipSuccess) fprintf(stderr, "cooperative launch failed: %s (grid %d)\n", hipGetErrorString(e), grid);
}
```

```cpp
#ifndef REP_P0
#define REP_P0 1
#define REP_INPROJ 1
#define REP_ATTN 1
#define REP_SCAN 1
#define REP_SYNC 1
#define REP_GEMMS 1
#define REP_PP 1
#define REP_Y 1
#define REP_GLU 1
#endif
#include <hip/hip_runtime.h>
#include <hip/hip_cooperative_groups.h>
#include <cstdio>
namespace cg = cooperative_groups;

#define LAS __attribute__((address_space(3)))
#define DI __device__ __forceinline__
typedef unsigned short bf16_t;
typedef short bf16x8 __attribute__((ext_vector_type(8)));
typedef float f32x4 __attribute__((ext_vector_type(4)));
typedef float f32x16 __attribute__((ext_vector_type(16)));
typedef unsigned u32x4 __attribute__((ext_vector_type(4)));
typedef unsigned u32x2 __attribute__((ext_vector_type(2)));

constexpr int T = 32768, SEQ = 4096;
constexpr int BM = 256, BK = 64, HALF = 128, HTB = HALF * BK * 2, STAGE_BYTES = 8 * HTB, NXCD = 8, WGM = 2;
constexpr int LDS_DUMMY = STAGE_BYTES + 16;
constexpr int LDS_BYTES = STAGE_BYTES + 16 + 2048;

constexpr size_t MBy = 1u << 20;
constexpr size_t WS_WIN = 0;
constexpr size_t WS_WGLU = WS_WIN + 12 * MBy;
constexpr size_t WS_WOUT = WS_WGLU + 2 * MBy;
constexpr size_t WS_WPG = WS_WOUT + 4 * MBy;
constexpr size_t WS_WPP = WS_WPG + 4 * MBy;
constexpr size_t WS_W1 = WS_WPP + 1 * MBy;
constexpr size_t WS_TOEP = WS_W1 + 16 * MBy;
constexpr size_t WS_MISC = WS_TOEP + 40 * MBy;
constexpr size_t WS_HBA = WS_MISC + 1 * MBy;
constexpr size_t WS_UCAT = WS_HBA + 64 * MBy;
constexpr size_t WS_SGGA = WS_UCAT + 40 * MBy;
constexpr size_t WS_QK = WS_SGGA + 64 * MBy;
constexpr size_t WS_VT = WS_QK + 64 * MBy;
constexpr size_t WS_CAT = WS_VT + 32 * MBy;
constexpr size_t WS_SBUF = WS_CAT + 64 * MBy;
constexpr size_t WS_PB = WS_SBUF + 16 * MBy;
constexpr size_t WS_ZB = WS_PB + 32 * MBy;
constexpr size_t WS_END = WS_ZB + 32 * MBy;

struct Params {
    const float *x, *p, *mix_g, *w_in, *a_re, *a_im, *log_dt, *b_re, *b_im, *c_re, *c_im, *dsk, *w_glu, *b_glu, *q_g, *k_g, *w_out, *ple_g, *w_pg, *w_pp;
    float* out; unsigned char* ws;
};

DI int lane_fresh() { int l; asm volatile("v_mbcnt_lo_u32_b32 %0, -1, 0\n\tv_mbcnt_hi_u32_b32 %0, -1, %0" : "=v"(l)); return l; }
DI unsigned cvt_pk_bf16(float lo, float hi) { unsigned r; asm volatile("v_cvt_pk_bf16_f32 %0, %1, %2" : "=v"(r) : "v"(lo), "v"(hi)); return r; }
DI float bf_lo(unsigned w) { return __uint_as_float(w << 16); }
DI float bf_hi(unsigned w) { return __uint_as_float(w & 0xffff0000u); }
DI float fsigmoid(float x) { return __builtin_amdgcn_rcpf(1.0f + __expf(-x)); }
DI float fsilu(float x) { return x * fsigmoid(x); }
DI float fgelu_tanh(float y) { const float u2 = 1.5957691216057308f * (y + 0.044715f * y * y * y); return y * fsigmoid(u2); }

DI int lds_byte(int r, int c) { const int st = (r >> 4) * 2 + (c >> 5), rr = r & 15, cc = c & 31, ob = rr * 64 + cc * 2; return st * 1024 + (ob ^ (((ob >> 9) & 1) << 5)); }
DI void stage_rc(int b, int& R, int& C) { const int st = b / 1024, sb = b % 1024, swz = sb ^ (((sb >> 9) & 1) << 5); R = (st >> 1) * 16 + swz / 64; C = (st & 1) * 32 + (swz % 64) / 2; }

struct Unit { int pm, pn, g; };
struct Gemm { const bf16_t* A; const bf16_t* Bt; int lda, ldb, K; size_t gsA, gsB; };
struct Order {
    int nM, nN, nwg, total, G, c, lim;
    DI void init(int nM_, int nN_, int nG, int G_, int c_) { nM = nM_; nN = nN_; nwg = nM * nN; total = nwg * nG; lim = total; G = G_; c = c_; asm volatile("" : "+s"(c)); }
    DI bool next(int i, Unit& u) const {
        if (nwg < 0) { if (i >= lim) return false; u.g = nM; u.pm = nN; u.pn = i; return true; }
        int L = i * G + c; if (L >= lim) return false;
        if (total > nwg) {
            const int gpx = (total / nwg) >> 3, q = (c >> 3) + (G >> 3) * i; if (q >= gpx * nwg) return false;
            L = ((c & 7) * gpx + q / nwg) * nwg + q % nwg; }
        u.g = L / nwg; int wgid = L - u.g * nwg;
        { const int q = nwg / NXCD, r = nwg % NXCD, xcd = wgid % NXCD, off = wgid / NXCD; wgid = (xcd < r ? xcd * (q + 1) : r * (q + 1) + (xcd - r) * q) + off; }
        const int nig = WGM * nN, gid = wgid / nig, fm = gid * WGM, gsz = (nM - fm) < WGM ? (nM - fm) : WGM;
        u.pm = fm + ((wgid % nig) % gsz); u.pn = (wgid % nig) / gsz; return true;
    }
};

template <class Epi>
DI void gemm_phase(LAS unsigned char* lds, const Gemm g, const Order& S, const Epi& E, const int wid) {
    const int lane = lane_fresh(), tid = wid * 64 + lane, wr = wid >> 2, wc = wid & 3, fr = lane & 15, fq = lane >> 4;
    const int K = g.K, nt = K / BK;
    unsigned voffA[2], voffB[2];
#pragma unroll
    for (int i = 0; i < 2; ++i) { int R, C; stage_rc(tid * 16 + i * 8192, R, C); voffA[i] = (unsigned)(R * g.lda + C) * 2u; voffB[i] = (unsigned)(R * g.ldb + C) * 2u; }
    const size_t kstep = (size_t)(BK * 2);
    const size_t hstepA = (size_t)HALF * g.lda * 2, hstepB = (size_t)HALF * g.ldb * 2;
    const size_t tstepA = 2 * hstepA, tstepB = 2 * hstepB;
    const unsigned ldsw = (unsigned)wid * 1024u;
    const int aoff = lds_byte(wr * 64 + fr, fq * 8), boff = lds_byte(wc * 32 + fr, fq * 8);
#define PG8_SA(b, h) (((b) * 2 + (h)) * HTB)
#define PG8_SB(b, h) ((4 + (b) * 2 + (h)) * HTB)
#define PG8_STAGE(bufoff, gbase, voff) do { _Pragma("unroll") for (int _i = 0; _i < 2; ++_i) \
        __builtin_amdgcn_global_load_lds((const unsigned*)((const char*)(gbase) + (voff)[_i]), (LAS unsigned*)(lds + (bufoff) + ldsw + _i * 8192), 16, 0, 0); } while (0)
#define PG8_LDA(dst, b, h) do { _Pragma("unroll") for (int m = 0; m < 4; ++m) _Pragma("unroll") for (int k = 0; k < 2; ++k) dst[m][k] = *(const LAS bf16x8*)(lds + PG8_SA(b, h) + aoff + m * 2048 + k * 1024); } while (0)
#define PG8_LDB(dst, b, h) do { _Pragma("unroll") for (int n = 0; n < 2; ++n) _Pragma("unroll") for (int k = 0; k < 2; ++k) dst[n][k] = *(const LAS bf16x8*)(lds + PG8_SB(b, h) + boff + n * 2048 + k * 1024); } while (0)
#define PG8_MMA(ai, bj, At, Bt) do { __builtin_amdgcn_s_setprio(1); _Pragma("unroll") for (int m = 0; m < 4; ++m) _Pragma("unroll") for (int n = 0; n < 2; ++n) _Pragma("unroll") for (int k = 0; k < 2; ++k) \
        acc[ai][bj][m][n] = __builtin_amdgcn_mfma_f32_16x16x32_bf16(Bt[n][k], At[m][k], acc[ai][bj][m][n], 0, 0, 0); __builtin_amdgcn_s_setprio(0); } while (0)
#define PG8_WAIT_V(n) asm volatile("s_waitcnt vmcnt(" #n ")" ::: "memory")
#define PG8_WAIT_L(n) asm volatile("s_waitcnt lgkmcnt(" #n ")" ::: "memory")
#define PG8_BAR __builtin_amdgcn_s_barrier()
#define PG8_SCHED __builtin_amdgcn_sched_barrier(0)
    Unit cur, nxt; int ui = 0;
    if (!S.next(0, cur)) return;
    f32x4 acc[2][2][4][2];
#pragma unroll
    for (int a = 0; a < 2; ++a)
#pragma unroll
        for (int b = 0; b < 2; ++b)
#pragma unroll
            for (int m = 0; m < 4; ++m)
#pragma unroll
                for (int n = 0; n < 2; ++n) acc[a][b][m][n] = (f32x4){0.f, 0.f, 0.f, 0.f};
    bf16x8 At[4][2], B0[2][2], B1[2][2];
    const char* cA = (const char*)(g.A + (size_t)cur.g * g.gsA) + (size_t)cur.pm * tstepA;
    const char* cB = (const char*)(g.Bt + (size_t)cur.g * g.gsB) + (size_t)cur.pn * tstepB;
    PG8_STAGE(PG8_SB(0, 0), cB, voffB); PG8_STAGE(PG8_SB(0, 1), cB + hstepB, voffB); PG8_STAGE(PG8_SA(0, 0), cA, voffA); PG8_STAGE(PG8_SA(0, 1), cA + hstepA, voffA);
    if (wr == 1) PG8_BAR;
    PG8_WAIT_V(2); PG8_BAR;
    PG8_STAGE(PG8_SB(1, 0), cB + kstep, voffB); PG8_STAGE(PG8_SA(1, 0), cA + kstep, voffA); PG8_STAGE(PG8_SB(1, 1), cB + hstepB + kstep, voffB);
    PG8_WAIT_V(6); PG8_BAR;
    for (;;) {
        const bool has_next = S.next(ui + 1, nxt);
        const char* nA = has_next ? (const char*)(g.A + (size_t)nxt.g * g.gsA) + (size_t)nxt.pm * tstepA : cA;
        const char* nB = has_next ? (const char*)(g.Bt + (size_t)nxt.g * g.gsB) + (size_t)nxt.pn * tstepB : cB;
        for (int t = 0; t < nt; t += 2) {
            const bool last = (t == nt - 2);
            const char* a1 = cA + (size_t)(t + 1) * kstep;
            const char* a2 = last ? nA : cA + (size_t)(t + 2) * kstep; const char* b2 = last ? nB : cB + (size_t)(t + 2) * kstep;
            const char* a3 = a2 + kstep; const char* b3 = b2 + kstep;
            if (t == nt - 2) E.prefetch(cur, lds, wid);
            PG8_LDB(B0, 0, 0); PG8_LDB(B1, 0, 1); PG8_SCHED; PG8_LDA(At, 0, 0); PG8_STAGE(PG8_SA(1, 1), a1 + hstepA, voffA);
            PG8_WAIT_V(8); PG8_WAIT_L(0); PG8_BAR; PG8_MMA(0, 0, At, B0); PG8_MMA(0, 1, At, B1); PG8_BAR; PG8_SCHED;
            PG8_LDA(At, 0, 1); PG8_STAGE(PG8_SB(0, 0), b2, voffB); PG8_STAGE(PG8_SB(0, 1), b2 + hstepB, voffB); PG8_STAGE(PG8_SA(0, 0), a2, voffA);
            PG8_WAIT_V(8); PG8_WAIT_L(0); PG8_BAR; PG8_MMA(1, 0, At, B0); PG8_MMA(1, 1, At, B1); PG8_BAR; PG8_SCHED;
            PG8_LDB(B0, 1, 0); PG8_LDB(B1, 1, 1); PG8_SCHED; PG8_LDA(At, 1, 0); PG8_STAGE(PG8_SA(0, 1), a2 + hstepA, voffA);
            PG8_WAIT_V(8); PG8_WAIT_L(0); PG8_BAR; PG8_MMA(0, 0, At, B0); PG8_MMA(0, 1, At, B1); PG8_BAR; PG8_SCHED;
            PG8_LDA(At, 1, 1); PG8_STAGE(PG8_SB(1, 0), b3, voffB); PG8_STAGE(PG8_SB(1, 1), b3 + hstepB, voffB); PG8_STAGE(PG8_SA(1, 0), a3, voffA);
            PG8_WAIT_V(8); PG8_WAIT_L(0); PG8_BAR; PG8_MMA(1, 0, At, B0); PG8_MMA(1, 1, At, B1); PG8_BAR; PG8_SCHED;
        }
        if (wr == 0) PG8_BAR;
        { const int le = lane_fresh(); E(acc, cur, wr, wc, le & 15, le >> 4); }
        if (!has_next) break;
#pragma unroll
        for (int a = 0; a < 2; ++a)
#pragma unroll
            for (int b = 0; b < 2; ++b)
#pragma unroll
                for (int m = 0; m < 4; ++m)
#pragma unroll
                    for (int n = 0; n < 2; ++n) acc[a][b][m][n] = (f32x4){0.f, 0.f, 0.f, 0.f};
        cur = nxt; cA = nA; cB = nB; ++ui;
        if (wr == 1) PG8_BAR;
    }
    PG8_WAIT_V(0);
    PG8_BAR;
#undef PG8_SA
#undef PG8_SB
#undef PG8_STAGE
#undef PG8_LDA
#undef PG8_LDB
#undef PG8_MMA
#undef PG8_WAIT_V
#undef PG8_WAIT_L
#undef PG8_BAR
#undef PG8_SCHED
}

#define EPI_ROWS _Pragma("unroll") for (int ai = 0; ai < 2; ++ai) _Pragma("unroll") for (int m = 0; m < 4; ++m) if ((__extension__({ if (m == 0) asm volatile("" ::: "memory"); 1; })))
#define EPI_ROWS_NF _Pragma("unroll") for (int ai = 0; ai < 2; ++ai) _Pragma("unroll") for (int m = 0; m < 4; ++m)
#define EPI_COLS _Pragma("unroll") for (int bj = 0; bj < 2; ++bj) _Pragma("unroll") for (int n = 0; n < 2; ++n)

struct EpiIn {
    DI void prefetch(const Unit& u, LAS unsigned char* lds, int wid) const {
        if (wid < 4) __builtin_amdgcn_global_load_lds((const unsigned*)(ss + u.pm * BM + wid * 64 + lane_fresh()), (LAS unsigned*)(lds + LDS_DUMMY + wid * 256), 4, 0, 0);
    }
    const float* ss; bf16_t *Ucat, *SG, *GA, *Q, *Kb, *VT; const float *qg, *kg;
    DI void operator()(const f32x4 (&acc)[2][2][4][2], const Unit& u, int wr, int wc, int fr, int fq) const {
        const int type = u.pn >> 1, hf = u.pn & 1;
        float rsv[2][4];
        EPI_ROWS_NF rsv[ai][m] = ss[u.pm * BM + ai * HALF + wr * 64 + m * 16 + fr];
        EPI_ROWS_NF rsv[ai][m] = rsqrtf(rsv[ai][m] * (1.f / 1024.f) + 1e-6f);
#define EPI_BJ _Pragma("unroll") for (int bj = 0; bj < 2; ++bj)
#define PACK8(w, a0, a1) do { w.x = cvt_pk_bf16(a0[0], a0[1]); w.y = cvt_pk_bf16(a0[2], a0[3]); w.z = cvt_pk_bf16(a1[0], a1[1]); w.w = cvt_pk_bf16(a1[2], a1[3]); } while (0)
        if (type == 0) {
            EPI_ROWS_NF { const int row = u.pm * BM + ai * HALF + wr * 64 + m * 16 + fr; const float rs = rsv[ai][m];
                EPI_BJ { const f32x4 v0 = acc[ai][bj][m][0] * rs, v1 = acc[ai][bj][m][1] * rs; const int g = 16 * hf + 4 * wc + 2 * bj + (fq >> 1);
                    u32x4 w; PACK8(w, v0, v1);
                    *(u32x4*)(Ucat + ((size_t)(g * 1024 + (row >> 5)) * 640 + (row & 31) * 16 + 8 * (fq & 1))) = w; } }
        } else if (type == 1 || type == 5) {
            bf16_t* dst = type == 1 ? SG : GA;
            EPI_ROWS_NF { const int row = u.pm * BM + ai * HALF + wr * 64 + m * 16 + fr; const float rs = rsv[ai][m];
                EPI_BJ { f32x4 v0 = acc[ai][bj][m][0] * rs, v1 = acc[ai][bj][m][1] * rs; const int cs = 256 * hf + 64 * wc + 32 * bj + 8 * fq;
#pragma unroll
                    for (int j = 0; j < 4; ++j) { v0[j] = fsilu(v0[j]); v1[j] = fsilu(v1[j]); }
                    u32x4 w; PACK8(w, v0, v1);
                    *(u32x4*)(dst + (size_t)row * 512 + cs) = w; } }
        } else if (type == 2 || type == 3) {
            bf16_t* dst = type == 2 ? Q : Kb; const float* gam = type == 2 ? qg : kg; const float sc = type == 2 ? 0.125f : 1.0f;
            f32x4 gv[2][2];
            EPI_COLS gv[bj][n] = *(const f32x4*)(gam + 32 * bj + 8 * fq + 4 * n) * sc;
            EPI_ROWS_NF { const int row = u.pm * BM + ai * HALF + wr * 64 + m * 16 + fr; const float rs = rsv[ai][m];
                f32x4 v[2][2]; float s = 0.f;
                EPI_COLS { v[bj][n] = acc[ai][bj][m][n] * rs; s += (v[bj][n][0] * v[bj][n][0] + v[bj][n][1] * v[bj][n][1]) + (v[bj][n][2] * v[bj][n][2] + v[bj][n][3] * v[bj][n][3]); }
                s += __shfl_xor(s, 16); s += __shfl_xor(s, 32);
                const float ri = rsqrtf(s * (1.f / 64.f) + 1e-6f);
                EPI_BJ { const f32x4 o0 = v[bj][0] * ri * gv[bj][0], o1 = v[bj][1] * ri * gv[bj][1]; const int cs = 256 * hf + 64 * wc + 32 * bj + 8 * fq;
                    u32x4 w; PACK8(w, o0, o1);
                    {
                        const int key = row & 4095; (void)cs;
                        *(u32x4*)(dst + (((size_t)((row >> 12) * 8 + 4 * hf + wc)) << 18) + (key >> 5) * 2048 + (2 * bj + (fq >> 1)) * 512 + (key & 31) * 16 + 8 * (fq & 1)) = w; } } }
        } else {
            EPI_ROWS_NF { const int row = u.pm * BM + ai * HALF + wr * 64 + m * 16 + fr; const float rs = rsv[ai][m];
                const int b = row >> 12, s = row & 4095, head = 4 * hf + wc;
                EPI_COLS { const f32x4 v = acc[ai][bj][m][n] * rs;
                    const unsigned w0 = cvt_pk_bf16(v[0], v[1]), w1 = cvt_pk_bf16(v[2], v[3]);
                    bf16_t* o = VT + (((size_t)(b * 8 + head)) << 18) + (s >> 5) * 2048 + bj * 1024 + ((s >> 4) & 1) * 512 + (8 * fq + 4 * n) * 16 + (s & 15);
                    o[0] = (bf16_t)(w0 & 0xffffu); o[16] = (bf16_t)(w0 >> 16); o[32] = (bf16_t)(w1 & 0xffffu); o[48] = (bf16_t)(w1 >> 16); } }
        }
#undef EPI_BJ
#undef PACK8
    }
};
struct EpiS {
    DI void prefetch(const Unit&, LAS unsigned char*, int) const {}
    float* Sbuf;
    DI void operator()(const f32x4 (&acc)[2][2][4][2], const Unit& u, int wr, int wc, int fr, int fq) const {
        EPI_ROWS { const int R = u.pm * BM + ai * HALF + wr * 64 + m * 16 + fr;
#pragma unroll
            for (int n = 0; n < 2; ++n) *(f32x4*)(Sbuf + ((size_t)(u.g * 1024 + R) * 128 + 32 * wc + 16 * n + 4 * fq)) = acc[ai][0][m][n]; }
    }
};
struct EpiY {
    DI void prefetch(const Unit&, LAS unsigned char*, int) const {}
    const bf16_t* Ucat; const float* dsk; bf16_t* zb;
    DI void operator()(const f32x4 (&acc)[2][2][4][2], const Unit& u, int wr, int wc, int fr, int fq) const {
        const int h0 = 8 * (fq & 1);
        const f32x4 dv0 = *(const f32x4*)(dsk + u.g * 16 + h0), dv1 = *(const f32x4*)(dsk + u.g * 16 + h0 + 4);
        EPI_ROWS { const int R = u.pm * BM + ai * HALF + wr * 64 + m * 16 + fr;
#pragma unroll
            for (int bj = 0; bj < 2; ++bj) { const int ncol = u.pn * BM + bj * HALF + 32 * wc + 8 * fq;
                const u32x4 ub = *(const u32x4*)(Ucat + ((size_t)(u.g * 1024 + R) * 640 + ncol));
                f32x4 y0 = acc[ai][bj][m][0], y1 = acc[ai][bj][m][1];
                y0[0] += dv0[0] * bf_lo(ub.x); y0[1] += dv0[1] * bf_hi(ub.x); y0[2] += dv0[2] * bf_lo(ub.y); y0[3] += dv0[3] * bf_hi(ub.y);
                y1[0] += dv1[0] * bf_lo(ub.z); y1[1] += dv1[1] * bf_hi(ub.z); y1[2] += dv1[2] * bf_lo(ub.w); y1[3] += dv1[3] * bf_hi(ub.w);
                u32x4 w; w.x = cvt_pk_bf16(fgelu_tanh(y0[0]), fgelu_tanh(y0[1])); w.y = cvt_pk_bf16(fgelu_tanh(y0[2]), fgelu_tanh(y0[3]));
                w.z = cvt_pk_bf16(fgelu_tanh(y1[0]), fgelu_tanh(y1[1])); w.w = cvt_pk_bf16(fgelu_tanh(y1[2]), fgelu_tanh(y1[3]));
                const int token = R * 32 + (ncol >> 4);
                *(u32x4*)(zb + (size_t)token * 512 + u.g * 16 + h0) = w; } }
    }
};
struct EpiGlu {
    DI void prefetch(const Unit& u, LAS unsigned char* lds, int wid) const {
        const int id = wid * 64 + lane_fresh(), row = id >> 1, seg = id & 1;
        __builtin_amdgcn_global_load_lds((const unsigned*)(SG + (size_t)(u.pm * BM + row) * 512 + u.pn * 128 + seg * 64), (LAS unsigned*)(lds + LDS_DUMMY + wid * 256), 4, 0, 0);
    }
    const float* bglu; const bf16_t* SG; bf16_t* cat;
    DI void operator()(const f32x4 (&acc)[2][2][4][2], const Unit& u, int wr, int wc, int fr, int fq) const {
        const int ch = u.pn * 128 + 32 * wc + 8 * fq;
        f32x4 bv[2], bg[2];
#pragma unroll
        for (int n = 0; n < 2; ++n) { bv[n] = *(const f32x4*)(bglu + ch + 4 * n); bg[n] = *(const f32x4*)(bglu + 512 + ch + 4 * n); }
        EPI_ROWS { const int row = u.pm * BM + ai * HALF + wr * 64 + m * 16 + fr;
            const f32x4 v0 = acc[ai][0][m][0] + bv[0], g0 = acc[ai][1][m][0] + bg[0], v1 = acc[ai][0][m][1] + bv[1], g1 = acc[ai][1][m][1] + bg[1];
            const u32x4 sg = *(const u32x4*)(SG + (size_t)row * 512 + ch);
            u32x4 w;
            w.x = cvt_pk_bf16(v0[0] * fsigmoid(g0[0]) * bf_lo(sg.x), v0[1] * fsigmoid(g0[1]) * bf_hi(sg.x)); w.y = cvt_pk_bf16(v0[2] * fsigmoid(g0[2]) * bf_lo(sg.y), v0[3] * fsigmoid(g0[3]) * bf_hi(sg.y));
            w.z = cvt_pk_bf16(v1[0] * fsigmoid(g1[0]) * bf_lo(sg.z), v1[1] * fsigmoid(g1[1]) * bf_hi(sg.z)); w.w = cvt_pk_bf16(v1[2] * fsigmoid(g1[2]) * bf_lo(sg.w), v1[3] * fsigmoid(g1[3]) * bf_hi(sg.w));
            *(u32x4*)(cat + (size_t)row * 1024 + ch) = w; }
    }
};
struct EpiOut {
    DI void prefetch(const Unit& u, LAS unsigned char* lds, int wid) const {
        const int tid = wid * 64 + lane_fresh();
#pragma unroll
        for (int i = 0; i < 2; ++i) { const int id = tid + 512 * i, row = id >> 2, seg = id & 3;
            __builtin_amdgcn_global_load_lds((const unsigned*)(hin + (size_t)(u.pm * BM + row) * 1024 + u.pn * BM + seg * 64), (LAS unsigned*)(lds + LDS_DUMMY + wid * 256), 4, 0, 0); }
    }
    const bf16_t* hin; bf16_t* hb; float* ss;
    DI void operator()(const f32x4 (&acc)[2][2][4][2], const Unit& u, int wr, int wc, int fr, int fq) const {
        EPI_ROWS { const int row = u.pm * BM + ai * HALF + wr * 64 + m * 16 + fr; float s = 0.f;
#pragma unroll
            for (int bj = 0; bj < 2; ++bj) { const size_t off = (size_t)row * 1024 + u.pn * BM + bj * HALF + 32 * wc + 8 * fq;
                const u32x4 rw = *(const u32x4*)(hin + off); f32x4 h0 = acc[ai][bj][m][0], h1_ = acc[ai][bj][m][1];
                h0[0] += bf_lo(rw.x); h0[1] += bf_hi(rw.x); h0[2] += bf_lo(rw.y); h0[3] += bf_hi(rw.y); h1_[0] += bf_lo(rw.z); h1_[1] += bf_hi(rw.z); h1_[2] += bf_lo(rw.w); h1_[3] += bf_hi(rw.w);
                u32x4 w; w.x = cvt_pk_bf16(h0[0], h0[1]); w.y = cvt_pk_bf16(h0[2], h0[3]); w.z = cvt_pk_bf16(h1_[0], h1_[1]); w.w = cvt_pk_bf16(h1_[2], h1_[3]); *(u32x4*)(hb + off) = w;
                s += ((h0[0] * h0[0] + h0[1] * h0[1]) + (h0[2] * h0[2] + h0[3] * h0[3])) + ((h1_[0] * h1_[0] + h1_[1] * h1_[1]) + (h1_[2] * h1_[2] + h1_[3] * h1_[3])); }
            s += __shfl_xor(s, 16); s += __shfl_xor(s, 32);
            if (fq == 0) atomicAdd(ss + row, s); }
    }
};
struct EpiPle {
    DI void prefetch(const Unit& u, LAS unsigned char* lds, int wid) const {
        const int tid = wid * 64 + lane_fresh();
#pragma unroll
        for (int i = 0; i < 2; ++i) { const int id = tid + 512 * i, row = id >> 2, seg = id & 3; const size_t off = (size_t)(u.pm * BM + row) * 1024 + u.pn * BM + seg * 64;
            __builtin_amdgcn_global_load_lds((const unsigned*)(pp + off), (LAS unsigned*)(lds + LDS_DUMMY + wid * 256), 4, 0, 0); }
        if (wid < 4) __builtin_amdgcn_global_load_lds((const unsigned*)(ss1 + u.pm * BM + tid), (LAS unsigned*)(lds + LDS_DUMMY + wid * 256), 4, 0, 0);
    }
    const float* ss1; const bf16_t* h1; float* h; const bf16_t* pp; bf16_t* hb; float* ss2; int last;
    DI void operator()(const f32x4 (&acc)[2][2][4][2], const Unit& u, int wr, int wc, int fr, int fq) const {
        float rsv[2][4];
        EPI_ROWS_NF rsv[ai][m] = ss1[u.pm * BM + ai * HALF + wr * 64 + m * 16 + fr];
        EPI_ROWS_NF rsv[ai][m] = rsqrtf(rsv[ai][m] * (1.f / 1024.f) + 1e-6f);
        EPI_ROWS { const int row = u.pm * BM + ai * HALF + wr * 64 + m * 16 + fr; float s = 0.f;
            const float rs = rsv[ai][m];
#pragma unroll
            for (int bj = 0; bj < 2; ++bj) { const size_t off = (size_t)row * 1024 + u.pn * BM + bj * HALF + 32 * wc + 8 * fq;
                const f32x4 a0 = acc[ai][bj][m][0] * rs, a1 = acc[ai][bj][m][1] * rs; const u32x4 pw = *(const u32x4*)(pp + off); const u32x4 hw = *(const u32x4*)(h1 + off);
                f32x4 h0, h1_;
                h0[0] = bf_lo(hw.x) + fsigmoid(a0[0]) * bf_lo(pw.x); h0[1] = bf_hi(hw.x) + fsigmoid(a0[1]) * bf_hi(pw.x); h0[2] = bf_lo(hw.y) + fsigmoid(a0[2]) * bf_lo(pw.y); h0[3] = bf_hi(hw.y) + fsigmoid(a0[3]) * bf_hi(pw.y);
                h1_[0] = bf_lo(hw.z) + fsigmoid(a1[0]) * bf_lo(pw.z); h1_[1] = bf_hi(hw.z) + fsigmoid(a1[1]) * bf_hi(pw.z); h1_[2] = bf_lo(hw.w) + fsigmoid(a1[2]) * bf_lo(pw.w); h1_[3] = bf_hi(hw.w) + fsigmoid(a1[3]) * bf_hi(pw.w);
                if (last) { *(f32x4*)(h + off) = h0; *(f32x4*)(h + off + 4) = h1_; }
                if (!last) { u32x4 w; w.x = cvt_pk_bf16(h0[0], h0[1]); w.y = cvt_pk_bf16(h0[2], h0[3]); w.z = cvt_pk_bf16(h1_[0], h1_[1]); w.w = cvt_pk_bf16(h1_[2], h1_[3]); *(u32x4*)(hb + off) = w;
                    s += ((h0[0] * h0[0] + h0[1] * h0[1]) + (h0[2] * h0[2] + h0[3] * h0[3])) + ((h1_[0] * h1_[0] + h1_[1] * h1_[1]) + (h1_[2] * h1_[2] + h1_[3] * h1_[3])); } }
            if (!last) { s += __shfl_xor(s, 16); s += __shfl_xor(s, 32); if (fq == 0) atomicAdd(ss2 + row, s); } }
    }
};
struct EpiPP {
    DI void prefetch(const Unit&, LAS unsigned char*, int) const {}
    bf16_t* pp;
    DI void operator()(const f32x4 (&acc)[2][2][4][2], const Unit& u, int wr, int wc, int fr, int fq) const {
        EPI_ROWS { const int row = u.pm * BM + ai * HALF + wr * 64 + m * 16 + fr;
#pragma unroll
            for (int bj = 0; bj < 2; ++bj) { const size_t off = (size_t)row * 1024 + u.pn * BM + bj * HALF + 32 * wc + 8 * fq; const f32x4 a0 = acc[ai][bj][m][0] * 1.0f, a1 = acc[ai][bj][m][1] * 1.0f;
                u32x4 w; w.x = cvt_pk_bf16(a0[0], a0[1]); w.y = cvt_pk_bf16(a0[2], a0[3]); w.z = cvt_pk_bf16(a1[0], a1[1]); w.w = cvt_pk_bf16(a1[2], a1[3]); *(u32x4*)(pp + off) = w; } }
    }
};

DI void attn_item(int item, const bf16_t* Q, const bf16_t* Kb, const bf16_t* VT, const bf16_t* GA, bf16_t* cat, int lane, LAS float* patch) {
    const int qb = item & 127, h = (item >> 7) & 7, b = item >> 10;
    const int q0 = qb * 32, hf = lane >> 5, ql = lane & 31;
    const bf16_t* qp = Q + (((size_t)(b * 8 + h)) << 18) + (size_t)(q0 >> 5) * 2048 + ql * 16 + 8 * hf;
    bf16x8 qf[4];
#pragma unroll
    for (int s = 0; s < 4; ++s) qf[s] = *(const bf16x8*)(qp + 512 * s);
    const int kperm = (ql & 16) | ((ql & 4) << 1) | ((ql & 8) >> 1) | (ql & 3);
    const bf16_t* kbase = Kb + (((size_t)(b * 8 + h)) << 18) + kperm * 16 + 8 * hf;
    const bf16_t* vbase = VT + (((size_t)(b * 8 + h)) << 18) + ql * 16 + 8 * hf;
    f32x16 o0, o1;
#pragma unroll
    for (int i = 0; i < 16; ++i) { o0[i] = 0.f; o1[i] = 0.f; }
    float cprod = 1.f;
    bf16x8 kf[4], vf[2][2];
    { const bf16_t* kp = kbase + (size_t)(q0 >> 5) * 2048; const bf16_t* vp = vbase + (size_t)(q0 >> 5) * 2048;
#pragma unroll
      for (int s = 0; s < 4; ++s) kf[s] = *(const bf16x8*)(kp + 512 * s);
#pragma unroll
      for (int s = 0; s < 2; ++s) { vf[s][0] = *(const bf16x8*)(vp + 512 * s); vf[s][1] = *(const bf16x8*)(vp + 1024 + 512 * s); } }
#define ATT_TILE(DIAG) { \
        f32x16 st; _Pragma("unroll") for (int i = 0; i < 16; ++i) st[i] = 0.f; \
        _Pragma("unroll") for (int s = 0; s < 4; ++s) st = __builtin_amdgcn_mfma_f32_32x32x16_bf16(kf[s], qf[s], st, 0, 0, 0); \
        const int kn = kb >= 32 ? kb - 32 : 0; const bf16_t* kp = kbase + (size_t)(kn >> 5) * 2048; const bf16_t* vp = vbase + (size_t)(kn >> 5) * 2048; \
        bf16x8 kf2[4], vf2[2][2]; \
        _Pragma("unroll") for (int s = 0; s < 4; ++s) kf2[s] = *(const bf16x8*)(kp + 512 * s); \
        _Pragma("unroll") for (int s = 0; s < 2; ++s) { vf2[s][0] = *(const bf16x8*)(vp + 512 * s); vf2[s][1] = *(const bf16x8*)(vp + 1024 + 512 * s); } \
        float sg[16], ns[16]; float PA = 1.f, PB = 1.f; \
        _Pragma("unroll") for (int r = 0; r < 16; ++r) { \
            const float t = st[r] * -1.4426950408889634f; \
            const float e = __builtin_amdgcn_exp2f(fminf(t, 115.0f));        \
            float sgm = __builtin_amdgcn_rcpf(1.0f + e);                     \
            float nsv = e * sgm;                                             \
            if (DIAG) { const int koff = 16 * (r >> 3) + 8 * hf + (r & 7); if (koff >= ql) { sgm = 0.f; nsv = 1.f; } } \
            sg[r] = sgm; ns[r] = nsv; if (r < 8) PA *= nsv; else PB *= nsv; } \
        const float PAo = __shfl_xor(PA, 32), PBo = __shfl_xor(PB, 32); \
        float runA = cprod * (PB * PBo) * (hf == 0 ? PAo : 1.f); float runB = cprod * (hf == 0 ? PBo : 1.f); \
        float w[16]; \
        _Pragma("unroll") for (int r = 7; r >= 0; --r) { w[r] = sg[r] * runA; runA *= ns[r]; } \
        _Pragma("unroll") for (int r = 15; r >= 8; --r) { w[r] = sg[r] * runB; runB *= ns[r]; } \
        cprod *= (PA * PAo) * (PB * PBo); \
        _Pragma("unroll") for (int s = 0; s < 2; ++s) { \
            u32x4 pw; pw.x = cvt_pk_bf16(w[8 * s], w[8 * s + 1]); pw.y = cvt_pk_bf16(w[8 * s + 2], w[8 * s + 3]); pw.z = cvt_pk_bf16(w[8 * s + 4], w[8 * s + 5]); pw.w = cvt_pk_bf16(w[8 * s + 6], w[8 * s + 7]); \
            const bf16x8 wf = __builtin_bit_cast(bf16x8, pw); \
            o0 = __builtin_amdgcn_mfma_f32_32x32x16_bf16(wf, vf[s][0], o0, 0, 0, 0); \
            o1 = __builtin_amdgcn_mfma_f32_32x32x16_bf16(wf, vf[s][1], o1, 0, 0, 0); } \
        _Pragma("unroll") for (int s = 0; s < 4; ++s) kf[s] = kf2[s]; \
        _Pragma("unroll") for (int s = 0; s < 2; ++s) { vf[s][0] = vf2[s][0]; vf[s][1] = vf2[s][1]; } \
        kb -= 32; }
    { int kb = q0;
      ATT_TILE(true)
      if (kb >= 0 && !__all(cprod < 1.17549435e-38f)) {
          _Pragma("nounroll") for (;;) { ATT_TILE(false) if (kb < 0 || __all(cprod < 1.17549435e-38f)) break; } } }
#undef ATT_TILE
#pragma unroll
    for (int r = 0; r < 16; ++r) { const int q = 8 * (r >> 2) + 4 * hf + (r & 3); patch[q * 68 + ql] = o0[r]; patch[q * 68 + 32 + ql] = o1[r]; }
    asm volatile("s_waitcnt lgkmcnt(0)" ::: "memory");
    { const int q = lane >> 1, dh = 32 * (lane & 1); const size_t tok = (size_t)(b * SEQ + q0 + q);
      const u32x4* gp = (const u32x4*)(GA + tok * 512 + h * 64 + dh); u32x4* cp = (u32x4*)(cat + tok * 1024 + 512 + h * 64 + dh);
#pragma unroll
      for (int i = 0; i < 4; ++i) { const u32x4 gw = gp[i]; const f32x4 a0 = *(const LAS f32x4*)(patch + q * 68 + dh + 8 * i), a1 = *(const LAS f32x4*)(patch + q * 68 + dh + 8 * i + 4);
          u32x4 w; w.x = cvt_pk_bf16(a0[0] * bf_lo(gw.x), a0[1] * bf_hi(gw.x)); w.y = cvt_pk_bf16(a0[2] * bf_lo(gw.y), a0[3] * bf_hi(gw.y));
          w.z = cvt_pk_bf16(a1[0] * bf_lo(gw.z), a1[1] * bf_hi(gw.z)); w.w = cvt_pk_bf16(a1[2] * bf_lo(gw.w), a1[3] * bf_hi(gw.w));
          cp[i] = w; } }
    asm volatile("s_waitcnt lgkmcnt(0)" ::: "memory");
}

DI void sincos_d(double ang, double& s, double& c) {
    const double k = rint(ang * 0.63661977236758134308);
    double y = fma(-k, 1.5707963267948966192, ang); y = fma(-k, 6.123233995736766e-17, y);
    const double y2 = y * y;
    const double sp = y * (1.0 - y2 * (1.0 / 6.0) * (1.0 - y2 * (1.0 / 20.0) * (1.0 - y2 * (1.0 / 42.0) * (1.0 - y2 * (1.0 / 72.0) * (1.0 - y2 * (1.0 / 110.0) * (1.0 - y2 * (1.0 / 156.0) * (1.0 - y2 * (1.0 / 210.0) * (1.0 - y2 * (1.0 / 272.0)))))))));
    const double cp = 1.0 - y2 * (1.0 / 2.0) * (1.0 - y2 * (1.0 / 12.0) * (1.0 - y2 * (1.0 / 30.0) * (1.0 - y2 * (1.0 / 56.0) * (1.0 - y2 * (1.0 / 90.0) * (1.0 - y2 * (1.0 / 132.0) * (1.0 - y2 * (1.0 / 182.0) * (1.0 - y2 * (1.0 / 240.0))))))));
    const int q = (int)((long long)k & 3);
    s = (q == 0) ? sp : (q == 1) ? cp : (q == 2) ? -sp : -cp;
    c = (q == 0) ? cp : (q == 1) ? -sp : (q == 2) ? -cp : sp;
}
DI double exp_d(double x) {
    const double k = rint(x * 1.4426950408889634074); const double r = fma(-k, 0.69314718055994530942, x);
    double t = 1.0;
#pragma unroll
    for (int i = 14; i >= 1; --i) t = 1.0 + t * r * (1.0 / (double)i);
    return ldexp(t, (int)k);
}

template <int MODE>
DI int colmap(int n) {
    if (MODE == 1) { const int pn = n >> 8, r = n & 255, bj = r >> 7, wc = (r >> 5) & 3, c = r & 31; return 256 * pn + 64 * wc + 32 * bj + c; }
    if (MODE == 2) { const int pn = n >> 8, r = n & 255; return r < 128 ? 128 * pn + r : 512 + 128 * pn + (r - 128); }
    if (MODE == 5) { const int rho = n & 31, nn = rho >> 4, i = rho & 15; const int m2 = (n & ~31) + 8 * (i >> 2) + 4 * nn + (i & 3); const int pn = m2 >> 8, r = m2 & 255, bj = r >> 7, wc = (r >> 5) & 3, c = r & 31; return 256 * pn + 64 * wc + 32 * bj + c; }
    if (MODE == 4) { const int rho = n & 31, nn = rho >> 4, i = rho & 15; const int m2 = (n & ~31) + 8 * (i >> 2) + 4 * nn + (i & 3); const int pn = m2 >> 8, r = m2 & 255; return r < 128 ? 128 * pn + r : 512 + 128 * pn + (r - 128); }
    if (MODE == 3) { const int rho = n & 31, nn = rho >> 4, i = rho & 15; return (n & ~31) + 8 * (i >> 2) + 4 * nn + (i & 3); }
    return n;
}
template <int MODE>
DI void transpose_w(const float* W, int K, int N, bf16_t* WT, const float* kscale, LAS float* scr, int gw, int nw, int lane) {
    const int nblk = N >> 5, items = (K >> 6) * nblk;
    for (int item = gw; item < items; item += nw) {
        const int kb = item / nblk, nb = item - kb * nblk, k0 = 64 * kb, n0 = 32 * nb, colL = colmap<MODE>(n0 + (lane & 31));
        float tv[32];
#pragma unroll
        for (int i = 0; i < 32; ++i) { const int kk = 2 * i + (lane >> 5); tv[i] = W[(size_t)(k0 + kk) * N + colL]; }
        if (kscale) {
#pragma unroll
            for (int i = 0; i < 32; ++i) tv[i] *= kscale[k0 + 2 * i + (lane >> 5)]; }
#pragma unroll
        for (int i = 0; i < 32; ++i) { const int kk = 2 * i + (lane >> 5); scr[kk * 33 + (lane & 31)] = tv[i]; }
        asm volatile("s_waitcnt lgkmcnt(0)" ::: "memory");
        const int cc = lane & 7;
#pragma unroll
        for (int j = 0; j < 4; ++j) { const int n = (lane >> 3) + 8 * j; const LAS float* sp = scr + (8 * cc) * 33 + n;
            u32x4 o; o.x = cvt_pk_bf16(sp[0 * 33], sp[1 * 33]); o.y = cvt_pk_bf16(sp[2 * 33], sp[3 * 33]); o.z = cvt_pk_bf16(sp[4 * 33], sp[5 * 33]); o.w = cvt_pk_bf16(sp[6 * 33], sp[7 * 33]);
            *(u32x4*)(WT + (size_t)(n0 + n) * K + k0 + 8 * cc) = o; }
        asm volatile("s_waitcnt lgkmcnt(0)" ::: "memory");
    }
}

DI void ssm_prep(const Params& P, int lg, int qd, LAS unsigned char* lds, int tid) {
    LAS float* apr = (LAS float*)lds;
    LAS float* api = apr + 33 * 64;
    LAS float* bbr = api + 33 * 64;
    LAS float* bbi = bbr + 1024;
    LAS float* cr = bbi + 1024;
    LAS float* ci = cr + 1024;
    LAS float* ktab = ci + 1024;
    LAS float* part = ktab + 8192;
    LAS double* fz = (LAS double*)(part + 8192);
    const double dt = exp_d((double)P.log_dt[lg]);
    for (int idx = tid; idx < 33 * 64; idx += 512) {
        const int tau = idx >> 6, p = idx & 63;
        const double lr = (double)P.a_re[lg * 64 + p], li = (double)P.a_im[lg * 64 + p];
        const double mag = exp_d(lr * dt * (double)tau); double s, c; sincos_d(li * dt * (double)tau, s, c);
        apr[idx] = (float)(mag * c); api[idx] = (float)(mag * s);
        if (tau == 32 && qd == 0) { float* a32 = (float*)(P.ws + WS_MISC) + (size_t)(lg * 64 + p) * 2; a32[0] = (float)(mag * c); a32[1] = (float)(mag * s); }
        if (tau == 1) {
            const double nr = mag * c - 1.0, ni = mag * s, den = lr * lr + li * li;
            fz[2 * p] = (nr * lr + ni * li) / den; fz[2 * p + 1] = (ni * lr - nr * li) / den; }
    }
    for (int idx = tid; idx < 1024; idx += 512) { cr[idx] = P.c_re[(size_t)lg * 1024 + idx]; ci[idx] = P.c_im[(size_t)lg * 1024 + idx]; }
    __syncthreads();
    for (int idx = tid; idx < 1024; idx += 512) { const int p = idx >> 4; const double fr_ = fz[2 * p], fi_ = fz[2 * p + 1];
        const double br = (double)P.b_re[(size_t)lg * 1024 + idx], bi = (double)P.b_im[(size_t)lg * 1024 + idx];
        bbr[idx] = (float)(fr_ * br - fi_ * bi); bbi[idx] = (float)(fr_ * bi + fi_ * br); }
    __syncthreads();
    {
        const int hh = tid & 255, hp = hh >> 4, h = hh & 15, ph = tid >> 8;
        float cbr[32], cbi[32];
#pragma unroll
        for (int i = 0; i < 32; ++i) { const int p = 32 * ph + i; const float c_r = cr[h * 64 + p], c_i = ci[h * 64 + p], x_r = bbr[p * 16 + hp], x_i = bbi[p * 16 + hp];
            cbr[i] = c_r * x_r - c_i * x_i; cbi[i] = c_r * x_i + c_i * x_r; }
        for (int tau = 0; tau < 32; ++tau) { float acc = 0.f;
#pragma unroll
            for (int i = 0; i < 32; ++i) acc += apr[tau * 64 + 32 * ph + i] * cbr[i] - api[tau * 64 + 32 * ph + i] * cbi[i];
            if (ph) part[tau * 256 + hh] = acc; else ktab[tau * 256 + hh] = acc; }
    }
    __syncthreads();
    for (int o = tid; o < 8192; o += 512) ktab[o] += part[o];
    __syncthreads();
    bf16_t* W1 = (bf16_t*)(P.ws + WS_W1) + (size_t)lg * 256 * 512;
    for (int it = tid; it < 128 * 64; it += 512) {
        const int n = 128 * qd + (it >> 6), k8 = it & 63, s = k8 >> 1, hp0 = (k8 & 1) * 8; float v[8];
#pragma unroll
        for (int i = 0; i < 8; ++i) {
            if (n < 128) { const int p = n & 63; const float ar = apr[(31 - s) * 64 + p], ai = api[(31 - s) * 64 + p], xr = bbr[p * 16 + hp0 + i], xi = bbi[p * 16 + hp0 + i];
                v[i] = n < 64 ? ar * xr - ai * xi : ar * xi + ai * xr; }
            else v[i] = 0.f;
        }
        u32x4 o; o.x = cvt_pk_bf16(v[0], v[1]); o.y = cvt_pk_bf16(v[2], v[3]); o.z = cvt_pk_bf16(v[4], v[5]); o.w = cvt_pk_bf16(v[6], v[7]);
        *(u32x4*)(W1 + (size_t)n * 512 + k8 * 8) = o;
    }
    bf16_t* TP = (bf16_t*)(P.ws + WS_TOEP) + (size_t)lg * 512 * 640;
    for (int it = tid; it < 256 * 80; it += 512) {
        const int n = 256 * qd + it / 80, k8 = it % 80, nl = colmap<3>(n), t = nl >> 4, h = nl & 15; float v[8];
        if (k8 < 64) { const int s = k8 >> 1, hp0 = (k8 & 1) * 8;
#pragma unroll
            for (int i = 0; i < 8; ++i) v[i] = (s <= t) ? ktab[(t - s) * 256 + (hp0 + i) * 16 + h] : 0.f;
        } else if (k8 < 72) {
#pragma unroll
            for (int i = 0; i < 8; ++i) { const int p = (k8 - 64) * 8 + i; v[i] = cr[h * 64 + p] * apr[(t + 1) * 64 + p] - ci[h * 64 + p] * api[(t + 1) * 64 + p]; }
        } else {
#pragma unroll
            for (int i = 0; i < 8; ++i) { const int p = (k8 - 72) * 8 + i; v[i] = -(cr[h * 64 + p] * api[(t + 1) * 64 + p] + ci[h * 64 + p] * apr[(t + 1) * 64 + p]); }
        }
        u32x4 o; o.x = cvt_pk_bf16(v[0], v[1]); o.y = cvt_pk_bf16(v[2], v[3]); o.z = cvt_pk_bf16(v[4], v[5]); o.w = cvt_pk_bf16(v[6], v[7]);
        *(u32x4*)(TP + (size_t)n * 640 + k8 * 8) = o;
    }
    __syncthreads();
}

#define XB_TMO      128
#define XB_XCNT(j)  (256  + 64 * (j))
#define XB_XSUB(j)  (1280 + 64 * (j))
#define XB_XGEN(j)  (2304 + 64 * (j))
#define XB_TOP      3328
#define XB_TOPGEN   3392
#define XCD_BAR_WORDS 3456
#define XB_SPIN_CAP (1u << 18)
DI unsigned xb_ld(unsigned* p) { return __hip_atomic_load(p, __ATOMIC_RELAXED, __HIP_MEMORY_SCOPE_AGENT); }
DI unsigned xb_add(unsigned* p, unsigned v) { return __hip_atomic_fetch_add(p, v, __ATOMIC_RELAXED, __HIP_MEMORY_SCOPE_AGENT); }
DI unsigned xb_xcc_id() { return (unsigned)__builtin_amdgcn_s_getreg((3 << 11) | 20) & 0xFu; }
#define XB_SPIN(cond, bar) do { unsigned _sp = 0; while (cond) { __builtin_amdgcn_s_sleep(1); \
    if ((++_sp & 255u) == 0u) { if (xb_ld(&(bar)[XB_TMO])) break; if (_sp > XB_SPIN_CAP) { atomicAdd(&(bar)[XB_TMO], 1u); break; } } } } while (0)
DI void xcd_barrier_complete(unsigned* bar, unsigned x, unsigned G, unsigned& nloc, unsigned& nx) {
    unsigned sum, cnt, mine, sp = 0u;
    for (;;) {
        sum = 0u; cnt = 0u; mine = 0u;
#pragma unroll 1
        for (unsigned j = 0; j < 16; ++j) { const unsigned cj = xb_ld(&bar[XB_XCNT(j)]); sum += cj; cnt += (cj > 0u) ? 1u : 0u; mine = (j == x) ? cj : mine; }
        if (sum == G) break;
        __builtin_amdgcn_s_sleep(1);
        if ((++sp & 255u) == 0u) { if (xb_ld(&bar[XB_TMO])) break; if (sp > XB_SPIN_CAP) { atomicAdd(&bar[XB_TMO], 1u); break; } }
    }
    nloc = mine > 0u ? mine : 1u; nx = cnt > 0u ? cnt : 1u;
}
DI void xcd_barrier(unsigned* bar, volatile LAS unsigned* st, const int wid) {
    asm volatile("" : "+s"(bar));
    asm volatile("s_waitcnt vmcnt(0)" ::: "memory");
    __syncthreads();
    if (wid == 0 && lane_fresh() == 0) {
        const unsigned x = xb_xcc_id();
        __builtin_amdgcn_s_waitcnt(0);
        const unsigned nloc = st[0], nx = st[1];
        const unsigned old = xb_add(&bar[XB_XSUB(x)], 1u);
        const unsigned gen = old / nloc;
        if (old + 1u == (gen + 1u) * nloc) {
            __builtin_amdgcn_fence(__ATOMIC_RELEASE, "agent");
            asm volatile("s_waitcnt vmcnt(0)" ::: "memory");
            const unsigned og = xb_add(&bar[XB_TOP], 1u);
            const unsigned tg = og / nx;
            if (og + 1u == (tg + 1u) * nx) xb_add(&bar[XB_TOPGEN], 1u);
            else XB_SPIN(xb_ld(&bar[XB_TOPGEN]) == tg, bar);
            __builtin_amdgcn_fence(__ATOMIC_ACQUIRE, "agent");
            xb_add(&bar[XB_XGEN(x)], 1u);
            asm volatile("s_waitcnt vmcnt(0)" ::: "memory");
        } else {
            XB_SPIN(xb_ld(&bar[XB_XGEN(x)]) == gen, bar);
            __builtin_amdgcn_fence(__ATOMIC_ACQUIRE, "agent");
            asm volatile("s_waitcnt vmcnt(0)" ::: "memory");
        }
    }
    __syncthreads();
}

__global__ void __launch_bounds__(512) mega(Params P) {
    extern __shared__ __attribute__((aligned(16))) unsigned char shm[];
    LAS unsigned char* lds = (LAS unsigned char*)shm;
    cg::grid_group grid = cg::this_grid();
    const int wid = __builtin_amdgcn_readfirstlane(threadIdx.x >> 6);
    const int G = gridDim.x, c = blockIdx.x;
    const int gthreads = G * 512;
#define LANE lane_fresh()
#define TID (wid * 64 + lane_fresh())
#define GTID (c * 512 + wid * 64 + lane_fresh())
    unsigned char* ws = P.ws;
    float* ssb = (float*)(ws + WS_MISC + 65536);
    bf16_t* hbA = (bf16_t*)(ws + WS_HBA);
    bf16_t* Ucat = (bf16_t*)(ws + WS_UCAT);
    bf16_t* SG = (bf16_t*)(ws + WS_SGGA); bf16_t* GA = SG + (size_t)T * 512; bf16_t* hbB = SG;
    bf16_t* Qb = (bf16_t*)(ws + WS_QK); bf16_t* Kb = Qb + (size_t)T * 512; bf16_t* pp = Qb;
    bf16_t* VT = (bf16_t*)(ws + WS_VT); bf16_t* zb = (bf16_t*)(ws + WS_ZB);
    bf16_t* cat = (bf16_t*)(ws + WS_CAT);
    float* Sbuf = (float*)(ws + WS_SBUF);
    bf16_t* pb = (bf16_t*)(ws + WS_PB);

    unsigned* bar = (unsigned*)(ws + WS_MISC + 786432);
    volatile LAS unsigned* xst = (volatile LAS unsigned*)(lds + STAGE_BYTES);
#define GSYNC() xcd_barrier(bar, xst, wid)
    if (wid == 0 && LANE == 0) { xst[0] = 0u; xst[1] = 0u; (void)xb_add(&bar[XB_XCNT(xb_xcc_id())], 1u); }
    if (P.ws == nullptr) grid.sync();
    for (int rep = 0; rep < REP_P0; ++rep) {
    const int role = (c >> 3) & 1, sc = ((c >> 4) << 3) | (c & 7), SG_ = G >> 1;
    const int sthreads = SG_ * 512;
    if (role == 0) ssm_prep(P, sc >> 1, sc & 1, lds, TID);
    { const int lane = LANE; LAS float* scr = (LAS float*)lds + wid * (64 * 33); const int l = role == 0 ? 1 : 0;
    for (int i = sc * 512 + TID; i < 3 * T; i += SG_ * 512) if (role == 1) ssb[T + i] = 0.f;
    {
        transpose_w<5>(P.w_in + (size_t)l * 1024 * 3072, 1024, 3072, (bf16_t*)(ws + WS_WIN) + (size_t)l * 3072 * 1024, P.mix_g + l * 1024, scr, sc * 8 + wid, SG_ * 8, lane);
        transpose_w<4>(P.w_glu + (size_t)l * 512 * 1024, 512, 1024, (bf16_t*)(ws + WS_WGLU) + (size_t)l * 1024 * 512, nullptr, scr, sc * 8 + wid, SG_ * 8, lane);
        transpose_w<3>(P.w_out + (size_t)l * 1024 * 1024, 1024, 1024, (bf16_t*)(ws + WS_WOUT) + (size_t)l * 1024 * 1024, nullptr, scr, sc * 8 + wid, SG_ * 8, lane);
        transpose_w<3>(P.w_pg + (size_t)l * 1024 * 1024, 1024, 1024, (bf16_t*)(ws + WS_WPG) + (size_t)l * 1024 * 1024, P.ple_g + l * 1024, scr, sc * 8 + wid, SG_ * 8, lane);
        transpose_w<3>(P.w_pp + (size_t)l * 256 * 1024, 256, 1024, (bf16_t*)(ws + WS_WPP) + (size_t)l * 1024 * 256, nullptr, scr, sc * 8 + wid, SG_ * 8, lane);
    } }
    if (role == 1)
    for (int row = (sc * 8 + wid) * 2; row < T; row += SG_ * 16) {
        const int lane = LANE;
        const f32x4* xr = (const f32x4*)(P.x + (size_t)row * 1024); f32x4 v[2][4];
#pragma unroll
        for (int r2 = 0; r2 < 2; ++r2)
#pragma unroll
            for (int j = 0; j < 4; ++j) v[r2][j] = xr[r2 * 256 + lane + 64 * j];
#pragma unroll
        for (int r2 = 0; r2 < 2; ++r2) { float s = 0.f;
#pragma unroll
            for (int j = 0; j < 4; ++j) { const f32x4 q = v[r2][j]; s += (q[0] * q[0] + q[1] * q[1]) + (q[2] * q[2] + q[3] * q[3]);
                u32x2 w; w.x = cvt_pk_bf16(q[0], q[1]); w.y = cvt_pk_bf16(q[2], q[3]); *(u32x2*)(hbA + (size_t)(row + r2) * 1024 + (lane + 64 * j) * 4) = w; }
#pragma unroll
            for (int o = 1; o < 64; o <<= 1) s += __shfl_xor(s, o);
            if (lane == 0) ssb[row + r2] = s; }
    }
    { const size_t pbase = (size_t)(role == 0 ? 1 : 0) * T * 256 / 8, pend = pbase + (size_t)T * 256 / 8;
    for (size_t i = pbase + sc * 512 + TID; i < pend; i += (size_t)4 * sthreads) {
        f32x4 a[4], b[4];
#pragma unroll
        for (int q = 0; q < 4; ++q) { const size_t ii = i + (size_t)q * sthreads; if (ii < pend) { a[q] = ((const f32x4*)P.p)[2 * ii]; b[q] = ((const f32x4*)P.p)[2 * ii + 1]; } }
#pragma unroll
        for (int q = 0; q < 4; ++q) { const size_t ii = i + (size_t)q * sthreads; if (ii < pend) {
            u32x4 o; o.x = cvt_pk_bf16(a[q][0], a[q][1]); o.y = cvt_pk_bf16(a[q][2], a[q][3]); o.z = cvt_pk_bf16(b[q][0], b[q][1]); o.w = cvt_pk_bf16(b[q][2], b[q][3]);
            ((u32x4*)pb)[ii] = o; } }
    }
    }
    }
    if (wid == 0 && LANE == 0) { unsigned nloc, nx; xcd_barrier_complete(bar, xb_xcc_id(), G, nloc, nx); xst[0] = nloc; xst[1] = nx; }
    GSYNC();

    auto layer = [&](const int l) __attribute__((always_inline)) {
        float* ssIn = ssb + (size_t)(2 * l) * T; float* ssMid = ssb + (size_t)(2 * l + 1) * T; float* ssNext = ssb + (size_t)(2 * l + 2 > 3 ? 3 : 2 * l + 2) * T;
        { Gemm g{hbA, (const bf16_t*)(ws + WS_WIN) + (size_t)l * 3072 * 1024, 1024, 1024, 1024, 0, 0};
          Order S; S.init(T / 256, 12, 1, G, c);
          EpiIn E{ssIn, Ucat, SG, GA, Qb, Kb, VT, P.q_g + l * 64, P.k_g + l * 64};
          for (int rep = 0; rep < REP_INPROJ; ++rep) gemm_phase(lds, g, S, E, wid); }
        GSYNC();
        { Gemm g{Ucat, (const bf16_t*)(ws + WS_W1) + (size_t)l * 32 * 256 * 512, 640, 512, 512, (size_t)1024 * 640, (size_t)256 * 512};
          Order S; S.init(4, 1, 32, G, c);
          EpiS E{Sbuf};
          for (int rep = 0; rep < REP_GEMMS; ++rep) gemm_phase(lds, g, S, E, wid); }
        if (c < 128) {
            asm volatile("s_waitcnt vmcnt(0)" ::: "memory"); __syncthreads();
            const int lane = LANE, seg = lane >> 4, pl = lane & 15;
            const int q_ = c >> 3, L_ = ((c & 7) * 4 + (q_ >> 2)) * 4 + (q_ & 3);
            const int pq = wid & 3, g = L_ >> 2, b = 2 * (L_ & 3) + (wid >> 2), p = pq * 16 + pl;
            const float* a32 = (const float*)(ws + WS_MISC) + (size_t)((l * 32 + g) * 64 + p) * 2; const float ar = a32[0], ai = a32[1];
            const size_t row0 = (size_t)g * 1024 + b * 128 + seg * 32;
            const float* __restrict__ Sp = Sbuf + row0 * 128 + p;
            float sr[32], si[32];
#pragma unroll
            for (int j = 0; j < 32; ++j) { sr[j] = Sp[(size_t)j * 128]; si[j] = Sp[(size_t)j * 128 + 64]; }
            float hr = 0.f, hi = 0.f, wr_ = 1.f, wi_ = 0.f;
#pragma unroll
            for (int j = 0; j < 32; ++j) { const float nr = ar * hr - ai * hi + sr[j], ni = ar * hi + ai * hr + si[j]; hr = nr; hi = ni;
                const float xr = ar * wr_ - ai * wi_, xi = ar * wi_ + ai * wr_; wr_ = xr; wi_ = xi; }
            const float e0r = __shfl(hr, pl), e0i = __shfl(hi, pl), e1r = __shfl(hr, pl + 16), e1i = __shfl(hi, pl + 16), e2r = __shfl(hr, pl + 32), e2i = __shfl(hi, pl + 32);
            const float h1r = e0r, h1i = e0i;
            const float h2r = wr_ * h1r - wi_ * h1i + e1r, h2i = wr_ * h1i + wi_ * h1r + e1i;
            const float h3r = wr_ * h2r - wi_ * h2i + e2r, h3i = wr_ * h2i + wi_ * h2r + e2i;
            const float cinr = seg == 0 ? 0.f : seg == 1 ? h1r : seg == 2 ? h2r : h3r, cini = seg == 0 ? 0.f : seg == 1 ? h1i : seg == 2 ? h2i : h3i;
            bf16_t* __restrict__ Up = Ucat + row0 * 640 + 512 + p;
            hr = 0.f; hi = 0.f; float cr_ = cinr, ci_ = cini;
#pragma unroll
            for (int j = 0; j < 32; ++j) {
                const unsigned pk = cvt_pk_bf16(hr + cr_, hi + ci_);
                Up[(size_t)j * 640] = (bf16_t)(pk & 0xffffu); Up[(size_t)j * 640 + 64] = (bf16_t)(pk >> 16);
                const float nr = ar * hr - ai * hi + sr[j], ni = ar * hi + ai * hr + si[j]; hr = nr; hi = ni;
                const float xr = ar * cr_ - ai * ci_, xi = ar * ci_ + ai * cr_; cr_ = xr; ci_ = xi; }
            asm volatile("s_waitcnt vmcnt(0)" ::: "memory"); __syncthreads();
            { Gemm gy{Ucat, (const bf16_t*)(ws + WS_TOEP) + (size_t)l * 32 * 512 * 640, 640, 640, 640, (size_t)1024 * 640, (size_t)512 * 640};
              Order SY; SY.nwg = -1; SY.nM = g; SY.nN = L_ & 3; SY.lim = 2; SY.total = 0; SY.G = 0; SY.c = 0;
              EpiY EY{Ucat, P.dsk + l * 512, zb};
              for (int rep = 0; rep < REP_Y; ++rep) gemm_phase(lds, gy, SY, EY, wid); }
        }
        for (int rep = 0; rep < REP_ATTN; ++rep)
        {
            const int nit = c < 128 ? 1 : 7, base = c < 128 ? (c * 8 + wid) : 1024 + (c - 128) * 56 + wid;
            for (int j = 0; j < nit; ++j) attn_item(base + 8 * j, Qb, Kb, VT, GA, cat, LANE, (LAS float*)(lds + wid * 8704)); }
        GSYNC();
        { Gemm g{zb, (const bf16_t*)(ws + WS_WGLU) + (size_t)l * 1024 * 512, 512, 512, 512, 0, 0};
          Order S; S.init(T / 256, 4, 1, G, c);
          EpiGlu E{P.b_glu + l * 1024, SG, cat};
          for (int rep = 0; rep < REP_GLU; ++rep) gemm_phase(lds, g, S, E, wid); }
        { Gemm g{pb + (size_t)l * T * 256, (const bf16_t*)(ws + WS_WPP) + (size_t)l * 1024 * 256, 256, 256, 256, 0, 0};
          Order S; S.init(T / 256, 4, 1, G, c);
          EpiPP E{pp};
          for (int rep = 0; rep < REP_PP; ++rep) gemm_phase(lds, g, S, E, wid); }
        GSYNC();
        { Gemm g{cat, (const bf16_t*)(ws + WS_WOUT) + (size_t)l * 1024 * 1024, 1024, 1024, 1024, 0, 0};
          Order S; S.init(T / 256, 4, 1, G, c);
          EpiOut E{hbA, hbB, ssMid};
          gemm_phase(lds, g, S, E, wid); }
        GSYNC();
        { Gemm g{hbB, (const bf16_t*)(ws + WS_WPG) + (size_t)l * 1024 * 1024, 1024, 1024, 1024, 0, 0};
          Order S; S.init(T / 256, 4, 1, G, c);
          EpiPle E{ssMid, hbB, P.out, pp, hbA, ssNext, l == 1 ? 1 : 0};
          gemm_phase(lds, g, S, E, wid); }
        if (l == 0) GSYNC();
    };
    layer(0); layer(1);
}

extern "C" void kernel_launch(void* const* d_in, const int* in_sizes, int n_in, void* d_out, int out_size, void* d_ws, size_t ws_size, hipStream_t stream) {
    static int grid = 0;
    if (grid == 0) {
        if (n_in != 20 || ws_size < WS_END) { fprintf(stderr, "kernel_launch: unexpected inputs (n_in %d, ws %zu < %zu)\n", n_in, ws_size, (size_t)WS_END); grid = -1; return; }
        int dev = 0, cus = 0, per_cu = 0;
        hipGetDevice(&dev); hipDeviceGetAttribute(&cus, hipDeviceAttributeMultiprocessorCount, dev);
        if (hipFuncSetAttribute((const void*)mega, hipFuncAttributeMaxDynamicSharedMemorySize, LDS_BYTES) != hipSuccess) { fprintf(stderr, "hipFuncSetAttribute failed\n"); grid = -1; return; }
        if (hipOccupancyMaxActiveBlocksPerMultiprocessor(&per_cu, (const void*)mega, 512, LDS_BYTES) != hipSuccess || per_cu < 1) { fprintf(stderr, "occupancy query: %d\n", per_cu); per_cu = 1; }
        (void)hipGetLastError();
        if (cus < 256) { fprintf(stderr, "kernel_launch: built for a 256-CU device (static work partition over 256 workgroups), found %d CUs; nothing launched\n", cus); grid = -1; return; }
        grid = 256;
    }
    if (grid < 0) return;
    if (hipMemsetAsync((char*)d_ws + WS_MISC + 786432, 0, XCD_BAR_WORDS * 4, stream) != hipSuccess) { fprintf(stderr, "kernel_launch: hipMemsetAsync failed\n"); return; }
    Params P{};
    const float** pp = (const float**)&P;
    for (int i = 0; i < 20; ++i) pp[i] = (const float*)d_in[i];
    P.out = (float*)d_out; P.ws = (unsigned char*)d_ws;
    void* args[] = {&P};
    hipError_t e = hipLaunchCooperativeKernel((const void*)mega, dim3(grid), dim3(512), args, LDS_BYTES, stream);
    if (e != hipSuccess) fprintf(stderr, "cooperative launch failed: %s (grid %d)\n", hipGetErrorString(e), grid);
}
```

```cpp
#ifndef REP_P0
#define REP_P0 1
#define REP_INPROJ 1
#define REP_ATTN 1
#define REP_SCAN 1
#define REP_SYNC 1
#define REP_GEMMS 1
#define REP_PP 1
#define REP_Y 1
#define REP_GLU 1
#endif
#include <hip/hip_runtime.h>
#include <hip/hip_cooperative_groups.h>
#include <cstdio>
namespace cg = cooperative_groups;

#define LAS __attribute__((address_space(3)))
#define DI __device__ __forceinline__
typedef unsigned short bf16_t;
typedef short bf16x8 __attribute__((ext_vector_type(8)));
typedef float f32x4 __attribute__((ext_vector_type(4)));
typedef float f32x16 __attribute__((ext_vector_type(16)));
typedef unsigned u32x4 __attribute__((ext_vector_type(4)));
typedef unsigned u32x2 __attribute__((ext_vector_type(2)));

constexpr int T = 32768, SEQ = 4096;
constexpr int BM = 256, BK = 64, HALF = 128, HTB = HALF * BK * 2, STAGE_BYTES = 8 * HTB, NXCD = 8, WGM = 2;
constexpr int LDS_DUMMY = STAGE_BYTES + 16;
constexpr int LDS_BYTES = STAGE_BYTES + 16 + 2048;

constexpr size_t MBy = 1u << 20;
constexpr size_t WS_WIN = 0;
constexpr size_t WS_WGLU = WS_WIN + 12 * MBy;
constexpr size_t WS_WOUT = WS_WGLU + 2 * MBy;
constexpr size_t WS_WPG = WS_WOUT + 4 * MBy;
constexpr size_t WS_WPP = WS_WPG + 4 * MBy;
constexpr size_t WS_W1 = WS_WPP + 1 * MBy;
constexpr size_t WS_TOEP = WS_W1 + 16 * MBy;
constexpr size_t WS_MISC = WS_TOEP + 40 * MBy;
constexpr size_t WS_HBA = WS_MISC + 1 * MBy;
constexpr size_t WS_UCAT = WS_HBA + 64 * MBy;
constexpr size_t WS_SGGA = WS_UCAT + 40 * MBy;
constexpr size_t WS_QK = WS_SGGA + 64 * MBy;
constexpr size_t WS_VT = WS_QK + 64 * MBy;
constexpr size_t WS_CAT = WS_VT + 32 * MBy;
constexpr size_t WS_SBUF = WS_CAT + 64 * MBy;
constexpr size_t WS_PB = WS_SBUF + 16 * MBy;
constexpr size_t WS_ZB = WS_PB + 32 * MBy;
constexpr size_t WS_END = WS_ZB + 32 * MBy;

struct Params {
    const float *x, *p, *mix_g, *w_in, *a_re, *a_im, *log_dt, *b_re, *b_im, *c_re, *c_im, *dsk, *w_glu, *b_glu, *q_g, *k_g, *w_out, *ple_g, *w_pg, *w_pp;
    float* out; unsigned char* ws;
};

DI int lane_fresh() { int l; asm volatile("v_mbcnt_lo_u32_b32 %0, -1, 0\n\tv_mbcnt_hi_u32_b32 %0, -1, %0" : "=v"(l)); return l; }
DI unsigned cvt_pk_bf16(float lo, float hi) { unsigned r; asm volatile("v_cvt_pk_bf16_f32 %0, %1, %2" : "=v"(r) : "v"(lo), "v"(hi)); return r; }
DI float bf_lo(unsigned w) { return __uint_as_float(w << 16); }
DI float bf_hi(unsigned w) { return __uint_as_float(w & 0xffff0000u); }
DI float fsigmoid(float x) { return __builtin_amdgcn_rcpf(1.0f + __expf(-x)); }
DI float fsilu(float x) { return x * fsigmoid(x); }
DI float fgelu_tanh(float y) { const float u2 = 1.5957691216057308f * (y + 0.044715f * y * y * y); return y * fsigmoid(u2); }

DI int lds_byte(int r, int c) { const int st = (r >> 4) * 2 + (c >> 5), rr = r & 15, cc = c & 31, ob = rr * 64 + cc * 2; return st * 1024 + (ob ^ (((ob >> 9) & 1) << 5)); }
DI void stage_rc(int b, int& R, int& C) { const int st = b / 1024, sb = b % 1024, swz = sb ^ (((sb >> 9) & 1) << 5); R = (st >> 1) * 16 + swz / 64; C = (st & 1) * 32 + (swz % 64) / 2; }

struct Unit { int pm, pn, g; };
struct Gemm { const bf16_t* A; const bf16_t* Bt; int lda, ldb, K; size_t gsA, gsB; };
struct Order {
    int nM, nN, nwg, total, G, c, lim;
    DI void init(int nM_, int nN_, int nG, int G_, int c_) { nM = nM_; nN = nN_; nwg = nM * nN; total = nwg * nG; lim = total; G = G_; c = c_; asm volatile("" : "+s"(c)); }
    DI bool next(int i, Unit& u) const {
        if (nwg < 0) { if (i >= lim) return false; u.g = nM; u.pm = nN; u.pn = i; return true; }
        int L = i * G + c; if (L >= lim) return false;
        if (total > nwg) {
            const int gpx = (total / nwg) >> 3, q = (c >> 3) + (G >> 3) * i; if (q >= gpx * nwg) return false;
            L = ((c & 7) * gpx + q / nwg) * nwg + q % nwg; }
        u.g = L / nwg; int wgid = L - u.g * nwg;
        { const int q = nwg / NXCD, r = nwg % NXCD, xcd = wgid % NXCD, off = wgid / NXCD; wgid = (xcd < r ? xcd * (q + 1) : r * (q + 1) + (xcd - r) * q) + off; }
        const int nig = WGM * nN, gid = wgid / nig, fm = gid * WGM, gsz = (nM - fm) < WGM ? (nM - fm) : WGM;
        u.pm = fm + ((wgid % nig) % gsz); u.pn = (wgid % nig) / gsz; return true;
    }
};

template <class Epi>
DI void gemm_phase(LAS unsigned char* lds, const Gemm g, const Order& S, const Epi& E, const int wid) {
    const int lane = lane_fresh(), tid = wid * 64 + lane, wr = wid >> 2, wc = wid & 3, fr = lane & 15, fq = lane >> 4;
    const int K = g.K, nt = K / BK;
    unsigned voffA[2], voffB[2];
#pragma unroll
    for (int i = 0; i < 2; ++i) { int R, C; stage_rc(tid * 16 + i * 8192, R, C); voffA[i] = (unsigned)(R * g.lda + C) * 2u; voffB[i] = (unsigned)(R * g.ldb + C) * 2u; }
    const size_t kstep = (size_t)(BK * 2);
    const size_t hstepA = (size_t)HALF * g.lda * 2, hstepB = (size_t)HALF * g.ldb * 2;
    const size_t tstepA = 2 * hstepA, tstepB = 2 * hstepB;
    const unsigned ldsw = (unsigned)wid * 1024u;
    const int aoff = lds_byte(wr * 64 + fr, fq * 8), boff = lds_byte(wc * 32 + fr, fq * 8);
#define PG8_SA(b, h) (((b) * 2 + (h)) * HTB)
#define PG8_SB(b, h) ((4 + (b) * 2 + (h)) * HTB)
#define PG8_STAGE(bufoff, gbase, voff) do { _Pragma("unroll") for (int _i = 0; _i < 2; ++_i) \
        __builtin_amdgcn_global_load_lds((const unsigned*)((const char*)(gbase) + (voff)[_i]), (LAS unsigned*)(lds + (bufoff) + ldsw + _i * 8192), 16, 0, 0); } while (0)
#define PG8_LDA(dst, b, h) do { _Pragma("unroll") for (int m = 0; m < 4; ++m) _Pragma("unroll") for (int k = 0; k < 2; ++k) dst[m][k] = *(const LAS bf16x8*)(lds + PG8_SA(b, h) + aoff + m * 2048 + k * 1024); } while (0)
#define PG8_LDB(dst, b, h) do { _Pragma("unroll") for (int n = 0; n < 2; ++n) _Pragma("unroll") for (int k = 0; k < 2; ++k) dst[n][k] = *(const LAS bf16x8*)(lds + PG8_SB(b, h) + boff + n * 2048 + k * 1024); } while (0)
#define PG8_MMA(ai, bj, At, Bt) do { __builtin_amdgcn_s_setprio(1); _Pragma("unroll") for (int m = 0; m < 4; ++m) _Pragma("unroll") for (int n = 0; n < 2; ++n) _Pragma("unroll") for (int k = 0; k < 2; ++k) \
        acc[ai][bj][m][n] = __builtin_amdgcn_mfma_f32_16x16x32_bf16(Bt[n][k], At[m][k], acc[ai][bj][m][n], 0, 0, 0); __builtin_amdgcn_s_setprio(0); } while (0)
#define PG8_WAIT_V(n) asm volatile("s_waitcnt vmcnt(" #n ")" ::: "memory")
#define PG8_WAIT_L(n) asm volatile("s_waitcnt lgkmcnt(" #n ")" ::: "memory")
#define PG8_BAR __builtin_amdgcn_s_barrier()
#define PG8_SCHED __builtin_amdgcn_sched_barrier(0)
    Unit cur, nxt; int ui = 0;
    if (!S.next(0, cur)) return;
    f32x4 acc[2][2][4][2];
#pragma unroll
    for (int a = 0; a < 2; ++a)
#pragma unroll
        for (int b = 0; b < 2; ++b)
#pragma unroll
            for (int m = 0; m < 4; ++m)
#pragma unroll
                for (int n = 0; n < 2; ++n) acc[a][b][m][n] = (f32x4){0.f, 0.f, 0.f, 0.f};
    bf16x8 At[4][2], B0[2][2], B1[2][2];
    const char* cA = (const char*)(g.A + (size_t)cur.g * g.gsA) + (size_t)cur.pm * tstepA;
    const char* cB = (const char*)(g.Bt + (size_t)cur.g * g.gsB) + (size_t)cur.pn * tstepB;
    PG8_STAGE(PG8_SB(0, 0), cB, voffB); PG8_STAGE(PG8_SB(0, 1), cB + hstepB, voffB); PG8_STAGE(PG8_SA(0, 0), cA, voffA); PG8_STAGE(PG8_SA(0, 1), cA + hstepA, voffA);
    if (wr == 1) PG8_BAR;
    PG8_WAIT_V(2); PG8_BAR;
    PG8_STAGE(PG8_SB(1, 0), cB + kstep, voffB); PG8_STAGE(PG8_SA(1, 0), cA + kstep, voffA); PG8_STAGE(PG8_SB(1, 1), cB + hstepB + kstep, voffB);
    PG8_WAIT_V(6); PG8_BAR;
    for (;;) {
        const bool has_next = S.next(ui + 1, nxt);
        const char* nA = has_next ? (const char*)(g.A + (size_t)nxt.g * g.gsA) + (size_t)nxt.pm * tstepA : cA;
        const char* nB = has_next ? (const char*)(g.Bt + (size_t)nxt.g * g.gsB) + (size_t)nxt.pn * tstepB : cB;
        for (int t = 0; t < nt; t += 2) {
            const bool last = (t == nt - 2);
            const char* a1 = cA + (size_t)(t + 1) * kstep;
            const char* a2 = last ? nA : cA + (size_t)(t + 2) * kstep; const char* b2 = last ? nB : cB + (size_t)(t + 2) * kstep;
            const char* a3 = a2 + kstep; const char* b3 = b2 + kstep;
            if (t == nt - 2) E.prefetch(cur, lds, wid);
            PG8_LDB(B0, 0, 0); PG8_LDB(B1, 0, 1); PG8_SCHED; PG8_LDA(At, 0, 0); PG8_STAGE(PG8_SA(1, 1), a1 + hstepA, voffA);
            PG8_WAIT_V(8); PG8_WAIT_L(0); PG8_BAR; PG8_MMA(0, 0, At, B0); PG8_MMA(0, 1, At, B1); PG8_BAR; PG8_SCHED;
            PG8_LDA(At, 0, 1); PG8_STAGE(PG8_SB(0, 0), b2, voffB); PG8_STAGE(PG8_SB(0, 1), b2 + hstepB, voffB); PG8_STAGE(PG8_SA(0, 0), a2, voffA);
            PG8_WAIT_V(8); PG8_WAIT_L(0); PG8_BAR; PG8_MMA(1, 0, At, B0); PG8_MMA(1, 1, At, B1); PG8_BAR; PG8_SCHED;
            PG8_LDB(B0, 1, 0); PG8_LDB(B1, 1, 1); PG8_SCHED; PG8_LDA(At, 1, 0); PG8_STAGE(PG8_SA(0, 1), a2 + hstepA, voffA);
            PG8_WAIT_V(8); PG8_WAIT_L(0); PG8_BAR; PG8_MMA(0, 0, At, B0); PG8_MMA(0, 1, At, B1); PG8_BAR; PG8_SCHED;
            PG8_LDA(At, 1, 1); PG8_STAGE(PG8_SB(1, 0), b3, voffB); PG8_STAGE(PG8_SB(1, 1), b3 + hstepB, voffB); PG8_STAGE(PG8_SA(1, 0), a3, voffA);
            PG8_WAIT_V(8); PG8_WAIT_L(0); PG8_BAR; PG8_MMA(1, 0, At, B0); PG8_MMA(1, 1, At, B1); PG8_BAR; PG8_SCHED;
        }
        if (wr == 0) PG8_BAR;
        { const int le = lane_fresh(); E(acc, cur, wr, wc, le & 15, le >> 4); }
        if (!has_next) break;
#pragma unroll
        for (int a = 0; a < 2; ++a)
#pragma unroll
            for (int b = 0; b < 2; ++b)
#pragma unroll
                for (int m = 0; m < 4; ++m)
#pragma unroll
                    for (int n = 0; n < 2; ++n) acc[a][b][m][n] = (f32x4){0.f, 0.f, 0.f, 0.f};
        cur = nxt; cA = nA; cB = nB; ++ui;
        if (wr == 1) PG8_BAR;
    }
    PG8_WAIT_V(0);
    PG8_BAR;
#undef PG8_SA
#undef PG8_SB
#undef PG8_STAGE
#undef PG8_LDA
#undef PG8_LDB
#undef PG8_MMA
#undef PG8_WAIT_V
#undef PG8_WAIT_L
#undef PG8_BAR
#undef PG8_SCHED
}

#define EPI_ROWS _Pragma("unroll") for (int ai = 0; ai < 2; ++ai) _Pragma("unroll") for (int m = 0; m < 4; ++m) if ((__extension__({ if (m == 0) asm volatile("" ::: "memory"); 1; })))
#define EPI_ROWS_NF _Pragma("unroll") for (int ai = 0; ai < 2; ++ai) _Pragma("unroll") for (int m = 0; m < 4; ++m)
#define EPI_COLS _Pragma("unroll") for (int bj = 0; bj < 2; ++bj) _Pragma("unroll") for (int n = 0; n < 2; ++n)

struct EpiIn {
    DI void prefetch(const Unit& u, LAS unsigned char* lds, int wid) const {
    }
    const float* ss; bf16_t *Ucat, *SG, *GA, *Q, *Kb, *VT; const float *qg, *kg;
    DI void operator()(const f32x4 (&acc)[2][2][4][2], const Unit& u, int wr, int wc, int fr, int fq) const {
        const int type = u.pn >> 1, hf = u.pn & 1;
        float rsv[2][4];
        EPI_ROWS_NF rsv[ai][m] = ss[u.pm * BM + ai * HALF + wr * 64 + m * 16 + fr];
        EPI_ROWS_NF rsv[ai][m] = rsqrtf(rsv[ai][m] * (1.f / 1024.f) + 1e-6f);
#define EPI_BJ _Pragma("unroll") for (int bj = 0; bj < 2; ++bj)
#define PACK8(w, a0, a1) do { w.x = cvt_pk_bf16(a0[0], a0[1]); w.y = cvt_pk_bf16(a0[2], a0[3]); w.z = cvt_pk_bf16(a1[0], a1[1]); w.w = cvt_pk_bf16(a1[2], a1[3]); } while (0)
        if (type == 0) {
            EPI_ROWS_NF { const int row = u.pm * BM + ai * HALF + wr * 64 + m * 16 + fr; const float rs = rsv[ai][m];
                EPI_BJ { const f32x4 v0 = acc[ai][bj][m][0] * rs, v1 = acc[ai][bj][m][1] * rs; const int g = 16 * hf + 4 * wc + 2 * bj + (fq >> 1);
                    u32x4 w; PACK8(w, v0, v1);
                    *(u32x4*)(Ucat + ((size_t)(g * 1024 + (row >> 5)) * 640 + (row & 31) * 16 + 8 * (fq & 1))) = w; } }
        } else if (type == 1 || type == 5) {
            bf16_t* dst = type == 1 ? SG : GA;
            EPI_ROWS_NF { const int row = u.pm * BM + ai * HALF + wr * 64 + m * 16 + fr; const float rs = rsv[ai][m];
                EPI_BJ { f32x4 v0 = acc[ai][bj][m][0] * rs, v1 = acc[ai][bj][m][1] * rs; const int cs = 256 * hf + 64 * wc + 32 * bj + 8 * fq;
#pragma unroll
                    for (int j = 0; j < 4; ++j) { v0[j] = fsilu(v0[j]); v1[j] = fsilu(v1[j]); }
                    u32x4 w; PACK8(w, v0, v1);
                    *(u32x4*)(dst + (size_t)row * 512 + cs) = w; } }
        } else if (type == 2 || type == 3) {
            bf16_t* dst = type == 2 ? Q : Kb; const float* gam = type == 2 ? qg : kg; const float sc = type == 2 ? 0.125f : 1.0f;
            f32x4 gv[2][2];
            EPI_COLS gv[bj][n] = *(const f32x4*)(gam + 32 * bj + 8 * fq + 4 * n) * sc;
            EPI_ROWS_NF { const int row = u.pm * BM + ai * HALF + wr * 64 + m * 16 + fr; const float rs = rsv[ai][m];
                f32x4 v[2][2]; float s = 0.f;
                EPI_COLS { v[bj][n] = acc[ai][bj][m][n] * rs; s += (v[bj][n][0] * v[bj][n][0] + v[bj][n][1] * v[bj][n][1]) + (v[bj][n][2] * v[bj][n][2] + v[bj][n][3] * v[bj][n][3]); }
                s += __shfl_xor(s, 16); s += __shfl_xor(s, 32);
                const float ri = rsqrtf(s * (1.f / 64.f) + 1e-6f);
                EPI_BJ { const f32x4 o0 = v[bj][0] * ri * gv[bj][0], o1 = v[bj][1] * ri * gv[bj][1]; const int cs = 256 * hf + 64 * wc + 32 * bj + 8 * fq;
                    u32x4 w; PACK8(w, o0, o1);
                    {
                        const int key = row & 4095; (void)cs;
                        *(u32x4*)(dst + (((size_t)((row >> 12) * 8 + 4 * hf + wc)) << 18) + (key >> 5) * 2048 + (2 * bj + (fq >> 1)) * 512 + (key & 31) * 16 + 8 * (fq & 1)) = w; } } }
        } else {
            EPI_ROWS_NF { const int row = u.pm * BM + ai * HALF + wr * 64 + m * 16 + fr; const float rs = rsv[ai][m];
                const int b = row >> 12, s = row & 4095, head = 4 * hf + wc;
                EPI_COLS { const f32x4 v = acc[ai][bj][m][n] * rs;
                    const unsigned w0 = cvt_pk_bf16(v[0], v[1]), w1 = cvt_pk_bf16(v[2], v[3]);
                    bf16_t* o = VT + (((size_t)(b * 8 + head)) << 18) + (s >> 5) * 2048 + bj * 1024 + ((s >> 4) & 1) * 512 + (8 * fq + 4 * n) * 16 + (s & 15);
                    o[0] = (bf16_t)(w0 & 0xffffu); o[16] = (bf16_t)(w0 >> 16); o[32] = (bf16_t)(w1 & 0xffffu); o[48] = (bf16_t)(w1 >> 16); } }
        }
#undef EPI_BJ
#undef PACK8
    }
};
struct EpiS {
    DI void prefetch(const Unit&, LAS unsigned char*, int) const {}
    float* Sbuf;
    DI void operator()(const f32x4 (&acc)[2][2][4][2], const Unit& u, int wr, int wc, int fr, int fq) const {
        EPI_ROWS { const int R = u.pm * BM + ai * HALF + wr * 64 + m * 16 + fr;
#pragma unroll
            for (int n = 0; n < 2; ++n) *(f32x4*)(Sbuf + ((size_t)(u.g * 1024 + R) * 128 + 32 * wc + 16 * n + 4 * fq)) = acc[ai][0][m][n]; }
    }
};
struct EpiY {
    DI void prefetch(const Unit&, LAS unsigned char*, int) const {}
    const bf16_t* Ucat; const float* dsk; bf16_t* zb;
    DI void operator()(const f32x4 (&acc)[2][2][4][2], const Unit& u, int wr, int wc, int fr, int fq) const {
        const int h0 = 8 * (fq & 1);
        const f32x4 dv0 = *(const f32x4*)(dsk + u.g * 16 + h0), dv1 = *(const f32x4*)(dsk + u.g * 16 + h0 + 4);
        EPI_ROWS { const int R = u.pm * BM + ai * HALF + wr * 64 + m * 16 + fr;
#pragma unroll
            for (int bj = 0; bj < 2; ++bj) { const int ncol = u.pn * BM + bj * HALF + 32 * wc + 8 * fq;
                const u32x4 ub = *(const u32x4*)(Ucat + ((size_t)(u.g * 1024 + R) * 640 + ncol));
                f32x4 y0 = acc[ai][bj][m][0], y1 = acc[ai][bj][m][1];
                y0[0] += dv0[0] * bf_lo(ub.x); y0[1] += dv0[1] * bf_hi(ub.x); y0[2] += dv0[2] * bf_lo(ub.y); y0[3] += dv0[3] * bf_hi(ub.y);
                y1[0] += dv1[0] * bf_lo(ub.z); y1[1] += dv1[1] * bf_hi(ub.z); y1[2] += dv1[2] * bf_lo(ub.w); y1[3] += dv1[3] * bf_hi(ub.w);
                u32x4 w; w.x = cvt_pk_bf16(fgelu_tanh(y0[0]), fgelu_tanh(y0[1])); w.y = cvt_pk_bf16(fgelu_tanh(y0[2]), fgelu_tanh(y0[3]));
                w.z = cvt_pk_bf16(fgelu_tanh(y1[0]), fgelu_tanh(y1[1])); w.w = cvt_pk_bf16(fgelu_tanh(y1[2]), fgelu_tanh(y1[3]));
                const int token = R * 32 + (ncol >> 4);
                *(u32x4*)(zb + (size_t)token * 512 + u.g * 16 + h0) = w; } }
    }
};
struct EpiGlu {
    DI void prefetch(const Unit& u, LAS unsigned char* lds, int wid) const {
        const int id = wid * 64 + lane_fresh(), row = id >> 1, seg = id & 1;
        __builtin_amdgcn_global_load_lds((const unsigned*)(SG + (size_t)(u.pm * BM + row) * 512 + u.pn * 128 + seg * 64), (LAS unsigned*)(lds + LDS_DUMMY + wid * 256), 4, 0, 0);
    }
    const float* bglu; const bf16_t* SG; bf16_t* cat;
    DI void operator()(const f32x4 (&acc)[2][2][4][2], const Unit& u, int wr, int wc, int fr, int fq) const {
        const int ch = u.pn * 128 + 32 * wc + 8 * fq;
        f32x4 bv[2], bg[2];
#pragma unroll
        for (int n = 0; n < 2; ++n) { bv[n] = *(const f32x4*)(bglu + ch + 4 * n); bg[n] = *(const f32x4*)(bglu + 512 + ch + 4 * n); }
        EPI_ROWS { const int row = u.pm * BM + ai * HALF + wr * 64 + m * 16 + fr;
            const f32x4 v0 = acc[ai][0][m][0] + bv[0], g0 = acc[ai][1][m][0] + bg[0], v1 = acc[ai][0][m][1] + bv[1], g1 = acc[ai][1][m][1] + bg[1];
            const u32x4 sg = *(const u32x4*)(SG + (size_t)row * 512 + ch);
            u32x4 w;
            w.x = cvt_pk_bf16(v0[0] * fsigmoid(g0[0]) * bf_lo(sg.x), v0[1] * fsigmoid(g0[1]) * bf_hi(sg.x)); w.y = cvt_pk_bf16(v0[2] * fsigmoid(g0[2]) * bf_lo(sg.y), v0[3] * fsigmoid(g0[3]) * bf_hi(sg.y));
            w.z = cvt_pk_bf16(v1[0] * fsigmoid(g1[0]) * bf_lo(sg.z), v1[1] * fsigmoid(g1[1]) * bf_hi(sg.z)); w.w = cvt_pk_bf16(v1[2] * fsigmoid(g1[2]) * bf_lo(sg.w), v1[3] * fsigmoid(g1[3]) * bf_hi(sg.w));
            *(u32x4*)(cat + (size_t)row * 1024 + ch) = w; }
    }
};
struct EpiOut {
    DI void prefetch(const Unit& u, LAS unsigned char* lds, int wid) const {
        const int tid = wid * 64 + lane_fresh();
#pragma unroll
        for (int i = 0; i < 2; ++i) { const int id = tid + 512 * i, row = id >> 2, seg = id & 3;
            __builtin_amdgcn_global_load_lds((const unsigned*)(hin + (size_t)(u.pm * BM + row) * 1024 + u.pn * BM + seg * 64), (LAS unsigned*)(lds + LDS_DUMMY + wid * 256), 4, 0, 0); }
    }
    const bf16_t* hin; bf16_t* hb; float* ss;
    DI void operator()(const f32x4 (&acc)[2][2][4][2], const Unit& u, int wr, int wc, int fr, int fq) const {
        EPI_ROWS { const int row = u.pm * BM + ai * HALF + wr * 64 + m * 16 + fr; float s = 0.f;
#pragma unroll
            for (int bj = 0; bj < 2; ++bj) { const size_t off = (size_t)row * 1024 + u.pn * BM + bj * HALF + 32 * wc + 8 * fq;
                const u32x4 rw = *(const u32x4*)(hin + off); f32x4 h0 = acc[ai][bj][m][0], h1_ = acc[ai][bj][m][1];
                h0[0] += bf_lo(rw.x); h0[1] += bf_hi(rw.x); h0[2] += bf_lo(rw.y); h0[3] += bf_hi(rw.y); h1_[0] += bf_lo(rw.z); h1_[1] += bf_hi(rw.z); h1_[2] += bf_lo(rw.w); h1_[3] += bf_hi(rw.w);
                u32x4 w; w.x = cvt_pk_bf16(h0[0], h0[1]); w.y = cvt_pk_bf16(h0[2], h0[3]); w.z = cvt_pk_bf16(h1_[0], h1_[1]); w.w = cvt_pk_bf16(h1_[2], h1_[3]); *(u32x4*)(hb + off) = w;
                s += ((h0[0] * h0[0] + h0[1] * h0[1]) + (h0[2] * h0[2] + h0[3] * h0[3])) + ((h1_[0] * h1_[0] + h1_[1] * h1_[1]) + (h1_[2] * h1_[2] + h1_[3] * h1_[3])); }
            s += __shfl_xor(s, 16); s += __shfl_xor(s, 32);
            if (fq == 0) atomicAdd(ss + row, s); }
    }
};
struct EpiPle {
    DI void prefetch(const Unit& u, LAS unsigned char* lds, int wid) const {
        const int tid = wid * 64 + lane_fresh();
#pragma unroll
        for (int i = 0; i < 2; ++i) { const int id = tid + 512 * i, row = id >> 2, seg = id & 3; const size_t off = (size_t)(u.pm * BM + row) * 1024 + u.pn * BM + seg * 64;
            __builtin_amdgcn_global_load_lds((const unsigned*)(pp + off), (LAS unsigned*)(lds + LDS_DUMMY + wid * 256), 4, 0, 0); }
        if (wid < 4) __builtin_amdgcn_global_load_lds((const unsigned*)(ss1 + u.pm * BM + tid), (LAS unsigned*)(lds + LDS_DUMMY + wid * 256), 4, 0, 0);
    }
    const float* ss1; const bf16_t* h1; float* h; const bf16_t* pp; bf16_t* hb; float* ss2; int last;
    DI void operator()(const f32x4 (&acc)[2][2][4][2], const Unit& u, int wr, int wc, int fr, int fq) const {
        float rsv[2][4];
        EPI_ROWS_NF rsv[ai][m] = ss1[u.pm * BM + ai * HALF + wr * 64 + m * 16 + fr];
        EPI_ROWS_NF rsv[ai][m] = rsqrtf(rsv[ai][m] * (1.f / 1024.f) + 1e-6f);
        EPI_ROWS { const int row = u.pm * BM + ai * HALF + wr * 64 + m * 16 + fr; float s = 0.f;
            const float rs = rsv[ai][m];
#pragma unroll
            for (int bj = 0; bj < 2; ++bj) { const size_t off = (size_t)row * 1024 + u.pn * BM + bj * HALF + 32 * wc + 8 * fq;
                const f32x4 a0 = acc[ai][bj][m][0] * rs, a1 = acc[ai][bj][m][1] * rs; const u32x4 pw = *(const u32x4*)(pp + off); const u32x4 hw = *(const u32x4*)(h1 + off);
                f32x4 h0, h1_;
                h0[0] = bf_lo(hw.x) + fsigmoid(a0[0]) * bf_lo(pw.x); h0[1] = bf_hi(hw.x) + fsigmoid(a0[1]) * bf_hi(pw.x); h0[2] = bf_lo(hw.y) + fsigmoid(a0[2]) * bf_lo(pw.y); h0[3] = bf_hi(hw.y) + fsigmoid(a0[3]) * bf_hi(pw.y);
                h1_[0] = bf_lo(hw.z) + fsigmoid(a1[0]) * bf_lo(pw.z); h1_[1] = bf_hi(hw.z) + fsigmoid(a1[1]) * bf_hi(pw.z); h1_[2] = bf_lo(hw.w) + fsigmoid(a1[2]) * bf_lo(pw.w); h1_[3] = bf_hi(hw.w) + fsigmoid(a1[3]) * bf_hi(pw.w);
                if (last) { *(f32x4*)(h + off) = h0; *(f32x4*)(h + off + 4) = h1_; }
                if (!last) { u32x4 w; w.x = cvt_pk_bf16(h0[0], h0[1]); w.y = cvt_pk_bf16(h0[2], h0[3]); w.z = cvt_pk_bf16(h1_[0], h1_[1]); w.w = cvt_pk_bf16(h1_[2], h1_[3]); *(u32x4*)(hb + off) = w;
                    s += ((h0[0] * h0[0] + h0[1] * h0[1]) + (h0[2] * h0[2] + h0[3] * h0[3])) + ((h1_[0] * h1_[0] + h1_[1] * h1_[1]) + (h1_[2] * h1_[2] + h1_[3] * h1_[3])); } }
            if (!last) { s += __shfl_xor(s, 16); s += __shfl_xor(s, 32); if (fq == 0) atomicAdd(ss2 + row, s); } }
    }
};
struct EpiPP {
    DI void prefetch(const Unit&, LAS unsigned char*, int) const {}
    bf16_t* pp;
    DI void operator()(const f32x4 (&acc)[2][2][4][2], const Unit& u, int wr, int wc, int fr, int fq) const {
        EPI_ROWS { const int row = u.pm * BM + ai * HALF + wr * 64 + m * 16 + fr;
#pragma unroll
            for (int bj = 0; bj < 2; ++bj) { const size_t off = (size_t)row * 1024 + u.pn * BM + bj * HALF + 32 * wc + 8 * fq; const f32x4 a0 = acc[ai][bj][m][0] * 1.0f, a1 = acc[ai][bj][m][1] * 1.0f;
                u32x4 w; w.x = cvt_pk_bf16(a0[0], a0[1]); w.y = cvt_pk_bf16(a0[2], a0[3]); w.z = cvt_pk_bf16(a1[0], a1[1]); w.w = cvt_pk_bf16(a1[2], a1[3]); *(u32x4*)(pp + off) = w; } }
    }
};

DI void attn_item(int item, const bf16_t* Q, const bf16_t* Kb, const bf16_t* VT, const bf16_t* GA, bf16_t* cat, int lane, LAS float* patch) {
    const int qb = item & 127, h = (item >> 7) & 7, b = item >> 10;
    const int q0 = qb * 32, hf = lane >> 5, ql = lane & 31;
    const bf16_t* qp = Q + (((size_t)(b * 8 + h)) << 18) + (size_t)(q0 >> 5) * 2048 + ql * 16 + 8 * hf;
    bf16x8 qf[4];
#pragma unroll
    for (int s = 0; s < 4; ++s) qf[s] = *(const bf16x8*)(qp + 512 * s);
    const int kperm = (ql & 16) | ((ql & 4) << 1) | ((ql & 8) >> 1) | (ql & 3);
    const bf16_t* kbase = Kb + (((size_t)(b * 8 + h)) << 18) + kperm * 16 + 8 * hf;
    const bf16_t* vbase = VT + (((size_t)(b * 8 + h)) << 18) + ql * 16 + 8 * hf;
    f32x16 o0, o1;
#pragma unroll
    for (int i = 0; i < 16; ++i) { o0[i] = 0.f; o1[i] = 0.f; }
    float cprod = 1.f;
    bf16x8 kf[4], vf[2][2];
    { const bf16_t* kp = kbase + (size_t)(q0 >> 5) * 2048; const bf16_t* vp = vbase + (size_t)(q0 >> 5) * 2048;
#pragma unroll
      for (int s = 0; s < 4; ++s) kf[s] = *(const bf16x8*)(kp + 512 * s);
#pragma unroll
      for (int s = 0; s < 2; ++s) { vf[s][0] = *(const bf16x8*)(vp + 512 * s); vf[s][1] = *(const bf16x8*)(vp + 1024 + 512 * s); } }
#define ATT_TILE(DIAG) { \
        f32x16 st; _Pragma("unroll") for (int i = 0; i < 16; ++i) st[i] = 0.f; \
        _Pragma("unroll") for (int s = 0; s < 4; ++s) st = __builtin_amdgcn_mfma_f32_32x32x16_bf16(kf[s], qf[s], st, 0, 0, 0); \
        const int kn = kb >= 32 ? kb - 32 : 0; const bf16_t* kp = kbase + (size_t)(kn >> 5) * 2048; const bf16_t* vp = vbase + (size_t)(kn >> 5) * 2048; \
        bf16x8 kf2[4], vf2[2][2]; \
        _Pragma("unroll") for (int s = 0; s < 4; ++s) kf2[s] = *(const bf16x8*)(kp + 512 * s); \
        _Pragma("unroll") for (int s = 0; s < 2; ++s) { vf2[s][0] = *(const bf16x8*)(vp + 512 * s); vf2[s][1] = *(const bf16x8*)(vp + 1024 + 512 * s); } \
        float sg[16], ns[16]; float PA = 1.f, PB = 1.f; \
        _Pragma("unroll") for (int r = 0; r < 16; ++r) { \
            const float t = st[r] * -1.4426950408889634f; \
            const float e = __builtin_amdgcn_exp2f(fminf(t, 115.0f));        \
            float sgm = __builtin_amdgcn_rcpf(1.0f + e);                     \
            float nsv = e * sgm;                                             \
            if (DIAG) { const int koff = 16 * (r >> 3) + 8 * hf + (r & 7); if (koff >= ql) { sgm = 0.f; nsv = 1.f; } } \
            sg[r] = sgm; ns[r] = nsv; if (r < 8) PA *= nsv; else PB *= nsv; } \
        const float PAo = __shfl_xor(PA, 32), PBo = __shfl_xor(PB, 32); \
        float runA = cprod * (PB * PBo) * (hf == 0 ? PAo : 1.f); float runB = cprod * (hf == 0 ? PBo : 1.f); \
        float w[16]; \
        _Pragma("unroll") for (int r = 7; r >= 0; --r) { w[r] = sg[r] * runA; runA *= ns[r]; } \
        _Pragma("unroll") for (int r = 15; r >= 8; --r) { w[r] = sg[r] * runB; runB *= ns[r]; } \
        cprod *= (PA * PAo) * (PB * PBo); \
        _Pragma("unroll") for (int s = 0; s < 2; ++s) { \
            u32x4 pw; pw.x = cvt_pk_bf16(w[8 * s], w[8 * s + 1]); pw.y = cvt_pk_bf16(w[8 * s + 2], w[8 * s + 3]); pw.z = cvt_pk_bf16(w[8 * s + 4], w[8 * s + 5]); pw.w = cvt_pk_bf16(w[8 * s + 6], w[8 * s + 7]); \
            const bf16x8 wf = __builtin_bit_cast(bf16x8, pw); \
            o0 = __builtin_amdgcn_mfma_f32_32x32x16_bf16(wf, vf[s][0], o0, 0, 0, 0); \
            o1 = __builtin_amdgcn_mfma_f32_32x32x16_bf16(wf, vf[s][1], o1, 0, 0, 0); } \
        _Pragma("unroll") for (int s = 0; s < 4; ++s) kf[s] = kf2[s]; \
        _Pragma("unroll") for (int s = 0; s < 2; ++s) { vf[s][0] = vf2[s][0]; vf[s][1] = vf2[s][1]; } \
        kb -= 32; }
    { int kb = q0;
      ATT_TILE(true)
      if (kb >= 0 && !__all(cprod < 1.17549435e-38f)) {
          _Pragma("nounroll") for (;;) { ATT_TILE(false) if (kb < 0 || __all(cprod < 1.17549435e-38f)) break; } } }
#undef ATT_TILE
#pragma unroll
    for (int r = 0; r < 16; ++r) { const int q = 8 * (r >> 2) + 4 * hf + (r & 3); patch[q * 68 + ql] = o0[r]; patch[q * 68 + 32 + ql] = o1[r]; }
    asm volatile("s_waitcnt lgkmcnt(0)" ::: "memory");
    { const int q = lane >> 1, dh = 32 * (lane & 1); const size_t tok = (size_t)(b * SEQ + q0 + q);
      const u32x4* gp = (const u32x4*)(GA + tok * 512 + h * 64 + dh); u32x4* cp = (u32x4*)(cat + tok * 1024 + 512 + h * 64 + dh);
#pragma unroll
      for (int i = 0; i < 4; ++i) { const u32x4 gw = gp[i]; const f32x4 a0 = *(const LAS f32x4*)(patch + q * 68 + dh + 8 * i), a1 = *(const LAS f32x4*)(patch + q * 68 + dh + 8 * i + 4);
          u32x4 w; w.x = cvt_pk_bf16(a0[0] * bf_lo(gw.x), a0[1] * bf_hi(gw.x)); w.y = cvt_pk_bf16(a0[2] * bf_lo(gw.y), a0[3] * bf_hi(gw.y));
          w.z = cvt_pk_bf16(a1[0] * bf_lo(gw.z), a1[1] * bf_hi(gw.z)); w.w = cvt_pk_bf16(a1[2] * bf_lo(gw.w), a1[3] * bf_hi(gw.w));
          cp[i] = w; } }
    asm volatile("s_waitcnt lgkmcnt(0)" ::: "memory");
}

DI void sincos_d(double ang, double& s, double& c) {
    const double k = rint(ang * 0.63661977236758134308);
    double y = fma(-k, 1.5707963267948966192, ang); y = fma(-k, 6.123233995736766e-17, y);
    const double y2 = y * y;
    const double sp = y * (1.0 - y2 * (1.0 / 6.0) * (1.0 - y2 * (1.0 / 20.0) * (1.0 - y2 * (1.0 / 42.0) * (1.0 - y2 * (1.0 / 72.0) * (1.0 - y2 * (1.0 / 110.0) * (1.0 - y2 * (1.0 / 156.0) * (1.0 - y2 * (1.0 / 210.0) * (1.0 - y2 * (1.0 / 272.0)))))))));
    const double cp = 1.0 - y2 * (1.0 / 2.0) * (1.0 - y2 * (1.0 / 12.0) * (1.0 - y2 * (1.0 / 30.0) * (1.0 - y2 * (1.0 / 56.0) * (1.0 - y2 * (1.0 / 90.0) * (1.0 - y2 * (1.0 / 132.0) * (1.0 - y2 * (1.0 / 182.0) * (1.0 - y2 * (1.0 / 240.0))))))));
    const int q = (int)((long long)k & 3);
    s = (q == 0) ? sp : (q == 1) ? cp : (q == 2) ? -sp : -cp;
    c = (q == 0) ? cp : (q == 1) ? -sp : (q == 2) ? -cp : sp;
}
DI double exp_d(double x) {
    const double k = rint(x * 1.4426950408889634074); const double r = fma(-k, 0.69314718055994530942, x);
    double t = 1.0;
#pragma unroll
    for (int i = 14; i >= 1; --i) t = 1.0 + t * r * (1.0 / (double)i);
    return ldexp(t, (int)k);
}

template <int MODE>
DI int colmap(int n) {
    if (MODE == 1) { const int pn = n >> 8, r = n & 255, bj = r >> 7, wc = (r >> 5) & 3, c = r & 31; return 256 * pn + 64 * wc + 32 * bj + c; }
    if (MODE == 2) { const int pn = n >> 8, r = n & 255; return r < 128 ? 128 * pn + r : 512 + 128 * pn + (r - 128); }
    if (MODE == 5) { const int rho = n & 31, nn = rho >> 4, i = rho & 15; const int m2 = (n & ~31) + 8 * (i >> 2) + 4 * nn + (i & 3); const int pn = m2 >> 8, r = m2 & 255, bj = r >> 7, wc = (r >> 5) & 3, c = r & 31; return 256 * pn + 64 * wc + 32 * bj + c; }
    if (MODE == 4) { const int rho = n & 31, nn = rho >> 4, i = rho & 15; const int m2 = (n & ~31) + 8 * (i >> 2) + 4 * nn + (i & 3); const int pn = m2 >> 8, r = m2 & 255; return r < 128 ? 128 * pn + r : 512 + 128 * pn + (r - 128); }
    if (MODE == 3) { const int rho = n & 31, nn = rho >> 4, i = rho & 15; return (n & ~31) + 8 * (i >> 2) + 4 * nn + (i & 3); }
    return n;
}
template <int MODE>
DI void transpose_w(const float* W, int K, int N, bf16_t* WT, const float* kscale, LAS float* scr, int gw, int nw, int lane) {
    const int nblk = N >> 5, items = (K >> 6) * nblk;
    for (int item = gw; item < items; item += nw) {
        const int kb = item / nblk, nb = item - kb * nblk, k0 = 64 * kb, n0 = 32 * nb, colL = colmap<MODE>(n0 + (lane & 31));
        float tv[32];
#pragma unroll
        for (int i = 0; i < 32; ++i) { const int kk = 2 * i + (lane >> 5); tv[i] = W[(size_t)(k0 + kk) * N + colL]; }
        if (kscale) {
#pragma unroll
            for (int i = 0; i < 32; ++i) tv[i] *= kscale[k0 + 2 * i + (lane >> 5)]; }
#pragma unroll
        for (int i = 0; i < 32; ++i) { const int kk = 2 * i + (lane >> 5); scr[kk * 33 + (lane & 31)] = tv[i]; }
        asm volatile("s_waitcnt lgkmcnt(0)" ::: "memory");
        const int cc = lane & 7;
#pragma unroll
        for (int j = 0; j < 4; ++j) { const int n = (lane >> 3) + 8 * j; const LAS float* sp = scr + (8 * cc) * 33 + n;
            u32x4 o; o.x = cvt_pk_bf16(sp[0 * 33], sp[1 * 33]); o.y = cvt_pk_bf16(sp[2 * 33], sp[3 * 33]); o.z = cvt_pk_bf16(sp[4 * 33], sp[5 * 33]); o.w = cvt_pk_bf16(sp[6 * 33], sp[7 * 33]);
            *(u32x4*)(WT + (size_t)(n0 + n) * K + k0 + 8 * cc) = o; }
        asm volatile("s_waitcnt lgkmcnt(0)" ::: "memory");
    }
}

DI void ssm_prep(const Params& P, int lg, int qd, LAS unsigned char* lds, int tid) {
    LAS float* apr = (LAS float*)lds;
    LAS float* api = apr + 33 * 64;
    LAS float* bbr = api + 33 * 64;
    LAS float* bbi = bbr + 1024;
    LAS float* cr = bbi + 1024;
    LAS float* ci = cr + 1024;
    LAS float* ktab = ci + 1024;
    LAS float* part = ktab + 8192;
    LAS double* fz = (LAS double*)(part + 8192);
    const double dt = exp_d((double)P.log_dt[lg]);
    for (int idx = tid; idx < 33 * 64; idx += 512) {
        const int tau = idx >> 6, p = idx & 63;
        const double lr = (double)P.a_re[lg * 64 + p], li = (double)P.a_im[lg * 64 + p];
        const double mag = exp_d(lr * dt * (double)tau); double s, c; sincos_d(li * dt * (double)tau, s, c);
        apr[idx] = (float)(mag * c); api[idx] = (float)(mag * s);
        if (tau == 32 && qd == 0) { float* a32 = (float*)(P.ws + WS_MISC) + (size_t)(lg * 64 + p) * 2; a32[0] = (float)(mag * c); a32[1] = (float)(mag * s); }
        if (tau == 1) {
            const double nr = mag * c - 1.0, ni = mag * s, den = lr * lr + li * li;
            fz[2 * p] = (nr * lr + ni * li) / den; fz[2 * p + 1] = (ni * lr - nr * li) / den; }
    }
    for (int idx = tid; idx < 1024; idx += 512) { cr[idx] = P.c_re[(size_t)lg * 1024 + idx]; ci[idx] = P.c_im[(size_t)lg * 1024 + idx]; }
    __syncthreads();
    for (int idx = tid; idx < 1024; idx += 512) { const int p = idx >> 4; const double fr_ = fz[2 * p], fi_ = fz[2 * p + 1];
        const double br = (double)P.b_re[(size_t)lg * 1024 + idx], bi = (double)P.b_im[(size_t)lg * 1024 + idx];
        bbr[idx] = (float)(fr_ * br - fi_ * bi); bbi[idx] = (float)(fr_ * bi + fi_ * br); }
    __syncthreads();
    {
        const int hh = tid & 255, hp = hh >> 4, h = hh & 15, ph = tid >> 8;
        float cbr[32], cbi[32];
#pragma unroll
        for (int i = 0; i < 32; ++i) { const int p = 32 * ph + i; const float c_r = cr[h * 64 + p], c_i = ci[h * 64 + p], x_r = bbr[p * 16 + hp], x_i = bbi[p * 16 + hp];
            cbr[i] = c_r * x_r - c_i * x_i; cbi[i] = c_r * x_i + c_i * x_r; }
        for (int tau = 0; tau < 32; ++tau) { float acc = 0.f;
#pragma unroll
            for (int i = 0; i < 32; ++i) acc += apr[tau * 64 + 32 * ph + i] * cbr[i] - api[tau * 64 + 32 * ph + i] * cbi[i];
            if (ph) part[tau * 256 + hh] = acc; else ktab[tau * 256 + hh] = acc; }
    }
    __syncthreads();
    for (int o = tid; o < 8192; o += 512) ktab[o] += part[o];
    __syncthreads();
    bf16_t* W1 = (bf16_t*)(P.ws + WS_W1) + (size_t)lg * 256 * 512;
    for (int it = tid; it < 128 * 64; it += 512) {
        const int n = 128 * qd + (it >> 6), k8 = it & 63, s = k8 >> 1, hp0 = (k8 & 1) * 8; float v[8];
#pragma unroll
        for (int i = 0; i < 8; ++i) {
            if (n < 128) { const int p = n & 63; const float ar = apr[(31 - s) * 64 + p], ai = api[(31 - s) * 64 + p], xr = bbr[p * 16 + hp0 + i], xi = bbi[p * 16 + hp0 + i];
                v[i] = n < 64 ? ar * xr - ai * xi : ar * xi + ai * xr; }
            else v[i] = 0.f;
        }
        u32x4 o; o.x = cvt_pk_bf16(v[0], v[1]); o.y = cvt_pk_bf16(v[2], v[3]); o.z = cvt_pk_bf16(v[4], v[5]); o.w = cvt_pk_bf16(v[6], v[7]);
        *(u32x4*)(W1 + (size_t)n * 512 + k8 * 8) = o;
    }
    bf16_t* TP = (bf16_t*)(P.ws + WS_TOEP) + (size_t)lg * 512 * 640;
    for (int it = tid; it < 256 * 80; it += 512) {
        const int n = 256 * qd + it / 80, k8 = it % 80, nl = colmap<3>(n), t = nl >> 4, h = nl & 15; float v[8];
        if (k8 < 64) { const int s = k8 >> 1, hp0 = (k8 & 1) * 8;
#pragma unroll
            for (int i = 0; i < 8; ++i) v[i] = (s <= t) ? ktab[(t - s) * 256 + (hp0 + i) * 16 + h] : 0.f;
        } else if (k8 < 72) {
#pragma unroll
            for (int i = 0; i < 8; ++i) { const int p = (k8 - 64) * 8 + i; v[i] = cr[h * 64 + p] * apr[(t + 1) * 64 + p] - ci[h * 64 + p] * api[(t + 1) * 64 + p]; }
        } else {
#pragma unroll
            for (int i = 0; i < 8; ++i) { const int p = (k8 - 72) * 8 + i; v[i] = -(cr[h * 64 + p] * api[(t + 1) * 64 + p] + ci[h * 64 + p] * apr[(t + 1) * 64 + p]); }
        }
        u32x4 o; o.x = cvt_pk_bf16(v[0], v[1]); o.y = cvt_pk_bf16(v[2], v[3]); o.z = cvt_pk_bf16(v[4], v[5]); o.w = cvt_pk_bf16(v[6], v[7]);
        *(u32x4*)(TP + (size_t)n * 640 + k8 * 8) = o;
    }
    __syncthreads();
}

#define XB_TMO      128
#define XB_XCNT(j)  (256  + 64 * (j))
#define XB_XSUB(j)  (1280 + 64 * (j))
#define XB_XGEN(j)  (2304 + 64 * (j))
#define XB_TOP      3328
#define XB_TOPGEN   3392
#define XCD_BAR_WORDS 3456
#define XB_SPIN_CAP (1u << 18)
DI unsigned xb_ld(unsigned* p) { return __hip_atomic_load(p, __ATOMIC_RELAXED, __HIP_MEMORY_SCOPE_AGENT); }
DI unsigned xb_add(unsigned* p, unsigned v) { return __hip_atomic_fetch_add(p, v, __ATOMIC_RELAXED, __HIP_MEMORY_SCOPE_AGENT); }
DI unsigned xb_xcc_id() { return (unsigned)__builtin_amdgcn_s_getreg((3 << 11) | 20) & 0xFu; }
#define XB_SPIN(cond, bar) do { unsigned _sp = 0; while (cond) { __builtin_amdgcn_s_sleep(1); \
    if ((++_sp & 255u) == 0u) { if (xb_ld(&(bar)[XB_TMO])) break; if (_sp > XB_SPIN_CAP) { atomicAdd(&(bar)[XB_TMO], 1u); break; } } } } while (0)
DI void xcd_barrier_complete(unsigned* bar, unsigned x, unsigned G, unsigned& nloc, unsigned& nx) {
    unsigned sum, cnt, mine, sp = 0u;
    for (;;) {
        sum = 0u; cnt = 0u; mine = 0u;
#pragma unroll 1
        for (unsigned j = 0; j < 16; ++j) { const unsigned cj = xb_ld(&bar[XB_XCNT(j)]); sum += cj; cnt += (cj > 0u) ? 1u : 0u; mine = (j == x) ? cj : mine; }
        if (sum == G) break;
        __builtin_amdgcn_s_sleep(1);
        if ((++sp & 255u) == 0u) { if (xb_ld(&bar[XB_TMO])) break; if (sp > XB_SPIN_CAP) { atomicAdd(&bar[XB_TMO], 1u); break; } }
    }
    nloc = mine > 0u ? mine : 1u; nx = cnt > 0u ? cnt : 1u;
}
DI void xcd_barrier(unsigned* bar, volatile LAS unsigned* st, const int wid) {
    asm volatile("" : "+s"(bar));
    asm volatile("s_waitcnt vmcnt(0)" ::: "memory");
    __syncthreads();
    if (wid == 0 && lane_fresh() == 0) {
        const unsigned x = xb_xcc_id();
        __builtin_amdgcn_s_waitcnt(0);
        const unsigned nloc = st[0], nx = st[1];
        const unsigned old = xb_add(&bar[XB_XSUB(x)], 1u);
        const unsigned gen = old / nloc;
        if (old + 1u == (gen + 1u) * nloc) {
            __builtin_amdgcn_fence(__ATOMIC_RELEASE, "agent");
            asm volatile("s_waitcnt vmcnt(0)" ::: "memory");
            const unsigned og = xb_add(&bar[XB_TOP], 1u);
            const unsigned tg = og / nx;
            if (og + 1u == (tg + 1u) * nx) xb_add(&bar[XB_TOPGEN], 1u);
            else XB_SPIN(xb_ld(&bar[XB_TOPGEN]) == tg, bar);
            __builtin_amdgcn_fence(__ATOMIC_ACQUIRE, "agent");
            xb_add(&bar[XB_XGEN(x)], 1u);
            asm volatile("s_waitcnt vmcnt(0)" ::: "memory");
        } else {
            XB_SPIN(xb_ld(&bar[XB_XGEN(x)]) == gen, bar);
            __builtin_amdgcn_fence(__ATOMIC_ACQUIRE, "agent");
            asm volatile("s_waitcnt vmcnt(0)" ::: "memory");
        }
    }
    __syncthreads();
}

__global__ void __launch_bounds__(512) mega(Params P) {
    extern __shared__ __attribute__((aligned(16))) unsigned char shm[];
    LAS unsigned char* lds = (LAS unsigned char*)shm;
    cg::grid_group grid = cg::this_grid();
    const int wid = __builtin_amdgcn_readfirstlane(threadIdx.x >> 6);
    const int G = gridDim.x, c = blockIdx.x;
    const int gthreads = G * 512;
#define LANE lane_fresh()
#define TID (wid * 64 + lane_fresh())
#define GTID (c * 512 + wid * 64 + lane_fresh())
    unsigned char* ws = P.ws;
    float* ssb = (float*)(ws + WS_MISC + 65536);
    bf16_t* hbA = (bf16_t*)(ws + WS_HBA);
    bf16_t* Ucat = (bf16_t*)(ws + WS_UCAT);
    bf16_t* SG = (bf16_t*)(ws + WS_SGGA); bf16_t* GA = SG + (size_t)T * 512; bf16_t* hbB = SG;
    bf16_t* Qb = (bf16_t*)(ws + WS_QK); bf16_t* Kb = Qb + (size_t)T * 512; bf16_t* pp = Qb;
    bf16_t* VT = (bf16_t*)(ws + WS_VT); bf16_t* zb = (bf16_t*)(ws + WS_ZB);
    bf16_t* cat = (bf16_t*)(ws + WS_CAT);
    float* Sbuf = (float*)(ws + WS_SBUF);
    bf16_t* pb = (bf16_t*)(ws + WS_PB);

    unsigned* bar = (unsigned*)(ws + WS_MISC + 786432);
    volatile LAS unsigned* xst = (volatile LAS unsigned*)(lds + STAGE_BYTES);
#define GSYNC() xcd_barrier(bar, xst, wid)
    if (wid == 0 && LANE == 0) { xst[0] = 0u; xst[1] = 0u; (void)xb_add(&bar[XB_XCNT(xb_xcc_id())], 1u); }
    if (P.ws == nullptr) grid.sync();
    for (int rep = 0; rep < REP_P0; ++rep) {
    const int role = (c >> 3) & 1, sc = ((c >> 4) << 3) | (c & 7), SG_ = G >> 1;
    const int sthreads = SG_ * 512;
    if (role == 0) ssm_prep(P, sc >> 1, sc & 1, lds, TID);
    { const int lane = LANE; LAS float* scr = (LAS float*)lds + wid * (64 * 33); const int l = role == 0 ? 1 : 0;
    for (int i = sc * 512 + TID; i < 3 * T; i += SG_ * 512) if (role == 1) ssb[T + i] = 0.f;
    {
        transpose_w<5>(P.w_in + (size_t)l * 1024 * 3072, 1024, 3072, (bf16_t*)(ws + WS_WIN) + (size_t)l * 3072 * 1024, P.mix_g + l * 1024, scr, sc * 8 + wid, SG_ * 8, lane);
        transpose_w<4>(P.w_glu + (size_t)l * 512 * 1024, 512, 1024, (bf16_t*)(ws + WS_WGLU) + (size_t)l * 1024 * 512, nullptr, scr, sc * 8 + wid, SG_ * 8, lane);
        transpose_w<3>(P.w_out + (size_t)l * 1024 * 1024, 1024, 1024, (bf16_t*)(ws + WS_WOUT) + (size_t)l * 1024 * 1024, nullptr, scr, sc * 8 + wid, SG_ * 8, lane);
        transpose_w<3>(P.w_pg + (size_t)l * 1024 * 1024, 1024, 1024, (bf16_t*)(ws + WS_WPG) + (size_t)l * 1024 * 1024, P.ple_g + l * 1024, scr, sc * 8 + wid, SG_ * 8, lane);
        transpose_w<3>(P.w_pp + (size_t)l * 256 * 1024, 256, 1024, (bf16_t*)(ws + WS_WPP) + (size_t)l * 1024 * 256, nullptr, scr, sc * 8 + wid, SG_ * 8, lane);
    } }
    if (role == 1)
    for (int row = (sc * 8 + wid) * 2; row < T; row += SG_ * 16) {
        const int lane = LANE;
        const f32x4* xr = (const f32x4*)(P.x + (size_t)row * 1024); f32x4 v[2][4];
#pragma unroll
        for (int r2 = 0; r2 < 2; ++r2)
#pragma unroll
            for (int j = 0; j < 4; ++j) v[r2][j] = xr[r2 * 256 + lane + 64 * j];
#pragma unroll
        for (int r2 = 0; r2 < 2; ++r2) { float s = 0.f;
#pragma unroll
            for (int j = 0; j < 4; ++j) { const f32x4 q = v[r2][j]; s += (q[0] * q[0] + q[1] * q[1]) + (q[2] * q[2] + q[3] * q[3]);
                u32x2 w; w.x = cvt_pk_bf16(q[0], q[1]); w.y = cvt_pk_bf16(q[2], q[3]); *(u32x2*)(hbA + (size_t)(row + r2) * 1024 + (lane + 64 * j) * 4) = w; }
#pragma unroll
            for (int o = 1; o < 64; o <<= 1) s += __shfl_xor(s, o);
            if (lane == 0) ssb[row + r2] = s; }
    }
    { const size_t pbase = (size_t)(role == 0 ? 1 : 0) * T * 256 / 8, pend = pbase + (size_t)T * 256 / 8;
    for (size_t i = pbase + sc * 512 + TID; i < pend; i += (size_t)4 * sthreads) {
        f32x4 a[4], b[4];
#pragma unroll
        for (int q = 0; q < 4; ++q) { const size_t ii = i + (size_t)q * sthreads; if (ii < pend) { a[q] = ((const f32x4*)P.p)[2 * ii]; b[q] = ((const f32x4*)P.p)[2 * ii + 1]; } }
#pragma unroll
        for (int q = 0; q < 4; ++q) { const size_t ii = i + (size_t)q * sthreads; if (ii < pend) {
            u32x4 o; o.x = cvt_pk_bf16(a[q][0], a[q][1]); o.y = cvt_pk_bf16(a[q][2], a[q][3]); o.z = cvt_pk_bf16(b[q][0], b[q][1]); o.w = cvt_pk_bf16(b[q][2], b[q][3]);
            ((u32x4*)pb)[ii] = o; } }
    }
    }
    }
    if (wid == 0 && LANE == 0) { unsigned nloc, nx; xcd_barrier_complete(bar, xb_xcc_id(), G, nloc, nx); xst[0] = nloc; xst[1] = nx; }
    GSYNC();

    auto layer = [&](const int l) __attribute__((always_inline)) {
        float* ssIn = ssb + (size_t)(2 * l) * T; float* ssMid = ssb + (size_t)(2 * l + 1) * T; float* ssNext = ssb + (size_t)(2 * l + 2 > 3 ? 3 : 2 * l + 2) * T;
        { Gemm g{hbA, (const bf16_t*)(ws + WS_WIN) + (size_t)l * 3072 * 1024, 1024, 1024, 1024, 0, 0};
          Order S; S.init(T / 256, 12, 1, G, c);
          EpiIn E{ssIn, Ucat, SG, GA, Qb, Kb, VT, P.q_g + l * 64, P.k_g + l * 64};
          for (int rep = 0; rep < REP_INPROJ; ++rep) gemm_phase(lds, g, S, E, wid); }
        GSYNC();
        { Gemm g{Ucat, (const bf16_t*)(ws + WS_W1) + (size_t)l * 32 * 256 * 512, 640, 512, 512, (size_t)1024 * 640, (size_t)256 * 512};
          Order S; S.init(4, 1, 32, G, c);
          EpiS E{Sbuf};
          for (int rep = 0; rep < REP_GEMMS; ++rep) gemm_phase(lds, g, S, E, wid); }
        if (c < 128) {
            asm volatile("s_waitcnt vmcnt(0)" ::: "memory"); __syncthreads();
            const int lane = LANE, seg = lane >> 4, pl = lane & 15;
            const int q_ = c >> 3, L_ = ((c & 7) * 4 + (q_ >> 2)) * 4 + (q_ & 3);
            const int pq = wid & 3, g = L_ >> 2, b = 2 * (L_ & 3) + (wid >> 2), p = pq * 16 + pl;
            const float* a32 = (const float*)(ws + WS_MISC) + (size_t)((l * 32 + g) * 64 + p) * 2; const float ar = a32[0], ai = a32[1];
            const size_t row0 = (size_t)g * 1024 + b * 128 + seg * 32;
            const float* __restrict__ Sp = Sbuf + row0 * 128 + p;
            float sr[32], si[32];
#pragma unroll
            for (int j = 0; j < 32; ++j) { sr[j] = Sp[(size_t)j * 128]; si[j] = Sp[(size_t)j * 128 + 64]; }
            float hr = 0.f, hi = 0.f, wr_ = 1.f, wi_ = 0.f;
#pragma unroll
            for (int j = 0; j < 32; ++j) { const float nr = ar * hr - ai * hi + sr[j], ni = ar * hi + ai * hr + si[j]; hr = nr; hi = ni;
                const float xr = ar * wr_ - ai * wi_, xi = ar * wi_ + ai * wr_; wr_ = xr; wi_ = xi; }
            const float e0r = __shfl(hr, pl), e0i = __shfl(hi, pl), e1r = __shfl(hr, pl + 16), e1i = __shfl(hi, pl + 16), e2r = __shfl(hr, pl + 32), e2i = __shfl(hi, pl + 32);
            const float h1r = e0r, h1i = e0i;
            const float h2r = wr_ * h1r - wi_ * h1i + e1r, h2i = wr_ * h1i + wi_ * h1r + e1i;
            const float h3r = wr_ * h2r - wi_ * h2i + e2r, h3i = wr_ * h2i + wi_ * h2r + e2i;
            const float cinr = seg == 0 ? 0.f : seg == 1 ? h1r : seg == 2 ? h2r : h3r, cini = seg == 0 ? 0.f : seg == 1 ? h1i : seg == 2 ? h2i : h3i;
            bf16_t* __restrict__ Up = Ucat + row0 * 640 + 512 + p;
            hr = 0.f; hi = 0.f; float cr_ = cinr, ci_ = cini;
#pragma unroll
            for (int j = 0; j < 32; ++j) {
                const unsigned pk = cvt_pk_bf16(hr + cr_, hi + ci_);
                Up[(size_t)j * 640] = (bf16_t)(pk & 0xffffu); Up[(size_t)j * 640 + 64] = (bf16_t)(pk >> 16);
                const float nr = ar * hr - ai * hi + sr[j], ni = ar * hi + ai * hr + si[j]; hr = nr; hi = ni;
                const float xr = ar * cr_ - ai * ci_, xi = ar * ci_ + ai * cr_; cr_ = xr; ci_ = xi; }
            asm volatile("s_waitcnt vmcnt(0)" ::: "memory"); __syncthreads();
            { Gemm gy{Ucat, (const bf16_t*)(ws + WS_TOEP) + (size_t)l * 32 * 512 * 640, 640, 640, 640, (size_t)1024 * 640, (size_t)512 * 640};
              Order SY; SY.nwg = -1; SY.nM = g; SY.nN = L_ & 3; SY.lim = 2; SY.total = 0; SY.G = 0; SY.c = 0;
              EpiY EY{Ucat, P.dsk + l * 512, zb};
              for (int rep = 0; rep < REP_Y; ++rep) gemm_phase(lds, gy, SY, EY, wid); }
        }
        for (int rep = 0; rep < REP_ATTN; ++rep)
        {
            const int nit = c < 128 ? 1 : 7, base = c < 128 ? (c * 8 + wid) : 1024 + (c - 128) * 56 + wid;
            for (int j = 0; j < nit; ++j) attn_item(base + 8 * j, Qb, Kb, VT, GA, cat, LANE, (LAS float*)(lds + wid * 8704)); }
        GSYNC();
        { Gemm g{zb, (const bf16_t*)(ws + WS_WGLU) + (size_t)l * 1024 * 512, 512, 512, 512, 0, 0};
          Order S; S.init(T / 256, 4, 1, G, c);
          EpiGlu E{P.b_glu + l * 1024, SG, cat};
          for (int rep = 0; rep < REP_GLU; ++rep) gemm_phase(lds, g, S, E, wid); }
        { Gemm g{pb + (size_t)l * T * 256, (const bf16_t*)(ws + WS_WPP) + (size_t)l * 1024 * 256, 256, 256, 256, 0, 0};
          Order S; S.init(T / 256, 4, 1, G, c);
          EpiPP E{pp};
          for (int rep = 0; rep < REP_PP; ++rep) gemm_phase(lds, g, S, E, wid); }
        GSYNC();
        { Gemm g{cat, (const bf16_t*)(ws + WS_WOUT) + (size_t)l * 1024 * 1024, 1024, 1024, 1024, 0, 0};
          Order S; S.init(T / 256, 4, 1, G, c);
          EpiOut E{hbA, hbB, ssMid};
          gemm_phase(lds, g, S, E, wid); }
        GSYNC();
        { Gemm g{hbB, (const bf16_t*)(ws + WS_WPG) + (size_t)l * 1024 * 1024, 1024, 1024, 1024, 0, 0};
          Order S; S.init(T / 256, 4, 1, G, c);
          EpiPle E{ssMid, hbB, P.out, pp, hbA, ssNext, l == 1 ? 1 : 0};
          gemm_phase(lds, g, S, E, wid); }
        if (l == 0) GSYNC();
    };
    layer(0); layer(1);
}

extern "C" void kernel_launch(void* const* d_in, const int* in_sizes, int n_in, void* d_out, int out_size, void* d_ws, size_t ws_size, hipStream_t stream) {
    static int grid = 0;
    if (grid == 0) {
        if (n_in != 20 || ws_size < WS_END) { fprintf(stderr, "kernel_launch: unexpected inputs (n_in %d, ws %zu < %zu)\n", n_in, ws_size, (size_t)WS_END); grid = -1; return; }
        int dev = 0, cus = 0, per_cu = 0;
        hipGetDevice(&dev); hipDeviceGetAttribute(&cus, hipDeviceAttributeMultiprocessorCount, dev);
        if (hipFuncSetAttribute((const void*)mega, hipFuncAttributeMaxDynamicSharedMemorySize, LDS_BYTES) != hipSuccess) { fprintf(stderr, "hipFuncSetAttribute failed\n"); grid = -1; return; }
        if (hipOccupancyMaxActiveBlocksPerMultiprocessor(&per_cu, (const void*)mega, 512, LDS_BYTES) != hipSuccess || per_cu < 1) { fprintf(stderr, "occupancy query: %d\n", per_cu); per_cu = 1; }
        (void)hipGetLastError();
        if (cus < 256) { fprintf(stderr, "kernel_launch: built for a 256-CU device (static work partition over 256 workgroups), found %d CUs; nothing launched\n", cus); grid = -1; return; }
        grid = 256;
    }
    if (grid < 0) return;
    if (hipMemsetAsync((char*)d_ws + WS_MISC + 786432, 0, XCD_BAR_WORDS * 4, stream) != hipSuccess) { fprintf(stderr, "kernel_launch: hipMemsetAsync failed\n"); return; }
    Params P{};
    const float** pp = (const float**)&P;
    for (int i = 0; i < 20; ++i) pp[i] = (const float*)d_in[i];
    P.out = (float*)d_out; P.ws = (unsigned char*)d_ws;
    void* args[] = {&P};
    hipError_t e = hipLaunchCooperativeKernel((const void*)mega, dim3(grid), dim3(512), args, LDS_BYTES, stream);
    if (e != hipSuccess) fprintf(stderr, "cooperative launch failed: %s (grid %d)\n", hipGetErrorString(e), grid);
}
```
